# Optimizing an MI355X kernel written in HIP

```python
import math
import jax
import jax.numpy as jnp
from jax import lax
import numpy as np


D_MODEL = 2048
BATCH = 1
SEQ = 16384
DEPTH = 1

GRID_W = 64
CTX_LEN = 256
EPS = 1e-6

GMLP_GROUPS = 8
GMLP_CH = D_MODEL // 2 // GMLP_GROUPS
D_A = GMLP_GROUPS * GMLP_CH
CHUNK = 128

DIFF_HEADS = 8
DIFF_QK = D_MODEL // 4 // DIFF_HEADS
DIFF_V = 2 * DIFF_QK
D_QK = DIFF_HEADS * 2 * DIFF_QK
D_V = DIFF_HEADS * DIFF_V
ROPE_BASE = 10000.0
Q_BLOCK = 128

D_MIX = D_A + D_V
D_IN = 2 * D_A + 2 * D_QK + D_V

PEER_HEADS = 8
N_KEYS = 128
N_EXPERTS = N_KEYS * N_KEYS
PEER_DK = 256
PEER_TOPK = 16
PEER_BLOCK = 128

kernel_name = 'hybrid_gmlp_diffattn_peer_dit_block'


def rms_norm(x, g):
    xf = x.astype(jnp.float32)
    y = xf * lax.rsqrt(jnp.mean(xf * xf, axis=-1, keepdims=True) + EPS)
    return (y * g.astype(jnp.float32)).astype(x.dtype)


def group_layer_norm(v, g):
    B, L, _ = v.shape
    vf = v.astype(jnp.float32).reshape(B, L, GMLP_GROUPS, GMLP_CH)
    mu = jnp.mean(vf, axis=-1, keepdims=True)
    d = vf - mu
    y = d * lax.rsqrt(jnp.mean(d * d, axis=-1, keepdims=True) + EPS)
    return (y.reshape(B, L, D_A) * g.astype(jnp.float32)).astype(v.dtype)


def modulate(h, shift, scale):
    return h * (1 + scale) + shift


def adaln(cond, w, b):
    mod = jax.nn.silu(cond) @ w + b
    return [m[:, None, :] for m in jnp.split(mod, 6, axis=-1)]


def axial_rope(t):
    n_tok = t.shape[1]
    n_rows = n_tok // GRID_W
    rows = jnp.repeat(jnp.arange(n_rows, dtype=jnp.float32), GRID_W)
    cols = jnp.tile(jnp.arange(GRID_W, dtype=jnp.float32), n_rows)
    n_freq = DIFF_QK // 4
    inv = ROPE_BASE ** (-jnp.arange(n_freq, dtype=jnp.float32) / n_freq)
    ang = jnp.concatenate([rows[:, None] * inv, cols[:, None] * inv], axis=-1)
    cos = jnp.cos(ang)[None, :, None, None, :]
    sin = jnp.sin(ang)[None, :, None, None, :]
    te = t[..., 0::2].astype(jnp.float32)
    to = t[..., 1::2].astype(jnp.float32)
    out = jnp.stack([te * cos - to * sin, te * sin + to * cos], axis=-1)
    return out.reshape(t.shape).astype(t.dtype)


def qk_heads(z, g):
    B, L, _ = z.shape
    return rms_norm(z.reshape(B, L, DIFF_HEADS, 2, DIFF_QK), g)


def mixer_inputs(h, w_in, q_g, k_g, use_rope):
    B, L, _ = h.shape
    z = h @ w_in
    u_a, v_a, q, k, v = jnp.split(z, [D_A, 2 * D_A, 2 * D_A + D_QK, 2 * D_A + 2 * D_QK], axis=-1)
    q = qk_heads(q, q_g)
    k = qk_heads(k, k_g)
    if use_rope:
        q = axial_rope(q)
        k = axial_rope(k)
    return u_a, v_a, q, k, v.reshape(B, L, DIFF_HEADS, DIFF_V)


def context_kv(hc, w_in, k_g):
    B, L, _ = hc.shape
    z = hc @ w_in[:, 2 * D_A + D_QK:]
    k, v = jnp.split(z, [D_QK], axis=-1)
    return qk_heads(k, k_g), v.reshape(B, L, DIFF_HEADS, DIFF_V)


def chunk_gmlp(u, v, ln_g, ws, bs):
    B, L, _ = u.shape
    u = jax.nn.gelu(u, approximate=False)
    v = group_layer_norm(jax.nn.gelu(v, approximate=False), ln_g)
    vc = v.reshape(B, L // CHUNK, CHUNK, GMLP_GROUPS, GMLP_CH)
    mixed = jnp.einsum('gpq,bnqgc->bnpgc', ws, vc) + bs.T[None, None, :, :, None]
    return u * mixed.reshape(B, L, D_A)


def diff_lambda(lq1, lk1, lq2, lk2, lam_init):
    f32 = jnp.float32
    return (jnp.exp(jnp.sum(lq1.astype(f32) * lk1.astype(f32)))
            - jnp.exp(jnp.sum(lq2.astype(f32) * lk2.astype(f32))) + lam_init)


def diff_attention(q, k, v, lam):
    B, Lq = q.shape[0], q.shape[1]
    n_blk = Lq // Q_BLOCK
    qb = jnp.moveaxis(q.reshape(B, n_blk, Q_BLOCK, DIFF_HEADS, 2, DIFF_QK), 1, 0)
    scale = DIFF_QK ** -0.5

    def block(q_blk):
        s = jnp.einsum('bqhcd,bkhcd->bhcqk', q_blk, k).astype(jnp.float32) * scale
        p = jax.nn.softmax(s, axis=-1)
        a = p[:, :, 0] - lam * p[:, :, 1]
        return jnp.einsum('bhqk,bkhd->bqhd', a.astype(v.dtype), v)

    out = lax.map(block, qb)
    return jnp.moveaxis(out, 0, 1).reshape(B, Lq, DIFF_HEADS, DIFF_V)


def merge_mixers(a_out, attn, subln_g, lam_init, w_out):
    B, L = a_out.shape[0], a_out.shape[1]
    attn = rms_norm(attn, subln_g) * (1.0 - lam_init)
    return jnp.concatenate([a_out, attn.reshape(B, L, D_V)], axis=-1) @ w_out


def peer_ffn(h, wq, keys, u_tab, v_tab):
    B, L, D = h.shape
    hb = h.reshape(B * L // PEER_BLOCK, PEER_BLOCK, D)

    def block(ht):
        q = (ht @ wq).reshape(PEER_BLOCK, PEER_HEADS, 2, PEER_DK // 2)
        s = jnp.einsum('thcd,hcnd->thcn', q, keys).astype(jnp.float32)
        s_a, i_a = lax.top_k(s[:, :, 0], PEER_TOPK)
        s_b, i_b = lax.top_k(s[:, :, 1], PEER_TOPK)
        cand_s = (s_a[..., :, None] + s_b[..., None, :]).reshape(PEER_BLOCK, PEER_HEADS, PEER_TOPK * PEER_TOPK)
        cand_i = (i_a[..., :, None] * N_KEYS + i_b[..., None, :]).reshape(PEER_BLOCK, PEER_HEADS, PEER_TOPK * PEER_TOPK)
        top_s, pos = lax.top_k(cand_s, PEER_TOPK)
        idx = jnp.take_along_axis(cand_i, pos, axis=-1)
        gate = jax.nn.softmax(top_s, axis=-1)
        u_e = jnp.take(u_tab, idx, axis=0)
        act = jax.nn.gelu(jnp.einsum('thkd,td->thk', u_e, ht).astype(jnp.float32), approximate=False)
        v_e = jnp.take(v_tab, idx, axis=0)
        return jnp.einsum('thk,thkd->td', (gate * act).astype(v_tab.dtype), v_e)

    return lax.map(block, hb).reshape(B, L, D)


def setup_inputs(seed: int = 0) -> dict:
    key = jax.random.key(seed)
    ks = jax.random.split(key, 26)
    f32 = jnp.float32

    def nrm(k, shape, scale):
        return jax.random.normal(k, shape, f32) * scale

    D = D_MODEL
    return {
        'x': nrm(ks[0], (BATCH, SEQ, D), 1.0),
        'c': nrm(ks[1], (BATCH, D), 1.0),
        'ctx': nrm(ks[2], (BATCH, CTX_LEN, D), 1.0),
        'c_ctx': nrm(ks[3], (D,), 1.0),
        'w_ada': nrm(ks[4], (DEPTH, D, 6 * D), D ** -0.5),
        'b_ada': nrm(ks[5], (DEPTH, 6 * D), 0.02),
        'norm1_g': 1.0 + nrm(ks[6], (DEPTH, D), 0.05),
        'norm2_g': 1.0 + nrm(ks[7], (DEPTH, D), 0.05),
        'w_in': nrm(ks[8], (DEPTH, D, D_IN), D ** -0.5),
        'gmlp_ln_g': 1.0 + nrm(ks[9], (DEPTH, D_A), 0.05),
        'gmlp_ws': nrm(ks[10], (DEPTH, GMLP_GROUPS, CHUNK, CHUNK), 0.5 * CHUNK ** -0.5),
        'gmlp_bs': 1.0 + nrm(ks[11], (DEPTH, GMLP_GROUPS, CHUNK), 0.1),
        'q_norm_g': 1.0 + nrm(ks[12], (DEPTH, DIFF_QK), 0.05),
        'k_norm_g': 1.0 + nrm(ks[13], (DEPTH, DIFF_QK), 0.05),
        'lambda_q1': nrm(ks[14], (DEPTH, DIFF_QK), 0.1),
        'lambda_k1': nrm(ks[15], (DEPTH, DIFF_QK), 0.1),
        'lambda_q2': nrm(ks[16], (DEPTH, DIFF_QK), 0.1),
        'lambda_k2': nrm(ks[17], (DEPTH, DIFF_QK), 0.1),
        'subln_g': 1.0 + nrm(ks[18], (DEPTH, DIFF_V), 0.05),
        'w_out': nrm(ks[19], (DEPTH, D_MIX, D), D_MIX ** -0.5),
        'peer_wq': nrm(ks[20], (DEPTH, D, PEER_HEADS * PEER_DK), D ** -0.5),
        'peer_keys': nrm(ks[21], (DEPTH, PEER_HEADS, 2, N_KEYS, PEER_DK // 2), (PEER_DK // 2) ** -0.5),
        'peer_u': nrm(ks[22], (DEPTH, N_EXPERTS, D), D ** -0.5),
        'peer_v': nrm(ks[23], (DEPTH, N_EXPERTS, D), 0.5),
    }


def reference(x, c, ctx, c_ctx, w_ada, b_ada, norm1_g, norm2_g, w_in, gmlp_ln_g, gmlp_ws, gmlp_bs,
              q_norm_g, k_norm_g, lambda_q1, lambda_k1, lambda_q2, lambda_k2, subln_g, w_out,
              peer_wq, peer_keys, peer_u, peer_v):
    for l in range(DEPTH):
        lam_init = 0.8 - 0.6 * math.exp(-0.3 * l)
        lam = diff_lambda(lambda_q1[l], lambda_k1[l], lambda_q2[l], lambda_k2[l], lam_init)
        sh1, sc1, g1, sh2, sc2, g2 = adaln(c, w_ada[l], b_ada[l])
        mods_c = adaln(c_ctx[None, :], w_ada[l], b_ada[l])

        hc = modulate(rms_norm(ctx, norm1_g[l]), mods_c[0], mods_c[1])
        if l < DEPTH - 1:
            u_c, va_c, q_c, k_c, v_c = mixer_inputs(hc, w_in[l], q_norm_g[l], k_norm_g[l], False)
        else:
            k_c, v_c = context_kv(hc, w_in[l], k_norm_g[l])

        h = modulate(rms_norm(x, norm1_g[l]), sh1, sc1)
        u_a, v_a, q, k, v = mixer_inputs(h, w_in[l], q_norm_g[l], k_norm_g[l], True)
        a_out = chunk_gmlp(u_a, v_a, gmlp_ln_g[l], gmlp_ws[l], gmlp_bs[l])
        attn = diff_attention(q, jnp.concatenate([k_c, k], axis=1), jnp.concatenate([v_c, v], axis=1), lam)
        x_new = x + g1 * merge_mixers(a_out, attn, subln_g[l], lam_init, w_out[l])

        h2 = modulate(rms_norm(x_new, norm2_g[l]), sh2, sc2)
        x_new = x_new + g2 * peer_ffn(h2, peer_wq[l], peer_keys[l], peer_u[l], peer_v[l])

        if l < DEPTH - 1:
            a_c = chunk_gmlp(u_c, va_c, gmlp_ln_g[l], gmlp_ws[l], gmlp_bs[l])
            attn_c = diff_attention(q_c, k_c, v_c, lam)
            ctx = ctx + mods_c[2] * merge_mixers(a_c, attn_c, subln_g[l], lam_init, w_out[l])
            hc2 = modulate(rms_norm(ctx, norm2_g[l]), mods_c[3], mods_c[4])
            ctx = ctx + mods_c[5] * peer_ffn(hc2, peer_wq[l], peer_keys[l], peer_u[l], peer_v[l])
        x = x_new
    return x
```

```cpp
#include <hip/hip_runtime.h>
#include <hip/hip_cooperative_groups.h>
#include <cstdint>
#include <cstdio>
#include <cmath>

typedef unsigned short bf16_t;
typedef short bf16x8 __attribute__((ext_vector_type(8)));
typedef float f32x4 __attribute__((ext_vector_type(4)));
typedef float f32x16 __attribute__((ext_vector_type(16)));
typedef unsigned u32x4 __attribute__((ext_vector_type(4)));
typedef unsigned u32x2 __attribute__((ext_vector_type(2)));

constexpr int DM = 2048, SEQ = 16384, CTX = 256, LT = SEQ + CTX;
constexpr int D_A = 1024, D_QK = 1024, D_V = 1024, D_IN = 5120;
constexpr int NH = 8, DQK = 64, DV = 128;
constexpr int NTILE = LT / 64;
constexpr int PEER_H = 8, NKEYS = 128, TOPK = 16;
constexpr float EPS = 1e-6f;
constexpr float LAM_INIT = 0.2f;
constexpr float LOG2E = 1.4426950408889634f;
constexpr float QSCALE = 0.125f * LOG2E;

constexpr size_t MiB = 1u << 20;
constexpr size_t WS_CTL = 0;
constexpr size_t WS_MODS = 1 * MiB;
constexpr size_t WS_WIN_T = 2 * MiB;
constexpr size_t WS_WOUT_T = 22 * MiB;
constexpr size_t WS_WQ_T = 30 * MiB;
constexpr size_t WS_KEYS = 38 * MiB;
constexpr size_t WS_GWS = 38 * MiB + 512 * 1024;
constexpr size_t WS_UT = 39 * MiB;
constexpr size_t WS_VT = 103 * MiB;
constexpr size_t WS_R1 = 167 * MiB;
constexpr size_t WS_R2 = 232 * MiB;
constexpr size_t WS_R3 = 296 * MiB;
constexpr size_t WS_R4 = 394 * MiB;
constexpr size_t WS_R5 = 491 * MiB;
constexpr size_t WS_END = 507 * MiB;

struct Params {
    const float *x, *c, *ctx, *c_ctx, *w_ada, *b_ada, *norm1_g, *norm2_g, *w_in, *gmlp_ln_g, *gmlp_ws, *gmlp_bs, *q_norm_g, *k_norm_g,
        *lq1, *lk1, *lq2, *lk2, *subln_g, *w_out, *peer_wq, *peer_keys, *peer_u, *peer_v;
    float* out;
    unsigned char* ws;
};
#define P_MODS(p) ((float*)((p).ws + WS_MODS))
#define P_MODSC(p) ((float*)((p).ws + WS_MODS) + 12288)
#define P_SCAL(p) ((float*)((p).ws + WS_MODS) + 16384)
#define P_G2V(p) ((float*)((p).ws + WS_MODS + 196608))
#define P_S2V(p) ((float*)((p).ws + WS_MODS + 204800))
#define P_BQ(p) ((float*)((p).ws + WS_MODS + 212992))
#define P_RSS(p) ((float*)((p).ws + WS_R2))
#define P_ROPE(p) ((float*)((p).ws + WS_MODS + 131072))
#define P_HB(p) ((bf16_t*)((p).ws + WS_R1))
#define P_HB8(p) ((unsigned char*)((p).ws + WS_R3))
#define P_A2(p) ((bf16_t*)((p).ws + WS_R1))
#define P_UG(p) ((bf16_t*)((p).ws + WS_R2))
#define P_VG(p) ((bf16_t*)((p).ws + WS_R2 + 32 * MiB))
#define P_XB(p) ((bf16_t*)((p).ws + WS_R2))
#define P_QKV(p) ((bf16_t*)((p).ws + WS_R3))
#define P_QP(p) ((bf16_t*)((p).ws + WS_R3))
#define P_QS(p) ((bf16_t*)((p).ws + WS_R4))
#define P_KIMG(p) ((bf16_t*)((p).ws + WS_R4 + 32 * MiB))
#define P_QS8(p) ((unsigned char*)((p).ws + WS_R4))
#define P_KIMG8(p) ((unsigned char*)((p).ws + WS_R4 + 32 * MiB))
#define P_VIMG8(p) ((unsigned char*)((p).ws + WS_R4 + 32 * MiB + 33 * MiB))
#define P_VIMG(p) ((bf16_t*)((p).ws + WS_R4 + 32 * MiB + 33 * MiB))
#define P_XN(p) ((bf16_t*)((p).ws + WS_R4))
#define P_IDX(p) ((int*)((p).ws + WS_R5))
#define P_GATE(p) ((float*)((p).ws + WS_R5 + 8 * MiB))

__device__ __forceinline__ float bf2f(bf16_t b) { return __uint_as_float((unsigned)b << 16); }
__device__ __forceinline__ unsigned f2bf(float f) { unsigned u = __float_as_uint(f); return (u + 0x7fffu + ((u >> 16) & 1u)) >> 16; }
__device__ __forceinline__ unsigned pk2(float lo, float hi) { return f2bf(lo) | (f2bf(hi) << 16); }
__device__ __forceinline__ float wave_sum(float v) {
#pragma unroll
    for (int o = 1; o < 64; o <<= 1) v += __shfl_xor(v, o);
    return v;
}
__device__ __forceinline__ float gelu_erf(float v) { return 0.5f * v * (1.0f + erff(v * 0.70710678118654752f)); }
__device__ __forceinline__ int k8_off(int key, int colbyte) { const int c_ = colbyte >> 6, d_ = colbyte & 63; return c_ * 4096 + key * 64 + ((((d_ >> 4) ^ ((key >> 2) & 3)) << 4) | (d_ & 15)); }
__device__ __forceinline__ int v8_off(int k, int c) { const int p_ = (((k >> 2) & 1) << 5) | ((k >> 5) << 4) | (((k >> 3) & 3) << 2) | (k & 3); return c * 64 + ((((p_ >> 4) ^ ((c >> 2) & 3)) << 4) | (p_ & 15)); }
__device__ __forceinline__ int k_img_off(int key, int colbyte) { return key * 256 + (colbyte ^ ((key & 15) << 4)); }
__device__ __forceinline__ int v_img_off(int k, int c) { const int kk = (k & ~0xC) | ((k & 4) << 1) | ((k & 8) >> 1); return ((kk >> 3) * 4 + (c >> 5)) * 512 + ((kk & 7) * 32 + (c & 31)) * 2; }

__device__ __forceinline__ void p0_adaln(const Params& p, float* lds, int b, int nb) {
    const int tid = threadIdx.x, lane = tid & 63, wave = tid >> 6;
    float* sc = lds; float* scc = lds + 2048; float* red = lds + 4096;
    for (int k = tid; k < 2048; k += 512) { float v = p.c[k]; sc[k] = v / (1.0f + expf(-v)); v = p.c_ctx[k]; scc[k] = v / (1.0f + expf(-v)); }
    __syncthreads();
    float* mods = P_MODS(p); float* modsc = P_MODSC(p);
    for (int item = b; item < 192; item += nb) {
        const int col = item * 64 + lane;
        const float* w = p.w_ada + col;
        float a0 = 0.f, a1 = 0.f;
        const int k0 = wave * 256;
#pragma unroll 8
        for (int k = 0; k < 256; ++k) { const float wv = w[(size_t)(k0 + k) * 12288]; a0 += sc[k0 + k] * wv; a1 += scc[k0 + k] * wv; }
        red[(wave * 2 + 0) * 64 + lane] = a0; red[(wave * 2 + 1) * 64 + lane] = a1;
        __syncthreads();
        if (wave == 0) {
            float s0 = 0.f, s1 = 0.f;
#pragma unroll
            for (int w8 = 0; w8 < 8; ++w8) { s0 += red[(w8 * 2 + 0) * 64 + lane]; s1 += red[(w8 * 2 + 1) * 64 + lane]; }
            const float bb = p.b_ada[col];
            mods[col] = s0 + bb; if (col < 4096) modsc[col] = s1 + bb;
        }
        __syncthreads();
    }
    if (b == 0 && wave == 0) {
        float d1 = wave_sum(p.lq1[lane] * p.lk1[lane]), d2 = wave_sum(p.lq2[lane] * p.lk2[lane]);
        float gq = fabsf(p.q_norm_g[lane]), gk = fabsf(p.k_norm_g[lane]);
#pragma unroll
        for (int o = 1; o < 64; o <<= 1) { gq = fmaxf(gq, __shfl_xor(gq, o)); gk = fmaxf(gk, __shfl_xor(gk, o)); }
        if (lane == 0) { float* s = P_SCAL(p); s[0] = expf(d1) - expf(d2) + LAM_INIT; s[1] = 8.0f * gq * gk * LOG2E * 1.0001f + 0.01f; }
    }
}
__device__ __forceinline__ void cvt_range(const float* __restrict__ src, bf16_t* __restrict__ dst, size_t n8, size_t gtid, size_t gthreads) {
    for (size_t i = gtid; i < n8; i += gthreads) {
        const f32x4 a = *(const f32x4*)(src + i * 8), b = *(const f32x4*)(src + i * 8 + 4);
        u32x4 o; o.x = pk2(a.x, a.y); o.y = pk2(a.z, a.w); o.z = pk2(b.x, b.y); o.w = pk2(b.z, b.w);
        *(u32x4*)(dst + i * 8) = o;
    }
}
#ifndef FP6_INTERLEAVED
#define FP6_INTERLEAVED 1
#endif
constexpr float U6_SCALE = 72.0f, V6_SCALE = 3.2f, H6_SCALE = 1.0f;
typedef unsigned u32x6 __attribute__((ext_vector_type(6)));
typedef _Float16 h16x2 __attribute__((ext_vector_type(2)));
typedef _Float16 h16x32 __attribute__((ext_vector_type(32)));
__device__ __forceinline__ unsigned pk4_fp8(f32x4 a, float sc) {
    int w = 0; w = __builtin_amdgcn_cvt_pk_fp8_f32(a.x * sc, a.y * sc, w, false); w = __builtin_amdgcn_cvt_pk_fp8_f32(a.z * sc, a.w * sc, w, true); return (unsigned)w;
}
__device__ __forceinline__ void cvt_range_fp8(const float* __restrict__ src, unsigned char* __restrict__ dst, size_t n16, float sc, size_t gtid, size_t gthreads) {
    for (size_t i = gtid; i < n16; i += gthreads) {
        const f32x4 a = *(const f32x4*)(src + i * 16), b = *(const f32x4*)(src + i * 16 + 4), c = *(const f32x4*)(src + i * 16 + 8), d = *(const f32x4*)(src + i * 16 + 12);
        u32x4 o; o.x = pk4_fp8(a, sc); o.y = pk4_fp8(b, sc); o.z = pk4_fp8(c, sc); o.w = pk4_fp8(d, sc);
        *(u32x4*)(dst + i * 16) = o;
    }
}
__device__ __forceinline__ void transpose_item(const float* W, int K, int N, bf16_t* WT, float* scr, int item, int lane, const float* kscale = nullptr) {
    const int nblk = N / 32, kb = item / nblk, nbk = item % nblk, k0 = 64 * kb, n0 = 32 * nbk;
#pragma unroll 8
    for (int i = 0; i < 32; ++i) { const int kk = 2 * i + (lane >> 5); const float w_ = W[(size_t)(k0 + kk) * N + n0 + (lane & 31)]; scr[kk * 33 + (lane & 31)] = kscale ? w_ * kscale[k0 + kk] : w_; }
    __builtin_amdgcn_s_waitcnt(0xC07F); __builtin_amdgcn_wave_barrier();
    const int c8 = lane & 7;
#pragma unroll
    for (int j = 0; j < 4; ++j) { const int n = (lane >> 3) + 8 * j; const float* s = scr + (8 * c8) * 33 + n;
        u32x4 o; o.x = pk2(s[0 * 33], s[1 * 33]); o.y = pk2(s[2 * 33], s[3 * 33]); o.z = pk2(s[4 * 33], s[5 * 33]); o.w = pk2(s[6 * 33], s[7 * 33]);
        *(u32x4*)(WT + (size_t)(n0 + n) * K + k0 + 8 * c8) = o; }
    __builtin_amdgcn_s_waitcnt(0xC07F); __builtin_amdgcn_wave_barrier();
}
constexpr float W8_SCALE = 64.0f;
__device__ __forceinline__ void transpose_item8(const float* W, int K, int N, unsigned char* WT, float* scr, int item, int lane, float sc) {
    const int nblk = N / 32, kb = item / nblk, nbk = item % nblk, k0 = 64 * kb, n0 = 32 * nbk;
#pragma unroll 8
    for (int i = 0; i < 32; ++i) { const int kk = 2 * i + (lane >> 5); scr[kk * 33 + (lane & 31)] = W[(size_t)(k0 + kk) * N + n0 + (lane & 31)]; }
    __builtin_amdgcn_s_waitcnt(0xC07F); __builtin_amdgcn_wave_barrier();
    const int c8 = lane & 7;
#pragma unroll
    for (int j = 0; j < 4; ++j) { const int n = (lane >> 3) + 8 * j; const float* s = scr + (8 * c8) * 33 + n;
        u32x2 o; o.x = pk4_fp8((f32x4){s[0 * 33], s[1 * 33], s[2 * 33], s[3 * 33]}, sc); o.y = pk4_fp8((f32x4){s[4 * 33], s[5 * 33], s[6 * 33], s[7 * 33]}, sc);
        *(u32x2*)(WT + (size_t)(n0 + n) * K + k0 + 8 * c8) = o; }
    __builtin_amdgcn_s_waitcnt(0xC07F); __builtin_amdgcn_wave_barrier();
}
__device__ __forceinline__ void norm_row_dual(const float* xrow, const float* g, const float* sh, const float* sc, bf16_t* orow, unsigned char* orow8, int lane) {
    f32x4 v[8]; float ss = 0.f;
#pragma unroll
    for (int j = 0; j < 8; ++j) { v[j] = *(const f32x4*)(xrow + j * 256 + lane * 4); ss += (v[j].x * v[j].x + v[j].y * v[j].y) + (v[j].z * v[j].z + v[j].w * v[j].w); }
    ss = wave_sum(ss);
    const float r = 1.0f / sqrtf(ss * (1.0f / 2048.0f) + EPS);
#pragma unroll
    for (int j = 0; j < 8; ++j) {
        const int o = j * 256 + lane * 4;
        const f32x4 gg = *(const f32x4*)(g + o), s4 = *(const f32x4*)(sh + o), c4 = *(const f32x4*)(sc + o);
        const f32x4 y = (v[j] * r * gg) * (1.0f + c4) + s4;
        u32x2 w; w.x = pk2(y.x, y.y); w.y = pk2(y.z, y.w);
        *(u32x2*)(orow + o) = w;
        *(unsigned*)(orow8 + o) = pk4_fp8(y, 1.0f);
    }
}

namespace pg8 {
#define PG8_LAS __attribute__((address_space(3)))
typedef unsigned short bf16_t;
typedef short bf16x8 __attribute__((ext_vector_type(8)));
typedef float f32x4 __attribute__((ext_vector_type(4)));
typedef unsigned u32x4 __attribute__((ext_vector_type(4)));
constexpr int BM = 256, BK = 64, HALF = 128, HTB = HALF * BK * 2  , STAGE_BYTES = 8 * HTB, NXCD = 8, WGM = 8;

__host__ __device__ __forceinline__ int lds_byte(int r, int c) { const int st = (r >> 4) * 2 + (c >> 5), rr = r & 15, cc = c & 31, ob = rr * 64 + cc * 2; return st * 1024 + (ob ^ (((ob >> 9) & 1) << 5)); }
__host__ __device__ __forceinline__ void stage_rc(int b, int& R, int& C) { const int st = b / 1024, sb = b % 1024, swz = sb ^ (((sb >> 9) & 1) << 5); R = (st >> 1) * 16 + swz / 64; C = (st & 1) * 32 + (swz % 64) / 2; }
__host__ __device__ __forceinline__ int perm32(int rho) { const int n = rho >> 4, i = rho & 15; return 8 * (i >> 2) + 4 * n + (i & 3); }

struct Unit { int pm, pn; };
struct Gemm { const bf16_t* A; const bf16_t* Bt; int M, N, K; };

struct StaticOrder {
    int nM, nN, nwg, G, c;
    __host__ __device__ void init(int M, int N, int G_, int c_) { nM = M / BM; nN = N / BM; nwg = nM * nN; G = G_; c = c_; }
    __host__ __device__ bool next(int i, Unit& u) const {
        const long L = (long)i * G + c; if (L >= nwg) return false;
        int wgid = (int)L; { const int q = nwg / NXCD, r = nwg % NXCD, xcd = wgid % NXCD, off = wgid / NXCD; wgid = (xcd < r ? xcd * (q + 1) : r * (q + 1) + (xcd - r) * q) + off; }
        const int nig = WGM * nN, gid = wgid / nig, fm = gid * WGM, gsz = (nM - fm) < WGM ? (nM - fm) : WGM;
        u.pm = fm + ((wgid % nig) % gsz); u.pn = (wgid % nig) / gsz; return true;
    }
    __device__ __forceinline__ void a_ready(const Unit&) const {}
    __device__ __forceinline__ void done(const Unit&) const {}
};

__device__ __forceinline__ unsigned cvt_pk_bf16(float lo, float hi) { unsigned r; asm volatile("v_cvt_pk_bf16_f32 %0, %1, %2" : "=v"(r) : "v"(lo), "v"(hi)); return r; }
typedef float f32x2 __attribute__((ext_vector_type(2)));
__device__ __forceinline__ f32x2 gelu_pk(f32x2 v) {
    const f32x2 av = __builtin_elementwise_abs(v), d = av * 0.2316418882f + 1.0f;
    f32x2 t; t.x = __builtin_amdgcn_rcpf(d.x); t.y = __builtin_amdgcn_rcpf(d.y);
    f32x2 q = t * 0.5307027145f + (-0.7265760135f); q = q * t + 0.7107068705f; q = q * t + (-0.142248368f); q = q * t + 0.127414796f; q = q * t;
    const f32x2 s = (v * v) * (-0.72134752044f);
    f32x2 e; e.x = __builtin_amdgcn_exp2f(s.x); e.y = __builtin_amdgcn_exp2f(s.y);
    const f32x2 m = v * (q * e), r = v - m;
    f32x2 o; o.x = v.x < 0.f ? m.x : r.x; o.y = v.y < 0.f ? m.y : r.y; return o;
}

template <int ACT  > struct EpiBf16 {
    static constexpr bool PERM = true, AFTER_DRAIN = false; static_assert(ACT == 0 || ACT == 1, "EpiBf16: ACT is 0 (none) or 1 (gelu_pk)");
    bf16_t* O; int ldc; const float* bias; int split_cols; size_t split_stride; float scale0;
    __device__ __forceinline__ void operator()(const f32x4 (&acc)[2][2][4][2], const Unit& u, int wr, int wc, int fr, int fq) const {
        const int row0 = u.pm * BM + wr * 64 + fr; int colt = u.pn * BM; bf16_t* base = O;
        float sc = 1.f; if (split_cols) { const int t = colt / split_cols; base += (size_t)t * split_stride; colt -= t * split_cols; if (t == 0) sc = scale0; }
        const int col0 = colt + wc * 32 + 8 * fq, bcol0 = u.pn * BM + wc * 32 + 8 * fq;
        f32x4 bv[2][2];
#pragma unroll
        for (int bj = 0; bj < 2; ++bj)
#pragma unroll
            for (int n = 0; n < 2; ++n) bv[bj][n] = bias ? *(const f32x4*)(bias + bcol0 + bj * HALF + 4 * n) : (f32x4){0.f, 0.f, 0.f, 0.f};
#pragma unroll
        for (int ai = 0; ai < 2; ++ai)
#pragma unroll
            for (int m = 0; m < 4; ++m) { bf16_t* rowp = base + (size_t)(row0 + ai * HALF + m * 16) * ldc + col0;
#pragma unroll
                for (int bj = 0; bj < 2; ++bj) { f32x4 v0 = acc[ai][bj][m][0] + bv[bj][0], v1 = acc[ai][bj][m][1] + bv[bj][1];
                    if (ACT == 1) { f32x2 a = gelu_pk((f32x2){v0[0], v0[1]}), b = gelu_pk((f32x2){v0[2], v0[3]}), c = gelu_pk((f32x2){v1[0], v1[1]}), d = gelu_pk((f32x2){v1[2], v1[3]});
                        v0 = (f32x4){a.x, a.y, b.x, b.y}; v1 = (f32x4){c.x, c.y, d.x, d.y}; }
                    v0 = v0 * sc; v1 = v1 * sc; u32x4 w; w.x = cvt_pk_bf16(v0[0], v0[1]); w.y = cvt_pk_bf16(v0[2], v0[3]); w.z = cvt_pk_bf16(v1[0], v1[1]); w.w = cvt_pk_bf16(v1[2], v1[3]);
                    *(u32x4*)(rowp + bj * HALF) = w; } }
    }
};

struct EpiG1m {
    static constexpr bool PERM = true, AFTER_DRAIN = false;
    bf16_t *ug, *vg; unsigned char *qs, *kimg, *vimg; const float *qg, *kg, *rope; PG8_LAS float* xs; int pm_off, pn_off; float wi;
    __device__ __forceinline__ void operator()(const f32x4 (&acc)[2][2][4][2], const Unit& u_, int wr, int wc_, int fr_, int fq_) const {
        const Unit u{u_.pm + pm_off, u_.pn + pn_off}; const float WI = wi;
        int wc = wc_, fr = fr_, fq = fq_;
        asm volatile("" : "+s"(wc), "+v"(fr), "+v"(fq));
        const int colt = u.pn * BM;
        if (colt < 2048) {
            if (u.pm == 0) return;
            bf16_t* base = (colt < 1024) ? ug : vg; const int cbase = colt & 1023;
            const int row0 = u.pm * BM + wr * 64 + fr - 256, col0 = cbase + wc * 32 + 8 * fq;
#pragma unroll
            for (int ai = 0; ai < 2; ++ai)
#pragma unroll
                for (int m = 0; m < 4; ++m) { bf16_t* rowp = base + (size_t)(row0 + ai * HALF + m * 16) * 1024 + col0;
#pragma unroll
                    for (int bj = 0; bj < 2; ++bj) { const f32x4 v0 = acc[ai][bj][m][0], v1 = acc[ai][bj][m][1];
                        const f32x2 a = gelu_pk((f32x2){v0[0], v0[1]}), b = gelu_pk((f32x2){v0[2], v0[3]}), c = gelu_pk((f32x2){v1[0], v1[1]}), d = gelu_pk((f32x2){v1[2], v1[3]});
                        u32x4 w; w.x = cvt_pk_bf16(a.x, a.y); w.y = cvt_pk_bf16(b.x, b.y); w.z = cvt_pk_bf16(c.x, c.y); w.w = cvt_pk_bf16(d.x, d.y);
                        *(u32x4*)(rowp + bj * HALF) = w; } }
        } else if (colt < 4096) {
            const bool isq = colt < 3072;
            if (isq && u.pm == 0) return;
            const bool latent = u.pm != 0;
            const int head0 = (colt - (isq ? 2048 : 3072)) >> 7, comp = wc >> 1, cin = 32 * (wc & 1) + 8 * fq;
            const float* gn = (isq ? qg : kg) + cin;
            const f32x4 g0 = *(const f32x4*)gn, g1 = *(const f32x4*)(gn + 4);
#pragma unroll
            for (int ai = 0; ai < 2; ++ai)
#pragma unroll
                for (int m = 0; m < 4; ++m)
#pragma unroll
                    for (int bj = 0; bj < 2; ++bj) { const f32x4 v0 = acc[ai][bj][m][0], v1 = acc[ai][bj][m][1];
                        float s_ = ((v0[0] * v0[0] + v0[1] * v0[1]) + (v0[2] * v0[2] + v0[3] * v0[3])) + ((v1[0] * v1[0] + v1[1] * v1[1]) + (v1[2] * v1[2] + v1[3] * v1[3]));
                        s_ += __shfl_xor(s_, 16); s_ += __shfl_xor(s_, 32);
                        if (fq == 0) xs[((ai * HALF + wr * 64 + m * 16 + fr) * 2 + bj) * 4 + wc] = s_; }
            asm volatile("s_waitcnt lgkmcnt(0)" ::: "memory"); __builtin_amdgcn_s_barrier(); asm volatile("" ::: "memory");
            const float mul = isq ? QSCALE : 1.0f;
#pragma unroll
            for (int ai = 0; ai < 2; ++ai)
#pragma unroll
                for (int m = 0; m < 4; ++m) { const int rl = ai * HALF + wr * 64 + m * 16 + fr, row = u.pm * BM + rl, pos = row - CTX;
                    const int tp = (wc & 1) ? 256 + (pos & 63) : (pos >> 6);
                    const float* tb = rope + ((size_t)(latent ? tp : 0) * 16 + 4 * fq) * 2;
                    f32x4 t0 = *(const f32x4*)tb, t1 = *(const f32x4*)(tb + 4);
                    if (!latent) { t0 = (f32x4){1.f, 0.f, 1.f, 0.f}; t1 = t0; }
#pragma unroll
                    for (int bj = 0; bj < 2; ++bj) { const float tot = xs[(rl * 2 + bj) * 4 + wc] + xs[(rl * 2 + bj) * 4 + (wc ^ 1)];
                        const float r_ = WI / sqrtf(tot * (WI * WI / 64.0f) + EPS);
                        const f32x4 a0 = acc[ai][bj][m][0] * r_ * g0, a1 = acc[ai][bj][m][1] * r_ * g1;
                        const float e0 = (a0[0] * t0[0] - a0[1] * t0[1]) * mul, o0 = (a0[0] * t0[1] + a0[1] * t0[0]) * mul, e1 = (a0[2] * t0[2] - a0[3] * t0[3]) * mul, o1 = (a0[2] * t0[3] + a0[3] * t0[2]) * mul;
                        const float e2 = (a1[0] * t1[0] - a1[1] * t1[1]) * mul, o2 = (a1[0] * t1[1] + a1[1] * t1[0]) * mul, e3 = (a1[2] * t1[2] - a1[3] * t1[3]) * mul, o3 = (a1[2] * t1[3] + a1[3] * t1[2]) * mul;
                        int w0 = __builtin_amdgcn_cvt_pk_fp8_f32(e0, o0, 0, false); w0 = __builtin_amdgcn_cvt_pk_fp8_f32(e1, o1, w0, true);
                        int w1 = __builtin_amdgcn_cvt_pk_fp8_f32(e2, o2, 0, false); w1 = __builtin_amdgcn_cvt_pk_fp8_f32(e3, o3, w1, true);
                        const u32x2 w = {(unsigned)w0, (unsigned)w1};
                        const int head = head0 + bj;
                        if (isq) *(u32x2*)(qs + ((size_t)head * SEQ + pos) * 128 + comp * 64 + cin) = w;
                        else *(u32x2*)(kimg + ((size_t)head * NTILE + (row >> 6)) * 8192 + k8_off(row & 63, comp * 64 + cin)) = w; }
                    asm volatile("" ::: "memory"); }
        } else {
            const int row0 = u.pm * BM + wr * 64 + fr, c0 = wc * 32 + 8 * fq, head0 = (colt - 4096) >> 7;
#pragma unroll
            for (int ai = 0; ai < 2; ++ai)
#pragma unroll
                for (int m = 0; m < 4; ++m) { const int row = row0 + ai * HALF + m * 16;
#pragma unroll
                    for (int bj = 0; bj < 2; ++bj) { const f32x4 v0 = acc[ai][bj][m][0], v1 = acc[ai][bj][m][1];
                        int w0 = __builtin_amdgcn_cvt_pk_fp8_f32(v0[0] * WI, v0[1] * WI, 0, false); w0 = __builtin_amdgcn_cvt_pk_fp8_f32(v0[2] * WI, v0[3] * WI, w0, true);
                        int w1 = __builtin_amdgcn_cvt_pk_fp8_f32(v1[0] * WI, v1[1] * WI, 0, false); w1 = __builtin_amdgcn_cvt_pk_fp8_f32(v1[2] * WI, v1[3] * WI, w1, true);
                        unsigned char* ib = vimg + ((size_t)(head0 + bj) * NTILE + (row >> 6)) * 8192;
#pragma unroll
                        for (int i = 0; i < 4; ++i) { ib[v8_off(row & 63, c0 + i)] = (unsigned char)((unsigned)w0 >> (8 * i)); ib[v8_off(row & 63, c0 + 4 + i)] = (unsigned char)((unsigned)w1 >> (8 * i)); } } }
        }
    }
};
struct EpiOutm {
    static constexpr bool PERM = true, AFTER_DRAIN = false;
    const float* x; const float* g1; bf16_t* xn; float* rss;
    __device__ __forceinline__ void operator()(const f32x4 (&acc)[2][2][4][2], const Unit& u, int wr, int wc, int fr, int fq) const {
        const int row0 = u.pm * BM + wr * 64 + fr, col0 = u.pn * BM + wc * 32 + 8 * fq;
        f32x4 gv[2][2];
#pragma unroll
        for (int bj = 0; bj < 2; ++bj)
#pragma unroll
            for (int n = 0; n < 2; ++n) gv[bj][n] = *(const f32x4*)(g1 + col0 + bj * HALF + 4 * n);
#pragma unroll
        for (int ai = 0; ai < 2; ++ai)
#pragma unroll
            for (int m = 0; m < 4; ++m) { const int row = row0 + ai * HALF + m * 16; const size_t off = (size_t)row * 2048 + col0; float ss = 0.f;
#pragma unroll
                for (int bj = 0; bj < 2; ++bj) {
                    const f32x4 v0 = *(const f32x4*)(x + off + bj * HALF) + gv[bj][0] * acc[ai][bj][m][0], v1 = *(const f32x4*)(x + off + bj * HALF + 4) + gv[bj][1] * acc[ai][bj][m][1];
                    ss += ((v0[0] * v0[0] + v0[1] * v0[1]) + (v0[2] * v0[2] + v0[3] * v0[3])) + ((v1[0] * v1[0] + v1[1] * v1[1]) + (v1[2] * v1[2] + v1[3] * v1[3]));
                    u32x4 w; w.x = cvt_pk_bf16(v0[0], v0[1]); w.y = cvt_pk_bf16(v0[2], v0[3]); w.z = cvt_pk_bf16(v1[0], v1[1]); w.w = cvt_pk_bf16(v1[2], v1[3]);
                    *(u32x4*)(xn + off + bj * HALF) = w; }
                ss += __shfl_xor(ss, 16); ss += __shfl_xor(ss, 32);
                if (fq == 0) rss[(size_t)row * 32 + u.pn * 4 + wc] = ss; }
    }
};
struct EpiQp {
    static constexpr bool PERM = true, AFTER_DRAIN = false;
    bf16_t* q; const float* rss; const float* bq;
    __device__ __forceinline__ void operator()(const f32x4 (&acc)[2][2][4][2], const Unit& u, int wr, int wc, int fr, int fq) const {
        const int row0 = u.pm * BM + wr * 64 + fr, col0 = u.pn * BM + wc * 32 + 8 * fq;
        f32x4 bv[2][2];
#pragma unroll
        for (int bj = 0; bj < 2; ++bj)
#pragma unroll
            for (int n = 0; n < 2; ++n) bv[bj][n] = *(const f32x4*)(bq + col0 + bj * HALF + 4 * n);
#pragma unroll
        for (int ai = 0; ai < 2; ++ai)
#pragma unroll
            for (int m = 0; m < 4; ++m) { const int row = row0 + ai * HALF + m * 16;
                const f32x4 p0 = *(const f32x4*)(rss + (size_t)row * 32 + fq * 8), p1 = *(const f32x4*)(rss + (size_t)row * 32 + fq * 8 + 4);
                float ss = ((p0[0] + p0[1]) + (p0[2] + p0[3])) + ((p1[0] + p1[1]) + (p1[2] + p1[3]));
                ss += __shfl_xor(ss, 16); ss += __shfl_xor(ss, 32);
                const float r_ = 1.0f / sqrtf(ss * (1.0f / 2048.0f) + EPS);
                bf16_t* rowp = q + (size_t)row * 2048 + col0;
#pragma unroll
                for (int bj = 0; bj < 2; ++bj) { const f32x4 v0 = acc[ai][bj][m][0] * r_ + bv[bj][0], v1 = acc[ai][bj][m][1] * r_ + bv[bj][1];
                    u32x4 w; w.x = cvt_pk_bf16(v0[0], v0[1]); w.y = cvt_pk_bf16(v0[2], v0[3]); w.z = cvt_pk_bf16(v1[0], v1[1]); w.w = cvt_pk_bf16(v1[2], v1[3]);
                    *(u32x4*)(rowp + bj * HALF) = w; } }
    }
};
typedef int pg8_i32x4 __attribute__((ext_vector_type(4)));
template <class Epi, class Sched, bool ALIGN_EPI = false, bool SP2 = false, bool FP8 = false>
__device__ __forceinline__ void gemm_phase(PG8_LAS unsigned char* lds, const Gemm g, const Sched& S, const Epi& E) {
    const int tid = threadIdx.x, wid = __builtin_amdgcn_readfirstlane(tid >> 6), lane = tid & 63, wr = wid >> 2, wc = wid & 3, fr = lane & 15, fq = lane >> 4;
    const int K = g.K, nt = K / BK;
    unsigned voffA[2], voffB[2];
#pragma unroll
    for (int i = 0; i < 2; ++i) { int R, C; stage_rc(tid * 16 + i * 8192, R, C); const int Rb = Epi::PERM ? ((R & ~31) + perm32(R & 31)) : R;
        voffA[i] = (unsigned)(R * K + C) * 2u; voffB[i] = (unsigned)(Rb * K + C) * 2u; }
    const size_t kstep = (size_t)(BK * 2);
    const size_t hstep = (size_t)HALF * K * 2;
    const size_t tstep = 2 * hstep;
    const unsigned ldsw = (unsigned)wid * 1024u;
    const int aoff = lds_byte(wr * 64 + fr, fq * 8), boff = lds_byte(wc * 32 + fr, fq * 8);
#define PG8_SA(b, h) (((b) * 2 + (h)) * HTB)
#define PG8_SB(b, h) ((4 + (b) * 2 + (h)) * HTB)
#define PG8_STAGE(bufoff, gbase, voff) do { _Pragma("unroll") for (int _i = 0; _i < 2; ++_i) \
        __builtin_amdgcn_global_load_lds((const unsigned*)((const char*)(gbase) + (voff)[_i]), (PG8_LAS unsigned*)(lds + (bufoff) + ldsw + _i * 8192), 16, 0, 0); } while (0)
#define PG8_LDA(dst, b, h) do { _Pragma("unroll") for (int m = 0; m < 4; ++m) _Pragma("unroll") for (int k = 0; k < 2; ++k) dst[m][k] = *(const PG8_LAS bf16x8*)(lds + PG8_SA(b, h) + aoff + m * 2048 + k * 1024); } while (0)
#define PG8_LDB(dst, b, h) do { _Pragma("unroll") for (int n = 0; n < 2; ++n) _Pragma("unroll") for (int k = 0; k < 2; ++k) dst[n][k] = *(const PG8_LAS bf16x8*)(lds + PG8_SB(b, h) + boff + n * 2048 + k * 1024); } while (0)
#define PG8_CAT(X) __builtin_shufflevector(__builtin_bit_cast(pg8_i32x4, X[0]), __builtin_bit_cast(pg8_i32x4, X[1]), 0, 1, 2, 3, 4, 5, 6, 7)
#define PG8_MMA(ai, bj, At, Bt) do { __builtin_amdgcn_s_setprio(1); _Pragma("unroll") for (int m = 0; m < 4; ++m) _Pragma("unroll") for (int n = 0; n < 2; ++n) { \
        if constexpr (FP8) asm volatile("v_mfma_f32_16x16x128_f8f6f4 %0, %1, %2, %0" : "+v"(acc[ai][bj][m][n]) : "v"(PG8_CAT(Bt[n])), "v"(PG8_CAT(At[m])));   \
        else { _Pragma("unroll") for (int k = 0; k < 2; ++k) acc[ai][bj][m][n] = __builtin_amdgcn_mfma_f32_16x16x32_bf16(Bt[n][k], At[m][k], acc[ai][bj][m][n], 0, 0, 0); } } __builtin_amdgcn_s_setprio(0); } while (0)
#define PG8_WAIT_V(n) asm volatile("s_waitcnt vmcnt(" #n ")" ::: "memory")
#define PG8_WAIT_L(n) asm volatile("s_waitcnt lgkmcnt(" #n ")" ::: "memory")
#define PG8_BAR __builtin_amdgcn_s_barrier()
#define PG8_SCHED __builtin_amdgcn_sched_barrier(0)
    Unit cur, nxt; int ui = 0;
    if (!S.next(0, cur)) return;
    f32x4 acc[2][2][4][2];
#pragma unroll
    for (int a = 0; a < 2; ++a)
#pragma unroll
        for (int b = 0; b < 2; ++b)
#pragma unroll
            for (int m = 0; m < 4; ++m)
#pragma unroll
                for (int n = 0; n < 2; ++n) acc[a][b][m][n] = (f32x4){0.f, 0.f, 0.f, 0.f};
    bf16x8 At[4][2], B0[2][2], B1[2][2];
    const char* cA = (const char*)g.A + (size_t)cur.pm * tstep; const char* cB = (const char*)g.Bt + (size_t)cur.pn * tstep;
    S.a_ready(cur);
    if constexpr (SP2) {
        PG8_STAGE(PG8_SB(0, 0), cB, voffB); PG8_STAGE(PG8_SB(0, 1), cB + hstep, voffB); PG8_STAGE(PG8_SA(0, 0), cA, voffA); PG8_STAGE(PG8_SA(0, 1), cA + hstep, voffA);
        if (wr == 1) PG8_BAR;
        PG8_WAIT_V(2); PG8_BAR;
        PG8_STAGE(PG8_SB(1, 0), cB + kstep, voffB); PG8_STAGE(PG8_SA(1, 0), cA + kstep, voffA); PG8_STAGE(PG8_SB(1, 1), cB + hstep + kstep, voffB);
        PG8_WAIT_V(6); PG8_BAR;
    } else {
        PG8_STAGE(PG8_SB(0, 0), cB, voffB); PG8_STAGE(PG8_SA(0, 0), cA, voffA); PG8_STAGE(PG8_SB(0, 1), cB + hstep, voffB); PG8_STAGE(PG8_SA(0, 1), cA + hstep, voffA);
        if (wr == 1) PG8_BAR;
        PG8_WAIT_V(4); PG8_BAR;
        PG8_STAGE(PG8_SB(1, 0), cB + kstep, voffB); PG8_STAGE(PG8_SA(1, 0), cA + kstep, voffA); PG8_STAGE(PG8_SB(1, 1), cB + hstep + kstep, voffB);
        PG8_WAIT_V(6); PG8_BAR;
    }
    for (;;) {
        const bool has_next = S.next(ui + 1, nxt);
        const char* nA = has_next ? (const char*)g.A + (size_t)nxt.pm * tstep : cA; const char* nB = has_next ? (const char*)g.Bt + (size_t)nxt.pn * tstep : cB;
        for (int t = 0; t < nt; t += 2) {
            const bool last = (t == nt - 2);
            const char* a1 = cA + (size_t)(t + 1) * kstep;
            const char* a2 = last ? nA : cA + (size_t)(t + 2) * kstep; const char* b2 = last ? nB : cB + (size_t)(t + 2) * kstep;
            const char* a3 = a2 + kstep; const char* b3 = b2 + kstep;
            if (last && has_next) S.a_ready(nxt);
            if constexpr (SP2) {
            PG8_LDB(B0, 0, 0); PG8_LDB(B1, 0, 1); PG8_SCHED; PG8_LDA(At, 0, 0); PG8_STAGE(PG8_SA(1, 1), a1 + hstep, voffA);
            PG8_WAIT_V(8); PG8_WAIT_L(0); PG8_BAR; PG8_MMA(0, 0, At, B0); PG8_MMA(0, 1, At, B1); PG8_BAR; PG8_SCHED;
            PG8_LDA(At, 0, 1); PG8_STAGE(PG8_SB(0, 0), b2, voffB); PG8_STAGE(PG8_SB(0, 1), b2 + hstep, voffB); PG8_STAGE(PG8_SA(0, 0), a2, voffA);
            PG8_WAIT_V(8); PG8_WAIT_L(0); PG8_BAR; PG8_MMA(1, 0, At, B0); PG8_MMA(1, 1, At, B1); PG8_BAR; PG8_SCHED;
            PG8_LDB(B0, 1, 0); PG8_LDB(B1, 1, 1); PG8_SCHED; PG8_LDA(At, 1, 0); PG8_STAGE(PG8_SA(0, 1), a2 + hstep, voffA);
            PG8_WAIT_V(8); PG8_WAIT_L(0); PG8_BAR; PG8_MMA(0, 0, At, B0); PG8_MMA(0, 1, At, B1); PG8_BAR; PG8_SCHED;
            PG8_LDA(At, 1, 1); PG8_STAGE(PG8_SB(1, 0), b3, voffB); PG8_STAGE(PG8_SB(1, 1), b3 + hstep, voffB); PG8_STAGE(PG8_SA(1, 0), a3, voffA);
            PG8_WAIT_V(8); PG8_WAIT_L(0); PG8_BAR; PG8_MMA(1, 0, At, B0); PG8_MMA(1, 1, At, B1); PG8_BAR; PG8_SCHED;
            } else {
            PG8_LDB(B0, 0, 0); PG8_SCHED; PG8_LDA(At, 0, 0); PG8_STAGE(PG8_SA(1, 1), a1 + hstep, voffA);
            PG8_WAIT_L(8); PG8_BAR; PG8_WAIT_L(0); PG8_MMA(0, 0, At, B0); PG8_BAR; PG8_SCHED;
            PG8_LDB(B1, 0, 1); PG8_STAGE(PG8_SB(0, 0), b2, voffB);
            PG8_BAR; PG8_WAIT_L(0); PG8_MMA(0, 1, At, B1); PG8_BAR;
            PG8_LDA(At, 0, 1); PG8_STAGE(PG8_SA(0, 0), a2, voffA);
            PG8_BAR; PG8_WAIT_L(0); PG8_MMA(1, 0, At, B0); PG8_BAR; PG8_SCHED;
            PG8_STAGE(PG8_SB(0, 1), b2 + hstep, voffB);
            PG8_WAIT_V(6); PG8_BAR; PG8_MMA(1, 1, At, B1); PG8_BAR;
            PG8_LDB(B0, 1, 0); PG8_SCHED; PG8_LDA(At, 1, 0); PG8_STAGE(PG8_SA(0, 1), a2 + hstep, voffA);
            PG8_WAIT_L(8); PG8_BAR; PG8_WAIT_L(0); PG8_MMA(0, 0, At, B0); PG8_BAR; PG8_SCHED;
            PG8_LDB(B1, 1, 1); PG8_STAGE(PG8_SB(1, 0), b3, voffB);
            PG8_BAR; PG8_WAIT_L(0); PG8_MMA(0, 1, At, B1); PG8_BAR;
            PG8_LDA(At, 1, 1); PG8_STAGE(PG8_SA(1, 0), a3, voffA);
            PG8_BAR; PG8_WAIT_L(0); PG8_MMA(1, 0, At, B0); PG8_BAR; PG8_SCHED;
            PG8_STAGE(PG8_SB(1, 1), b3 + hstep, voffB);
            PG8_WAIT_V(6); PG8_BAR; PG8_MMA(1, 1, At, B1); PG8_BAR;
            }
        }
        if constexpr (ALIGN_EPI) { if (wr == 0) PG8_BAR; }
        if constexpr (FP8) asm volatile("s_nop 15\n\ts_nop 15" ::: "memory");
        if constexpr (!Epi::AFTER_DRAIN) { E(acc, cur, wr, wc, fr, fq); S.done(cur); }
        if (!has_next) break;
#pragma unroll
        for (int a = 0; a < 2; ++a)
#pragma unroll
            for (int b = 0; b < 2; ++b)
#pragma unroll
                for (int m = 0; m < 4; ++m)
#pragma unroll
                    for (int n = 0; n < 2; ++n) acc[a][b][m][n] = (f32x4){0.f, 0.f, 0.f, 0.f};
        cur = nxt; cA = nA; cB = nB; ++ui;
        if constexpr (ALIGN_EPI) { if (wr == 1) PG8_BAR; }
    }
    PG8_WAIT_V(0);
    if constexpr (!ALIGN_EPI) { if (wr == 0) PG8_BAR; }
    PG8_BAR;
    if constexpr (Epi::AFTER_DRAIN) { E.fused(acc, cur, wr, wc, fr, fq, lds, wid, lane); S.done(cur); }
#undef PG8_SA
#undef PG8_SB
#undef PG8_STAGE
#undef PG8_LDA
#undef PG8_LDB
#undef PG8_MMA
#undef PG8_CAT
#undef PG8_WAIT_V
#undef PG8_WAIT_L
#undef PG8_BAR
#undef PG8_SCHED
}
}


#define LAS __attribute__((address_space(3)))
namespace att {
using bf16x8 = __attribute__((ext_vector_type(8))) short;
using s16x4 = __attribute__((ext_vector_type(4))) short;
#define KSWZ(row, colB) ((row) * 256 + ((colB) ^ (((row) & 15) << 4)))
__device__ __forceinline__ int crow(int r, int hi) { return (r & 3) + 8 * (r >> 2) + 4 * hi; }
__device__ __forceinline__ int v_rd_base(int lane) { return ((lane & 3) << 3) | (((lane >> 2) & 3) << 6) | (((lane >> 4) & 1) << 5) | (((lane >> 5) & 1) << 8); }
constexpr int v_rd_off(int d0, int ks, int half) { return d0 * 512 + ks * 4096 + half * 2048; }
template <int OFF> __device__ __forceinline__ s16x4 tr_read(int vb) { s16x4 r; asm volatile("ds_read_b64_tr_b16 %0, %1 offset:%2" : "=&v"(r) : "v"(vb), "i"(OFF) : "memory"); return r; }
typedef __attribute__((address_space(3))) const char* lds_cptr;
typedef short v4i16_t __attribute__((ext_vector_type(4)));
typedef float f32x2_t __attribute__((ext_vector_type(2)));
typedef __bf16 bf16x2_t __attribute__((ext_vector_type(2)));
__device__ __forceinline__ void glds16(const void* gsrc, unsigned lds_dst) { unsigned keep;
    asm volatile("s_mov_b32 %0, m0\n\ts_mov_b32 m0, %2\n\ts_nop 0\n\tglobal_load_lds_dwordx4 %1, off\n\ts_mov_b32 m0, %0" : "=&s"(keep) : "v"(gsrc), "s"(lds_dst) : "memory"); }
typedef int i32x8 __attribute__((ext_vector_type(8)));
typedef int i32x4v __attribute__((ext_vector_type(4)));
__device__ __forceinline__ i32x8 ld32(lds_cptr a, lds_cptr b) { const i32x4v x = *(const LAS i32x4v*)a, y = *(const LAS i32x4v*)b; return (i32x8){x[0], x[1], x[2], x[3], y[0], y[1], y[2], y[3]}; }
__device__ __forceinline__ void attn_unit8(const Params& p, int h, int qb, char* lds) {
    int tid = threadIdx.x;
    asm volatile("" : "+v"(tid));
    const int wid = tid >> 6, lane = tid & 63, r32 = lane & 31, hi = lane >> 5;
    constexpr int A8_V = 0, A8_K = 49152, A8_Q = 98304, A8_WS = 131072;
    const int vs = (r32 >> 2) & 3, lb = (int)(uintptr_t)lds;
    const int vo0 = lb + r32 * 64 + (((2 * hi) ^ vs) << 4), vo1 = lb + r32 * 64 + (((2 * hi + 1) ^ vs) << 4);
    const int qv0 = vo0 + A8_Q + wid * 4096, qv1 = vo1 + A8_Q + wid * 4096;
    {   const unsigned char* Qw = P_QS8(p) + ((size_t)h * SEQ + (size_t)qb * 256 + wid * 32 + r32) * 128 + hi * 32;
        const i32x4v a0 = *(const i32x4v*)Qw, a1 = *(const i32x4v*)(Qw + 16), b0 = *(const i32x4v*)(Qw + 64), b1 = *(const i32x4v*)(Qw + 80);
        *(LAS i32x4v*)(uintptr_t)(unsigned)qv0 = a0; *(LAS i32x4v*)(uintptr_t)(unsigned)qv1 = a1; *(LAS i32x4v*)(uintptr_t)(unsigned)(qv0 + 2048) = b0; *(LAS i32x4v*)(uintptr_t)(unsigned)(qv1 + 2048) = b1;
    }
    const unsigned char* kimg = P_KIMG8(p) + (size_t)h * NTILE * 8192 + tid * 16;
    const unsigned char* vimg = P_VIMG8(p) + (size_t)h * NTILE * 8192 + tid * 16;
    const unsigned ldsw = (unsigned)__builtin_amdgcn_readfirstlane(wid) * 1024u;
    const unsigned kdst = (unsigned)(uintptr_t)(lds + A8_K) + ldsw, vdst = (unsigned)(uintptr_t)(lds + A8_V) + ldsw;
#define GLDSK(t, b) do { const size_t o_ = (size_t)(t) * 16384; _Pragma("unroll") for (int i_ = 0; i_ < 2; ++i_) glds16(kimg + o_ + i_ * 8192, (unsigned)__builtin_amdgcn_readfirstlane(kdst + (b) * 16384 + i_ * 8192)); } while (0)
#define GLDSV(t, b) do { const size_t o_ = (size_t)(t) * 16384; _Pragma("unroll") for (int i_ = 0; i_ < 2; ++i_) glds16(vimg + o_ + i_ * 8192, (unsigned)__builtin_amdgcn_readfirstlane(vdst + (b) * 16384 + i_ * 8192)); } while (0)
    f32x16 oA[4], oB[4]; f32x4 lAc = {0.f, 0.f, 0.f, 0.f}, lBc = {0.f, 0.f, 0.f, 0.f};
    i32x8 onesB; { const int ow = (((lane & 15) == 0 && !((lane >> 4) & 1)) || ((lane & 15) == 1 && ((lane >> 4) & 1))) ? 0x38383838 : 0;
#pragma unroll
        for (int i = 0; i < 8; ++i) onesB[i] = ow; }
#pragma unroll
    for (int d = 0; d < 4; ++d) { oA[d] = f32x16{}; oB[d] = f32x16{}; }
    f32x16 sA0, sA1, sB0, sB1; i32x8 pA = {}, pB = {}, kx, ky, vx, vy, qA, qB;
#define SB() __builtin_amdgcn_sched_barrier(0)
#define RD(a0_, a1_, imm_) ld32((lds_cptr)(uintptr_t)(unsigned)((a0_) + (imm_)), (lds_cptr)(uintptr_t)(unsigned)((a1_) + (imm_)))
#define MMS(A_, B_) __builtin_amdgcn_mfma_scale_f32_32x32x64_f8f6f4(A_, B_, f32x16{}, 0, 0, 0, 0, 0, 0)
#define MMO(ACC, A_, B_) ACC = __builtin_amdgcn_mfma_scale_f32_32x32x64_f8f6f4(A_, B_, ACC, 1, 0, 0, 0, 0, 0)
#define EX4(S, B) do { S[B] = __builtin_amdgcn_exp2f(S[B]); S[B + 1] = __builtin_amdgcn_exp2f(S[B + 1]); S[B + 2] = __builtin_amdgcn_exp2f(S[B + 2]); S[B + 3] = __builtin_amdgcn_exp2f(S[B + 3]); } while (0)
#define MML(ACC, A_) ACC = __builtin_amdgcn_mfma_scale_f32_16x16x128_f8f6f4(A_, onesB, ACC, 1, 0, 0, 0, 0, 0)
#define PK4(S, B, OUT, I) do { OUT[I] = __builtin_amdgcn_cvt_pk_bf8_f32(S[B], S[B + 1], OUT[I], false); OUT[I] = __builtin_amdgcn_cvt_pk_bf8_f32(S[B + 2], S[B + 3], OUT[I], true); } while (0)
#define HALFE(S, O, P, I) do { EX4(S, O); EX4(S, (O) + 4); PK4(S, O, P, I); PK4(S, (O) + 4, P, (I) + 1); } while (0)
#define GROUPP(C0, C1, KI, VI, Q0, Q1, QI, N0, N1, NI, D1, D2, D3, D4) do { \
          vx = RD(Q0, Q1, (QI)); vy = RD(Q0, Q1, (QI) + 2048); SB(); sB0 = MMS(kx, qB); SB(); \
          MML(lBc, pB); MMO(oB[0], pB, vx); HALFE(sA0, 0, pA, 0); D1; SB(); \
          vx = RD(Q0, Q1, (QI) + 4096); SB(); MMO(oB[1], pB, vy); HALFE(sA0, 8, pA, 2); SB(); \
          vy = RD(Q0, Q1, (QI) + 6144); ky = RD(C0, C1, (KI) + 4096 + 2048); SB(); MMO(oB[2], pB, vx); HALFE(sA1, 0, pA, 4); D2; SB(); \
          vx = RD(C0, C1, (VI)); SB(); MMO(oB[3], pB, vy); sB1 = MMS(ky, qB); HALFE(sA1, 8, pA, 6); SB(); \
          vy = RD(C0, C1, (VI) + 2048); SB(); MML(lAc, pA); MMO(oA[0], pA, vx); D3; SB(); \
          vx = RD(C0, C1, (VI) + 4096); SB(); MMO(oA[1], pA, vy); HALFE(sB0, 0, pB, 0); SB(); \
          vy = RD(C0, C1, (VI) + 6144); kx = RD(N0, N1, (NI)); qA = RD(qv0, qv1, 0); SB(); MMO(oA[2], pA, vx); HALFE(sB0, 8, pB, 2); D4; SB(); \
          ky = RD(N0, N1, (NI) + 2048); SB(); MMO(oA[3], pA, vy); sA0 = MMS(kx, qA); HALFE(sB1, 0, pB, 4); SB(); \
          kx = RD(N0, N1, (NI) + 4096); qB = RD(qv0, qv1, 2048); SB(); sA1 = MMS(ky, qA); HALFE(sB1, 8, pB, 6); \
        asm volatile("" : "+v"(pB));        \
        SB(); } while (0)
    GLDSK(0, 0); GLDSV(0, 0); GLDSK(1, 1); GLDSV(1, 1);
    asm volatile("s_waitcnt vmcnt(0)" ::: "memory"); __syncthreads();
    int bcur = 0;
    int cb0 = vo0, cb1 = vo1;
    kx = RD(cb0, cb1, A8_K); ky = RD(cb0, cb1, A8_K + 2048); qA = RD(qv0, qv1, 0); sA0 = MMS(kx, qA); sA1 = MMS(ky, qA); SB();
    kx = RD(cb0, cb1, A8_K + 4096); qB = RD(qv0, qv1, 2048); SB();
    for (int j = 0; j < NTILE / 2; ++j) {
        const int bnx = (bcur == 2) ? 0 : bcur + 1, bn2 = (bnx == 2) ? 0 : bnx + 1;
        const int dprev = (j == 0) ? 0 : ((bcur == 0) ? 32768 : -16384), dnext = (bcur == 2) ? -32768 : 16384;
        {   int pb0 = cb0 + dprev, pb1 = cb1 + dprev;
            asm volatile("" : "+v"(pb0), "+v"(pb1));
            GROUPP(cb0, cb1, A8_K, A8_V, pb0, pb1, A8_V + 8192, cb0, cb1, A8_K + 8192, (void)0, (void)0, (void)0, (void)0); }
        asm volatile("s_waitcnt vmcnt(0)" ::: "memory"); __syncthreads();
        {
            const int tl = (j + 2 < NTILE / 2) ? j + 2 : NTILE / 2 - 1; const size_t to_ = (size_t)tl * 16384;
            const unsigned kd_ = (unsigned)__builtin_amdgcn_readfirstlane(kdst + bn2 * 16384), vd_ = (unsigned)__builtin_amdgcn_readfirstlane(vdst + bn2 * 16384);
            int nb0 = cb0 + dnext, nb1 = cb1 + dnext;
            asm volatile("" : "+v"(nb0), "+v"(nb1));
            GROUPP(cb0, cb1, A8_K + 8192, A8_V + 8192, cb0, cb1, A8_V, nb0, nb1, A8_K,
                   glds16(kimg + to_, kd_), glds16(kimg + to_ + 8192, kd_ + 8192), glds16(vimg + to_, vd_), glds16(vimg + to_ + 8192, vd_ + 8192));
            cb0 = nb0; cb1 = nb1; }
        bcur = bnx;
    }
    asm volatile("s_waitcnt vmcnt(0)" ::: "memory");
    {   const int dl = (bcur == 0) ? 32768 : -16384; const int pb0 = cb0 + dl, pb1 = cb1 + dl;
        vx = RD(pb0, pb1, A8_V + 8192); vy = RD(pb0, pb1, A8_V + 8192 + 2048); MML(lBc, pB); MMO(oB[0], pB, vx); MMO(oB[1], pB, vy); SB();
        vx = RD(pb0, pb1, A8_V + 8192 + 4096); vy = RD(pb0, pb1, A8_V + 8192 + 6144); MMO(oB[2], pB, vx); MMO(oB[3], pB, vy); }
    __syncthreads();
#undef SB
#undef RD
#undef MMS
#undef MMO
#undef EX4
#undef MML
#undef PK4
#undef HALFE
#undef GROUPP
#undef GLDSK
#undef GLDSV
    int tide = threadIdx.x;
    asm volatile("" : "+v"(tide));
    const int r32e = tide & 31, hie = (tide >> 5) & 1, wide = tide >> 6;
    const float lam = P_SCAL(p)[0];
    float* wsf = (float*)(lds + A8_WS) + wide * 64;
    {   const int lq = 16 * (r32e & 15) + 4 * ((r32e >> 4) + 2 * hie);
        if ((r32e & 15) <= 1) {
#pragma unroll
            for (int r = 0; r < 4; ++r) { wsf[lq + r] = __builtin_amdgcn_rcpf(lAc[r]); wsf[32 + lq + r] = lam * __builtin_amdgcn_rcpf(lBc[r]); } } }
    asm volatile("s_waitcnt lgkmcnt(0)" ::: "memory");
    bf16_t* Ow = (P_A2(p) + (size_t)qb * 256 * 2048) + (size_t)(wide * 32) * 2048 + 1024 + h * 128 + r32e;
    const float g0 = p.subln_g[r32e] * (1.0f - LAM_INIT), g1 = p.subln_g[32 + r32e] * (1.0f - LAM_INIT), g2 = p.subln_g[64 + r32e] * (1.0f - LAM_INIT), g3 = p.subln_g[96 + r32e] * (1.0f - LAM_INIT);
#pragma unroll
    for (int r = 0; r < 16; ++r) { const float ra = wsf[crow(r, hie)], rb2 = wsf[32 + crow(r, hie)];
        const float y0 = oA[0][r] * ra - oB[0][r] * rb2, y1 = oA[1][r] * ra - oB[1][r] * rb2, y2 = oA[2][r] * ra - oB[2][r] * rb2, y3 = oA[3][r] * ra - oB[3][r] * rb2;
        float q = (y0 * y0 + y1 * y1) + (y2 * y2 + y3 * y3);
        q += __shfl_xor(q, 1); q += __shfl_xor(q, 2); q += __shfl_xor(q, 4); q += __shfl_xor(q, 8); q += __shfl_xor(q, 16);
        const float rs = __builtin_amdgcn_rsqf(q * (1.0f / 128.0f) + EPS);
        bf16_t* o = Ow + (size_t)crow(r, hie) * 2048;
        o[0] = (bf16_t)f2bf(y0 * rs * g0); o[32] = (bf16_t)f2bf(y1 * rs * g1); o[64] = (bf16_t)f2bf(y2 * rs * g2); o[96] = (bf16_t)f2bf(y3 * rs * g3); }
    __syncthreads();
}
#undef KSWZ
}

namespace gm {
using att::bf16x8; using att::s16x4;
template <int D0> __device__ __forceinline__ void mm_half(f32x16& o, int vb, const bf16x8* pa) {
    const s16x4 l0 = att::tr_read<att::v_rd_off(D0, 0, 0)>(vb), h0 = att::tr_read<att::v_rd_off(D0, 0, 1)>(vb), l1 = att::tr_read<att::v_rd_off(D0, 1, 0)>(vb), h1 = att::tr_read<att::v_rd_off(D0, 1, 1)>(vb);
    const s16x4 l2 = att::tr_read<att::v_rd_off(D0, 2, 0)>(vb), h2 = att::tr_read<att::v_rd_off(D0, 2, 1)>(vb), l3 = att::tr_read<att::v_rd_off(D0, 3, 0)>(vb), h3 = att::tr_read<att::v_rd_off(D0, 3, 1)>(vb);
    asm volatile("s_waitcnt lgkmcnt(0)" ::: "memory"); __builtin_amdgcn_sched_barrier(0);
#define PKV(L, H) (bf16x8){L[0], L[1], L[2], L[3], H[0], H[1], H[2], H[3]}
    o = __builtin_amdgcn_mfma_f32_32x32x16_bf16(pa[0], PKV(l0, h0), o, 0, 0, 0);
    o = __builtin_amdgcn_mfma_f32_32x32x16_bf16(pa[1], PKV(l1, h1), o, 0, 0, 0);
    o = __builtin_amdgcn_mfma_f32_32x32x16_bf16(pa[2], PKV(l2, h2), o, 0, 0, 0);
    o = __builtin_amdgcn_mfma_f32_32x32x16_bf16(pa[3], PKV(l3, h3), o, 0, 0, 0);
#undef PKV
}
__device__ __forceinline__ void gmlp_unit(const Params& p, int n, int g, char* lds) {
    int tid = threadIdx.x; asm volatile("" : "+v"(tid));
    const int wid = tid >> 6, lane = tid & 63, r32 = lane & 31, hi = lane >> 5;
    {
        const int q = tid >> 2, cq = tid & 3;
        const bf16_t* src = P_VG(p) + ((size_t)n * 128 + q) * 1024 + g * 128 + cq * 32;
        float xv[32];
#pragma unroll
        for (int i = 0; i < 4; ++i) { const u32x4 w = *(const u32x4*)(src + i * 8); const unsigned ws_[4] = {w.x, w.y, w.z, w.w};
#pragma unroll
            for (int k = 0; k < 4; ++k) { xv[i * 8 + 2 * k] = __uint_as_float(ws_[k] << 16); xv[i * 8 + 2 * k + 1] = __uint_as_float(ws_[k] & 0xffff0000u); } }
        float sm = 0.f;
#pragma unroll
        for (int i = 0; i < 32; ++i) sm += xv[i];
        sm += __shfl_xor(sm, 1); sm += __shfl_xor(sm, 2);
        const float mu = sm * (1.0f / 128.0f); float var = 0.f;
#pragma unroll
        for (int i = 0; i < 32; ++i) { xv[i] -= mu; var += xv[i] * xv[i]; }
        var += __shfl_xor(var, 1); var += __shfl_xor(var, 2);
        const float rs = 1.0f / sqrtf(var * (1.0f / 128.0f) + EPS);
        const float* lg = p.gmlp_ln_g + g * 128 + cq * 32;
        char* img = lds + (q >> 6) * 16384;
#pragma unroll
        for (int i = 0; i < 4; ++i) { u32x4 o;
            o.x = pk2(xv[i * 8 + 0] * rs * lg[i * 8 + 0], xv[i * 8 + 1] * rs * lg[i * 8 + 1]); o.y = pk2(xv[i * 8 + 2] * rs * lg[i * 8 + 2], xv[i * 8 + 3] * rs * lg[i * 8 + 3]);
            o.z = pk2(xv[i * 8 + 4] * rs * lg[i * 8 + 4], xv[i * 8 + 5] * rs * lg[i * 8 + 5]); o.w = pk2(xv[i * 8 + 6] * rs * lg[i * 8 + 6], xv[i * 8 + 7] * rs * lg[i * 8 + 7]);
            *(u32x4*)(img + v_img_off(q & 63, cq * 32 + i * 8)) = o; }
    }
    __syncthreads();
    const int pb = wid >> 1, d0b = (wid & 1) * 2;
    bf16x8 pa[8];
    const bf16_t* wsg = (const bf16_t*)(p.ws + WS_GWS) + ((size_t)g * 128 + pb * 32 + r32) * 128 + hi * 8;
#pragma unroll
    for (int ks = 0; ks < 8; ++ks) pa[ks] = *reinterpret_cast<const bf16x8*>(wsg + ks * 16);
    f32x16 o0 = f32x16{}, o1 = f32x16{};
    const int vb = (int)(uintptr_t)lds + att::v_rd_base(lane) + d0b * 512;
    mm_half<0>(o0, vb, pa); mm_half<1>(o1, vb, pa);
    mm_half<0>(o0, vb + 16384, pa + 4); mm_half<1>(o1, vb + 16384, pa + 4);
#pragma unroll
    for (int r = 0; r < 16; ++r) { const int prow = pb * 32 + att::crow(r, hi); const float bsv = p.gmlp_bs[g * 128 + prow];
        const size_t row = (size_t)n * 128 + prow; const int col = g * 128 + d0b * 32 + r32;
        const float u0 = bf2f(P_UG(p)[row * 1024 + col]), u1 = bf2f(P_UG(p)[row * 1024 + col + 32]);
        P_A2(p)[row * 2048 + col] = (bf16_t)f2bf(u0 * (o0[r] + bsv)); P_A2(p)[row * 2048 + col + 32] = (bf16_t)f2bf(u1 * (o1[r] + bsv)); }
    __syncthreads();
}
}

namespace peer {
typedef __bf16 bf16x2_t __attribute__((ext_vector_type(2)));
__device__ __forceinline__ float fmax_s(float a, float b) { float r; asm("v_max_f32 %0, %1, %2" : "=v"(r) : "v"(a), "v"(b)); return r; }
__device__ __forceinline__ float fmin_s(float a, float b) { float r; asm("v_min_f32 %0, %1, %2" : "=v"(r) : "v"(a), "v"(b)); return r; }
__device__ __forceinline__ void ce_desc(float& a, float& b) { const float mx = fmax_s(a, b), mn = fmin_s(a, b); a = mx; b = mn; }
__device__ __forceinline__ void ce_asc(float& a, float& b) { const float mx = fmax_s(a, b), mn = fmin_s(a, b); a = mn; b = mx; }
__device__ __forceinline__ void sort16_desc(float* v) {
#pragma unroll
    for (int k = 2; k <= 16; k <<= 1)
#pragma unroll
        for (int j = k >> 1; j > 0; j >>= 1)
#pragma unroll
            for (int i = 0; i < 16; ++i) { const int l = i ^ j; if (l > i) { if ((i & k) == 0) ce_desc(v[i], v[l]); else ce_asc(v[i], v[l]); } }
}
__device__ __forceinline__ void merge_top16(float* a, const float* b) {
#pragma unroll
    for (int i = 0; i < 16; ++i) a[i] = fmax_s(a[i], b[15 - i]);
#pragma unroll
    for (int j = 8; j > 0; j >>= 1)
#pragma unroll
        for (int i = 0; i < 16; ++i) { const int l = i ^ j; if (l > i) ce_desc(a[i], a[l]); }
}
__device__ __forceinline__ void top16_of_64(float* v) {
    sort16_desc(v); sort16_desc(v + 16); sort16_desc(v + 32); sort16_desc(v + 48);
    merge_top16(v, v + 16); merge_top16(v + 32, v + 48); merge_top16(v, v + 32);
}
__device__ __forceinline__ float dot2(unsigned a, unsigned b, float acc) { return __builtin_amdgcn_fdot2_f32_bf16(__builtin_bit_cast(bf16x2_t, a), __builtin_bit_cast(bf16x2_t, b), acc, false); }
__device__ __forceinline__ float wave_sum_dpp(float v) {
    v += __builtin_bit_cast(float, __builtin_amdgcn_update_dpp(0, __builtin_bit_cast(int, v), 0xB1, 0xF, 0xF, true));
    v += __builtin_bit_cast(float, __builtin_amdgcn_update_dpp(0, __builtin_bit_cast(int, v), 0x4E, 0xF, 0xF, true));
    v += __builtin_bit_cast(float, __builtin_amdgcn_update_dpp(0, __builtin_bit_cast(int, v), 0x141, 0xF, 0xF, true));
    v += __builtin_bit_cast(float, __builtin_amdgcn_update_dpp(0, __builtin_bit_cast(int, v), 0x140, 0xF, 0xF, true));
    const int vi = __builtin_bit_cast(int, v);
    const float a = __builtin_bit_cast(float, __builtin_amdgcn_readlane(vi, 0)), b = __builtin_bit_cast(float, __builtin_amdgcn_readlane(vi, 16));
    const float c = __builtin_bit_cast(float, __builtin_amdgcn_readlane(vi, 32)), d = __builtin_bit_cast(float, __builtin_amdgcn_readlane(vi, 48));
    return (a + b) + (c + d);
}
__device__ __forceinline__ float gelu_as(float v) {
    const float av = fabsf(v), t = __builtin_amdgcn_rcpf(av * 0.2316418882f + 1.0f);
    float q = t * 0.5307027145f + (-0.7265760135f); q = q * t + 0.7107068705f; q = q * t + (-0.142248368f); q = q * t + 0.127414796f; q = q * t;
    const float e = __builtin_amdgcn_exp2f((v * v) * (-0.72134752044f));
    const float m = v * (q * e);
    return v < 0.f ? m : v - m;
}
constexpr int PEER_TOK = 32;
__device__ __forceinline__ void peer_unit(const Params& p, int u, char* lds) {
    int tid = threadIdx.x; asm volatile("" : "+v"(tid));
    const int wid = tid >> 6, lane = tid & 63, r32 = lane & 31, hi = lane >> 5;
    constexpr int KS = 136;
    int* IDXl = (int*)lds; float* GATEl = (float*)(lds + 32 * KS * 4); int* SCR = (int*)(lds + 2 * 32 * KS * 4) + wid * 1024;
    const int t0 = u * PEER_TOK;
    {
        const int h = wid;
        float sab[2][16];
#pragma unroll
        for (int c = 0; c < 2; ++c) {
            f32x16 acc[4];
#pragma unroll
            for (int nb = 0; nb < 4; ++nb) acc[nb] = f32x16{};
            const bf16_t* qrow = P_QP(p) + (size_t)(t0 + r32) * 2048 + h * 256 + c * 128 + hi * 8;
            const bf16_t* krow = (const bf16_t*)(p.ws + WS_KEYS) + ((size_t)(h * 2 + c) * 128 + r32) * 128 + hi * 8;
#pragma unroll
            for (int ks = 0; ks < 8; ++ks) {
                const bf16x8 bq = *reinterpret_cast<const bf16x8*>(qrow + ks * 16);
#pragma unroll
                for (int nb = 0; nb < 4; ++nb) { const bf16x8 ak = *reinterpret_cast<const bf16x8*>(krow + nb * 32 * 128 + ks * 16);
                    acc[nb] = __builtin_amdgcn_mfma_f32_32x32x16_bf16(ak, bq, acc[nb], 0, 0, 0); }
            }
            float v[64];
#pragma unroll
            for (int nb = 0; nb < 4; ++nb)
#pragma unroll
                for (int r = 0; r < 16; ++r) { const unsigned cn = (unsigned)(32 * nb + (r & 3) + 8 * (r >> 2));
                    v[nb * 16 + r] = __uint_as_float((__float_as_uint(acc[nb][r]) & ~0x7Fu) | cn | ((unsigned)hi << 2)); }
            top16_of_64(v);
            float o[16];
#pragma unroll
            for (int i = 0; i < 16; ++i) o[i] = __shfl_xor(v[i], 32);
            merge_top16(v, o);
#pragma unroll
            for (int i = 0; i < 16; ++i) sab[c][i] = v[i];
        }
        if (hi == 0) {
#pragma unroll
            for (int i = 0; i < 16; ++i) { SCR[r32 * 32 + i] = (int)(__float_as_uint(sab[0][i]) & 0x7Fu); SCR[r32 * 32 + 16 + i] = (int)(__float_as_uint(sab[1][i]) & 0x7Fu); }
        }
        float cnd[64];
        {   int n = 0;
#pragma unroll
            for (int i = 0; i < 16; ++i)
#pragma unroll
                for (int j = 0; j < 16; ++j) if ((i + 1) * (j + 1) <= 16) { cnd[n] = __uint_as_float((__float_as_uint(sab[0][i] + sab[1][j]) & ~0xFFu) | (unsigned)(i * 16 + j)); ++n; }
#pragma unroll
            for (int k = 50; k < 64; ++k) cnd[k] = -INFINITY;
        }
        top16_of_64(cnd);
        float ex[16]; float sum = 0.f;
#pragma unroll
        for (int k = 0; k < 16; ++k) { ex[k] = __builtin_amdgcn_exp2f((cnd[k] - cnd[0]) * LOG2E); sum += ex[k]; }
        const float rsum = 1.0f / sum;
        asm volatile("s_waitcnt lgkmcnt(0)" ::: "memory");
        if (hi == 0) {
#pragma unroll
            for (int k = 0; k < 16; ++k) { const unsigned pos = __float_as_uint(cnd[k]) & 0xFFu;
                const int ia = SCR[r32 * 32 + (pos >> 4)], ib = SCR[r32 * 32 + 16 + (pos & 15)];
                IDXl[r32 * KS + h * 16 + k] = ia * 128 + ib; GATEl[r32 * KS + h * 16 + k] = ex[k] * rsum; }
            IDXl[r32 * KS + 128 + h] = 0; GATEl[r32 * KS + 128 + h] = 0.f;
        }
    }
    __syncthreads();
    {
#pragma unroll 1
        for (int tt = 0; tt < 4; ++tt) {
            const int tl = wid * 4 + tt;
            unsigned a0 = ((unsigned)IDXl[tl * KS + lane] << 7) | (unsigned)lane, a1 = ((unsigned)IDXl[tl * KS + 64 + lane] << 7) | (unsigned)(64 + lane);
#pragma unroll
            for (int k = 2; k <= 128; k <<= 1)
#pragma unroll
                for (int j = k >> 1; j > 0; j >>= 1) {
                    if (j == 64) { const unsigned mn = a0 < a1 ? a0 : a1, mx = a0 < a1 ? a1 : a0; a0 = mn; a1 = mx; }
                    else {
                        const unsigned o0 = (unsigned)__shfl_xor((int)a0, j), o1 = (unsigned)__shfl_xor((int)a1, j);
                        const bool lower = (lane & j) == 0;
                        const bool up0 = ((lane & k) == 0), up1 = (((64 + lane) & k) == 0);
                        const unsigned mn0 = a0 < o0 ? a0 : o0, mx0 = a0 < o0 ? o0 : a0, mn1 = a1 < o1 ? a1 : o1, mx1 = a1 < o1 ? o1 : a1;
                        a0 = (up0 == lower) ? mn0 : mx0; a1 = (up1 == lower) ? mn1 : mx1;
                    }
                }
            const float g0 = GATEl[tl * KS + (a0 & 127u)], g1 = GATEl[tl * KS + (a1 & 127u)];
            asm volatile("s_waitcnt lgkmcnt(0)" ::: "memory");
            IDXl[tl * KS + lane] = (int)(a0 >> 7); IDXl[tl * KS + 64 + lane] = (int)(a1 >> 7);
            GATEl[tl * KS + lane] = g0; GATEl[tl * KS + 64 + lane] = g1;
        }
        asm volatile("s_waitcnt lgkmcnt(0)" ::: "memory");
    }
    {
        typedef float f32x2 __attribute__((ext_vector_type(2)));
        const unsigned char* UT = p.ws + WS_UT;
        const float* g2 = P_MODS(p) + 5 * 2048;
        for (int tt = 0; tt < 4; ++tt) {
            const int tl = wid * 4 + tt; const size_t t = (size_t)t0 + tl;
            int lane_t = lane; asm volatile("" : "+v"(lane_t));
            const unsigned wbase = (unsigned)(uintptr_t)(lds + 2 * 32 * KS * 4) + (unsigned)__builtin_amdgcn_readfirstlane(wid) * 16000u;
            const unsigned h2b = wbase + 13824u;
            {
                float ps = (lane_t < 32) ? P_RSS(p)[t * 32 + lane_t] : 0.f;
                const float rstd = 1.0f / sqrtf(wave_sum_dpp(ps) * (1.0f / 2048.0f) + EPS) * H6_SCALE;
                const bf16_t* hp = P_XN(p) + t * 2048 + lane_t * 32;
                f32x16 lo_, hi_;
#pragma unroll
                for (int c = 0; c < 4; ++c) { const u32x4 w_ = *(const u32x4*)(hp + 8 * c); const unsigned ws_[4] = {w_.x, w_.y, w_.z, w_.w};
#pragma unroll
                    for (int q = 0; q < 2; ++q) { const int e0 = 8 * c + 4 * q; const f32x4 gg = *(const f32x4*)(P_G2V(p) + lane_t * 32 + e0), s4 = *(const f32x4*)(P_S2V(p) + lane_t * 32 + e0) * H6_SCALE;
                        const float v0 = __uint_as_float(ws_[2 * q] << 16) * rstd * gg[0] + s4[0], v1 = __uint_as_float(ws_[2 * q] & 0xffff0000u) * rstd * gg[1] + s4[1];
                        const float v2 = __uint_as_float(ws_[2 * q + 1] << 16) * rstd * gg[2] + s4[2], v3 = __uint_as_float(ws_[2 * q + 1] & 0xffff0000u) * rstd * gg[3] + s4[3];
                        if (c < 2) { lo_[e0] = v0; lo_[e0 + 1] = v1; lo_[e0 + 2] = v2; lo_[e0 + 3] = v3; } else { hi_[e0 - 16] = v0; hi_[e0 - 15] = v1; hi_[e0 - 14] = v2; hi_[e0 - 13] = v3; } } }
                const u32x6 pk = __builtin_amdgcn_cvt_scalef32_2xpk16_fp6_f32(lo_, hi_, 1.0f);
                const unsigned ha_ = h2b + (unsigned)lane_t * 32u;
                *(LAS u32x4*)(uintptr_t)ha_ = (u32x4){pk[0], pk[1], pk[2], pk[3]}; *(LAS u32x2*)(uintptr_t)(ha_ + 16u) = (u32x2){pk[4], pk[5]};
                asm volatile("s_waitcnt lgkmcnt(0)" ::: "memory");
            }
            f32x2 acc[16];
#pragma unroll
            for (int i = 0; i < 16; ++i) acc[i] = (f32x2){0.f, 0.f};
            const int l16 = lane & 15;
#if FP6_INTERLEAVED
#define FK(k_) ((((k_) & 15) << 1) | ((k_) >> 4))
#else
#define FK(k_) (k_)
#endif
#define DEC6(P_) __builtin_amdgcn_cvt_scalef32_pk32_f16_fp6(P_, 1.0f)
#define SBAR() __builtin_amdgcn_sched_barrier(0)
            constexpr int NBV = 4;
            u32x4 Aq[NBV], Bq[NBV]; u32x2 Ar[NBV], Br[NBV];
#define LOADV(S_, iv_, base_) do { _Pragma("unroll") for (int i_ = 0; i_ < NBV; ++i_) { \
                const int e_ = __builtin_amdgcn_readlane(iv_, (base_) + i_); const unsigned char* r_ = UT + (size_t)e_ * 3072 + 1536 + lane * 24; \
                S_##q[i_] = *(const u32x4*)r_; S_##r[i_] = *(const u32x2*)(r_ + 16); } } while (0)
#define COMPV(S_, base_) do { _Pragma("unroll") for (int i_ = 0; i_ < NBV; ++i_) { \
                const _Float16 wh_ = (_Float16)__builtin_bit_cast(float, __builtin_amdgcn_readlane(__builtin_bit_cast(int, wv), (base_) + i_)); const h16x2 w2_ = {wh_, wh_}; \
                const h16x32 dv_ = DEC6(((u32x6){S_##q[i_].x, S_##q[i_].y, S_##q[i_].z, S_##q[i_].w, S_##r[i_].x, S_##r[i_].y})); \
                _Pragma("unroll") for (int m_ = 0; m_ < 16; ++m_) acch[m_] = (h16x2){dv_[2 * m_], dv_[2 * m_ + 1]} * w2_ + acch[m_]; __builtin_amdgcn_sched_barrier(0); } } while (0)
            int idxv = IDXl[tl * KS + l16];
            LOADV(A, idxv, 0);
            u32x4 L0[3], L1[3], L2[3], L3[3];
            const unsigned char* ub = UT + (size_t)idxv * 3072 + (unsigned)(lane >> 4) * 16u;
#define LDU(L_, ub_, t8_) do { L_[0] = *(const u32x4*)((ub_) + (t8_) * 192); L_[1] = *(const u32x4*)((ub_) + (t8_) * 192 + 64); L_[2] = *(const u32x4*)((ub_) + (t8_) * 192 + 128); } while (0)
#define MMU(L_, t8_) do { const u32x4 a0_ = *(const LAS u32x4*)(uintptr_t)(hq + (unsigned)(2 * (t8_)) * 128u); const u32x2 a1_ = *(const LAS u32x2*)(uintptr_t)(hq + (unsigned)(2 * (t8_)) * 128u + 16u); \
                        const u32x4 c0_ = *(const LAS u32x4*)(uintptr_t)(hq + (unsigned)(2 * (t8_) + 1) * 128u); const u32x2 c1_ = *(const LAS u32x2*)(uintptr_t)(hq + (unsigned)(2 * (t8_) + 1) * 128u + 16u); \
                        const att::i32x8 A0_ = {(int)a0_.x, (int)a0_.y, (int)a0_.z, (int)a0_.w, (int)a1_.x, (int)a1_.y, 0, 0}, A1_ = {(int)c0_.x, (int)c0_.y, (int)c0_.z, (int)c0_.w, (int)c1_.x, (int)c1_.y, 0, 0}; \
                        const att::i32x8 B0_ = {(int)L_[0].x, (int)L_[0].y, (int)L_[0].z, (int)L_[0].w, (int)L_[1].x, (int)L_[1].y, 0, 0}, B1_ = {(int)L_[1].z, (int)L_[1].w, (int)L_[2].x, (int)L_[2].y, (int)L_[2].z, (int)L_[2].w, 0, 0}; \
                        dacc = __builtin_amdgcn_mfma_scale_f32_16x16x128_f8f6f4(A0_, B0_, dacc, 2, 2, 0, 0, 0, 0); dacc = __builtin_amdgcn_mfma_scale_f32_16x16x128_f8f6f4(A1_, B1_, dacc, 2, 2, 0, 0, 0, 0); } while (0)
            LDU(L0, ub, 0); LDU(L1, ub, 1); LDU(L2, ub, 2); LDU(L3, ub, 3);
            const unsigned hq = h2b + (unsigned)(lane >> 4) * 32u;
#pragma unroll 1
            for (int bt = 0; bt < 8; ++bt) {
                const float gatev = GATEl[tl * KS + bt * 16 + l16];
                const int idxn = IDXl[tl * KS + ((bt + 1) & 7) * 16 + l16];
                f32x4 dacc = {0.f, 0.f, 0.f, 0.f};
                {
                    MMU(L0, 0); LDU(L0, ub, 4); MMU(L1, 1); LDU(L1, ub, 5); MMU(L2, 2); LDU(L2, ub, 6); MMU(L3, 3); LDU(L3, ub, 7);
                    MMU(L0, 4); MMU(L1, 5); MMU(L2, 6); MMU(L3, 7);
                }
                const float wv = gatev * gelu_as(dacc[0] * (1.0f / (U6_SCALE * H6_SCALE)));
                h16x2 acch[16];
#pragma unroll
                for (int m = 0; m < 16; ++m) acch[m] = (h16x2){(_Float16)0.f, (_Float16)0.f};
                SBAR();
                LOADV(B, idxv, 4); SBAR(); COMPV(A, 0); SBAR();
                LOADV(A, idxv, 8); SBAR(); COMPV(B, 4); SBAR();
                LOADV(B, idxv, 12); SBAR(); COMPV(A, 8); SBAR();
                if (bt < 7) LOADV(A, idxn, 0);
                ub = UT + (size_t)idxn * 3072 + (unsigned)(lane >> 4) * 16u;
                if (bt < 7) { LDU(L0, ub, 0); LDU(L1, ub, 1); LDU(L2, ub, 2); LDU(L3, ub, 3); }
                SBAR(); COMPV(B, 12); SBAR();
#pragma unroll
                for (int m = 0; m < 16; ++m) { acc[m].x += (float)acch[m].x; acc[m].y += (float)acch[m].y; }
                idxv = idxn;
            }
#undef FK
#undef DEC6
#undef SBAR
#undef LOADV
#undef COMPV
#undef LDU
#undef MMU
            int lane_e = lane, tl_e = tl; asm volatile("" : "+v"(lane_e), "+v"(tl_e));
            const size_t t_e = (size_t)t0 + tl_e;
            float* orow = p.out + t_e * 2048; const bf16_t* xrow = P_XN(p) + t_e * 2048;
            const float fsc = 1.0f / V6_SCALE;
#pragma unroll
            for (int j = 0; j < 2; ++j) { const int ob = j * 1024 + lane_e * 16;
                const u32x4 xa = *(const u32x4*)(xrow + ob), xb = *(const u32x4*)(xrow + ob + 8);
                const unsigned xw[8] = {xa.x, xa.y, xa.z, xa.w, xb.x, xb.y, xb.z, xb.w};
#pragma unroll
                for (int q = 0; q < 4; ++q) { const int o = ob + q * 4;
                    const f32x4 x0 = {__uint_as_float(xw[2 * q] << 16), __uint_as_float(xw[2 * q] & 0xffff0000u), __uint_as_float(xw[2 * q + 1] << 16), __uint_as_float(xw[2 * q + 1] & 0xffff0000u)};
                    const f32x4 ga = *(const f32x4*)(g2 + o) * fsc;
                    const f32x4 r_ = x0 + ga * (j == 0 ? (f32x4){acc[4 * q].x, acc[4 * q + 1].x, acc[4 * q + 2].x, acc[4 * q + 3].x} : (f32x4){acc[4 * q].y, acc[4 * q + 1].y, acc[4 * q + 2].y, acc[4 * q + 3].y});
                    *(f32x4*)(orow + o) = r_; } }
        }
    }
    __syncthreads();
}
}

#define XB_TMO      128
#define XB_XCNT(j)  (256  + 64 * (j))
#define XB_XSUB(j)  (1280 + 64 * (j))
#define XB_XGEN(j)  (2304 + 64 * (j))
#define XB_TOP      3328
#define XB_TOPGEN   3392
#define XCD_BAR_WORDS 3456
#define XB_SPIN_CAP (1u << 18)

__device__ __forceinline__ unsigned xb_ld(unsigned* p)              { return __hip_atomic_load(p, __ATOMIC_RELAXED, __HIP_MEMORY_SCOPE_AGENT); }
__device__ __forceinline__ unsigned xb_add(unsigned* p, unsigned v) { return __hip_atomic_fetch_add(p, v, __ATOMIC_RELAXED, __HIP_MEMORY_SCOPE_AGENT); }
__device__ __forceinline__ unsigned xb_xcc_id() { return (unsigned)__builtin_amdgcn_s_getreg((3 << 11) | 20) & 0xFu; }
#define XB_SPIN(cond, bar) do { unsigned _sp = 0; while (cond) { __builtin_amdgcn_s_sleep(1); \
    if ((++_sp & 255u) == 0u) { if (xb_ld(&(bar)[XB_TMO])) break; if (_sp > XB_SPIN_CAP) { atomicAdd(&(bar)[XB_TMO], 1u); break; } } } } while (0)

struct XcdBarrier {
    unsigned* bar; unsigned x;
    volatile LAS unsigned* st;
};

__device__ __forceinline__ XcdBarrier xcd_barrier_post(unsigned* bar, volatile LAS unsigned* st) {
    XcdBarrier b; b.bar = bar; b.x = xb_xcc_id(); b.st = st;
    if (threadIdx.x == 0) (void)xb_add(&bar[XB_XCNT(b.x)], 1u);
    return b;
}
__device__ __forceinline__ void xcd_barrier_complete(unsigned* bar, unsigned x, unsigned& nloc, unsigned& nx) {
    const unsigned G = gridDim.x * gridDim.y * gridDim.z;
    unsigned sum, cnt, mine, sp = 0u;
    for (;;) {
        sum = 0u; cnt = 0u; mine = 0u;
#pragma unroll
        for (unsigned j = 0; j < 16; ++j) { const unsigned c = xb_ld(&bar[XB_XCNT(j)]); sum += c; cnt += (c > 0u) ? 1u : 0u; mine = (j == x) ? c : mine; }
        if (sum == G) break;
        __builtin_amdgcn_s_sleep(1);
        if ((++sp & 255u) == 0u) { if (xb_ld(&bar[XB_TMO])) break; if (sp > XB_SPIN_CAP) { atomicAdd(&bar[XB_TMO], 1u); break; } }
    }
    nloc = mine > 0u ? mine : 1u; nx = cnt > 0u ? cnt : 1u;
}

__device__ __forceinline__ void xcd_barrier(const XcdBarrier& b) {
    asm volatile("s_waitcnt vmcnt(0)" ::: "memory");
    __syncthreads();
    if (threadIdx.x == 0) {
        unsigned* bar = b.bar;
        __builtin_amdgcn_s_waitcnt(0);
        unsigned nloc = b.st[0], nx = b.st[1];
        if (nloc == 0u) { xcd_barrier_complete(bar, b.x, nloc, nx); b.st[0] = nloc; b.st[1] = nx; }
        const unsigned old = xb_add(&bar[XB_XSUB(b.x)], 1u);
        const unsigned gen = old / nloc;
        if (old + 1u == (gen + 1u) * nloc) {
            __builtin_amdgcn_fence(__ATOMIC_RELEASE, "agent");
            asm volatile("s_waitcnt vmcnt(0)" ::: "memory");
            const unsigned og = xb_add(&bar[XB_TOP], 1u);
            const unsigned tg = og / nx;
            if (og + 1u == (tg + 1u) * nx) xb_add(&bar[XB_TOPGEN], 1u);
            else XB_SPIN(xb_ld(&bar[XB_TOPGEN]) == tg, bar);
            __builtin_amdgcn_fence(__ATOMIC_ACQUIRE, "agent");
            xb_add(&bar[XB_XGEN(b.x)], 1u);
            asm volatile("s_waitcnt vmcnt(0)" ::: "memory");
        } else {
            XB_SPIN(xb_ld(&bar[XB_XGEN(b.x)]) == gen, bar);
            __builtin_amdgcn_fence(__ATOMIC_ACQUIRE, "agent");
            asm volatile("s_waitcnt vmcnt(0)" ::: "memory");
        }
    }
    __syncthreads();
}

namespace cg = cooperative_groups;
constexpr int MK_LDS = 163840;
enum { PH_PREP = 0, PH_HNORM, PH_GEMM1, PH_POST, PH_ATTN, PH_OUTP, PH_H2, PH_QP, PH_PEER, PH_N };
struct MkArgs { Params p; int ph_lo, ph_hi; };
__global__ __launch_bounds__(512, 2) void mk_fwd(MkArgs a) {
    extern __shared__ __attribute__((aligned(16))) unsigned char lds[];
    const Params& p = a.p;
    const int lo = a.ph_lo, hi = a.ph_hi;
    const int tid = threadIdx.x, lane = tid & 63, wave = __builtin_amdgcn_readfirstlane(tid >> 6);
    const int G = gridDim.x, bx = blockIdx.x;
    cg::grid_group grid = cg::this_grid();
    volatile LAS unsigned* xst = (volatile LAS unsigned*)((LAS unsigned char*)lds + MK_LDS - 64);
    if (tid < 16) xst[tid] = 0u;
    __syncthreads();
    const XcdBarrier xbar = xcd_barrier_post((unsigned*)(p.ws + WS_CTL) + 4096, xst);
#define IN(k) (lo <= (k) && (k) < hi)
#define SEAM(k) do { if (IN(k) && IN((k) + 1)) xcd_barrier(xbar); } while (0)
    if (lo < 0) grid.sync();
    if (IN(PH_PREP)) {
        float* fl = (float*)lds;
        p0_adaln(p, fl, bx, G);
        __syncthreads();
        const size_t gtid = (size_t)bx * 512 + tid, gthreads = (size_t)G * 512;
        cvt_range(p.peer_keys, (bf16_t*)(p.ws + WS_KEYS), 8 * 2 * 128 * 128 / 8, gtid, gthreads);
        cvt_range(p.gmlp_ws, (bf16_t*)(p.ws + WS_GWS), 8 * 128 * 128 / 8, gtid, gthreads);
        for (size_t i = gtid; i < 320 * 16; i += gthreads) { const int tp = (int)(i >> 4), f = (int)(i & 15);
            const float posf = (float)(tp < 256 ? tp : tp - 256), inv = exp2f(-(float)f * (13.287712379549449f / 16.0f)), ang = posf * inv;
            P_ROPE(p)[2 * i] = cosf(ang); P_ROPE(p)[2 * i + 1] = sinf(ang); }
        float* scr = fl + wave * (64 * 33);
        const int gw = bx * 8 + wave, ngw = G * 8;
        constexpr int I_IN = (2048 / 64) * (5120 / 32), I_SQ = (2048 / 64) * (2048 / 32);
        for (int it = gw; it < I_IN; it += ngw) {
            if ((it % 160) < 64) transpose_item(p.w_in, 2048, 5120, (bf16_t*)(p.ws + WS_WIN_T), scr, it, lane);
            else transpose_item8(p.w_in, 2048, 5120, p.ws + WS_WIN_T + 8 * MiB - (size_t)2048 * 2048, scr, it, lane, W8_SCALE); }
    }
    SEAM(PH_PREP);
    if (IN(PH_HNORM)) {
        const int gw = bx * 8 + wave, ngw = G * 8;
        const float* mods = P_MODS(p); const float* modsc = P_MODSC(p);
        if (bx == 0) for (int i = tid; i < 2048; i += 512) { P_G2V(p)[i] = p.norm2_g[i] * (1.0f + mods[4 * 2048 + i]); P_S2V(p)[i] = mods[3 * 2048 + i]; }
        for (int row = gw; row < LT; row += ngw) {
            if (row < CTX) norm_row_dual(p.ctx + (size_t)row * DM, p.norm1_g, modsc, modsc + 2048, P_HB(p) + (size_t)row * DM, P_HB8(p) + (size_t)row * DM, lane);
            else norm_row_dual(p.x + (size_t)(row - CTX) * DM, p.norm1_g, mods, mods + 2048, P_HB(p) + (size_t)row * DM, P_HB8(p) + (size_t)row * DM, lane);
        }
    }
    SEAM(PH_HNORM);
    if (IN(PH_GEMM1)) {
        {
            pg8::Gemm g{P_HB(p) + (size_t)CTX * DM, (const bf16_t*)(p.ws + WS_WIN_T), SEQ, 2048, DM}; pg8::StaticOrder S; S.init(SEQ, 2048, G, bx);
            pg8::EpiG1m E{P_UG(p), P_VG(p), P_QS8(p), P_KIMG8(p), P_VIMG8(p), p.q_norm_g, p.k_norm_g, P_ROPE(p), (LAS float*)((LAS unsigned char*)lds + 131072), 1, 0, 1.0f};
            pg8::gemm_phase<pg8::EpiG1m, pg8::StaticOrder, true, true, false>((LAS unsigned char*)lds, g, S, E); }
        {
            pg8::Gemm g{(const bf16_t*)P_HB8(p), (const bf16_t*)(p.ws + WS_WIN_T + 8 * MiB), LT, 3072, DM / 2}; pg8::StaticOrder S; S.init(LT, 3072, G, bx);
            pg8::EpiG1m E{P_UG(p), P_VG(p), P_QS8(p), P_KIMG8(p), P_VIMG8(p), p.q_norm_g, p.k_norm_g, P_ROPE(p), (LAS float*)((LAS unsigned char*)lds + 131072), 0, 8, 1.0f / W8_SCALE};
            pg8::gemm_phase<pg8::EpiG1m, pg8::StaticOrder, true, true, true>((LAS unsigned char*)lds, g, S, E); }
        {
            unsigned* qctr = (unsigned*)(p.ws + WS_CTL) + 64;
            float* scr = (float*)lds + wave * (64 * 33);
            for (;;) {
                __syncthreads();
                if (tid == 0) xst[8] = atomicAdd(qctr, 1u);
                __syncthreads();
                const unsigned c = xst[8];
                if (c >= 2592u) break;
                if (c >= 2560u) {
                    const int n0 = (int)(c - 2560u) * 64; const float* w_ = p.peer_wq + n0 + lane; const float* s2 = P_S2V(p); float a_ = 0.f;
#pragma unroll 8
                    for (int k = wave * 256; k < wave * 256 + 256; ++k) a_ += s2[k] * w_[(size_t)k * 2048];
                    float* red = (float*)lds; red[wave * 64 + lane] = a_;
                    __syncthreads();
                    if (wave == 0) { float t_ = 0.f;
#pragma unroll
                        for (int w8 = 0; w8 < 8; ++w8) t_ += red[w8 * 64 + lane];
                        P_BQ(p)[n0 + lane] = t_; }
                    continue; }
                if (c < 2048u) { const bool isv = c >= 1024u; const size_t r0 = (size_t)(c & 1023u) * 16;
                    const float* src = (isv ? p.peer_v : p.peer_u) + r0 * 2048; unsigned char* dst = p.ws + WS_UT + r0 * 3072 + (isv ? 1536 : 0); const float sc = isv ? V6_SCALE : U6_SCALE;
                    for (int i = tid; i < 16 * 64; i += 512) { const int rr = i >> 6, cc = i & 63;
                        const float* s_ = isv ? src + (size_t)rr * 2048 + cc * 16 : src + (size_t)rr * 2048 + cc * 32;
                        const int o2 = isv ? 1024 : 16;
                        f32x16 a_, b_;
#pragma unroll
                        for (int k = 0; k < 4; ++k) { const f32x4 x_ = *(const f32x4*)(s_ + 4 * k) * sc, y_ = *(const f32x4*)(s_ + o2 + 4 * k) * sc;
                            a_[4 * k] = x_[0]; a_[4 * k + 1] = x_[1]; a_[4 * k + 2] = x_[2]; a_[4 * k + 3] = x_[3]; b_[4 * k] = y_[0]; b_[4 * k + 1] = y_[1]; b_[4 * k + 2] = y_[2]; b_[4 * k + 3] = y_[3]; }
                        const u32x6 pk = __builtin_amdgcn_cvt_scalef32_2xpk16_fp6_f32(a_, b_, 1.0f);
                        const int sg = cc >> 2, kq = cc & 3;
                        if (isv) { unsigned char* d_ = dst + (size_t)rr * 3072 + cc * 24;
                            *(u32x2*)d_ = (u32x2){pk[0], pk[1]}; *(u32x2*)(d_ + 8) = (u32x2){pk[2], pk[3]}; *(u32x2*)(d_ + 16) = (u32x2){pk[4], pk[5]}; }
                        else { unsigned char* d_ = dst + (size_t)rr * 3072 + (sg >> 1) * 192 + kq * 16;
                            if ((sg & 1) == 0) { *(u32x4*)d_ = (u32x4){pk[0], pk[1], pk[2], pk[3]}; *(u32x2*)(d_ + 64) = (u32x2){pk[4], pk[5]}; }
                            else { *(u32x2*)(d_ + 64 + 8) = (u32x2){pk[0], pk[1]}; *(u32x4*)(d_ + 128) = (u32x4){pk[2], pk[3], pk[4], pk[5]}; } } } }
                else { const int it = (int)(c - 2048u) * 8 + wave; constexpr int I_SQ = (2048 / 64) * (2048 / 32);
                    if (it < I_SQ) transpose_item(p.w_out, 2048, 2048, (bf16_t*)(p.ws + WS_WOUT_T), scr, it, lane);
                    else transpose_item(p.peer_wq, 2048, 2048, (bf16_t*)(p.ws + WS_WQ_T), scr, it - I_SQ, lane, P_G2V(p)); }
            }
        }
    }
    SEAM(PH_GEMM1);
    if (IN(PH_POST)) {
        for (int u = bx; u < 128 * 8; u += G) gm::gmlp_unit(p, u >> 3, u & 7, (char*)lds);
    }
    SEAM(PH_POST);
    if (IN(PH_ATTN)) {
        for (int u = bx; u < NH * (SEQ / 256); u += G) att::attn_unit8(p, u & 7, u >> 3, (char*)lds);
    }
    SEAM(PH_ATTN);
    if (IN(PH_OUTP)) {
        pg8::Gemm g{P_A2(p), (const bf16_t*)(p.ws + WS_WOUT_T), SEQ, DM, DM}; pg8::StaticOrder S; S.init(SEQ, DM, G, bx);
        pg8::EpiOutm E{p.x, P_MODS(p) + 2 * 2048, P_XN(p), P_RSS(p)};
        pg8::gemm_phase<pg8::EpiOutm, pg8::StaticOrder, true, true>((LAS unsigned char*)lds, g, S, E);
    }
    SEAM(PH_OUTP);
    if (IN(PH_QP)) {
        pg8::Gemm g{P_XN(p), (const bf16_t*)(p.ws + WS_WQ_T), SEQ, DM, DM}; pg8::StaticOrder S; S.init(SEQ, DM, G, bx);
        pg8::EpiQp E{P_QP(p), P_RSS(p), P_BQ(p)};
        pg8::gemm_phase<pg8::EpiQp, pg8::StaticOrder, true, true>((LAS unsigned char*)lds, g, S, E);
    }
    SEAM(PH_QP);
    if (IN(PH_PEER)) {
        for (int u = bx; u < SEQ / peer::PEER_TOK; u += G) peer::peer_unit(p, u, (char*)lds);
    }
#undef IN
#undef SEAM
}
static int g_grid = 0;
static void mk_launch(const Params& p, int lo, int hi, hipStream_t stream) {
    (void)hipMemsetAsync(p.ws + WS_CTL, 0, 65536, stream);
    MkArgs a{}; a.p = p; a.ph_lo = lo; a.ph_hi = hi;
    void* args[] = {&a};
    hipError_t e = hipLaunchCooperativeKernel((const void*)mk_fwd, dim3(g_grid), dim3(512), args, MK_LDS, stream);
    if (e != hipSuccess) fprintf(stderr, "mk_launch [%d,%d) failed: %s (grid %d)\n", lo, hi, hipGetErrorString(e), g_grid);
}

extern "C" void kernel_launch(void* const* d_in, const int* in_sizes, int n_in, void* d_out, int out_size, void* d_ws, size_t ws_size, hipStream_t stream) {
    static int init = 0;
    if (!init) {
        if (n_in != 24 || ws_size < WS_END) { fprintf(stderr, "kernel_launch: unexpected n_in %d / ws %zu\n", n_in, ws_size); }
        (void)hipFuncSetAttribute((const void*)mk_fwd, hipFuncAttributeMaxDynamicSharedMemorySize, MK_LDS);
        int dev = 0, cus = 0, per_cu = 0;
        (void)hipGetDevice(&dev); (void)hipDeviceGetAttribute(&cus, hipDeviceAttributeMultiprocessorCount, dev);
        (void)hipOccupancyMaxActiveBlocksPerMultiprocessor(&per_cu, (const void*)mk_fwd, 512, MK_LDS);
        if (per_cu < 1) { fprintf(stderr, "kernel_launch: occupancy query says %d blocks/CU\n", per_cu); per_cu = 1; }
        g_grid = cus * 1;
        init = 1;
    }
    Params p{};
    const float** f = (const float**)&p;
    for (int i = 0; i < 24; ++i) f[i] = (const float*)d_in[i];
    p.out = (float*)d_out; p.ws = (unsigned char*)d_ws;

    mk_launch(p, PH_PREP, PH_N, stream);
}
```

```cpp
#include <hip/hip_runtime.h>
#include <hip/hip_cooperative_groups.h>
#include <cstdint>
#include <cstdio>
#include <cmath>

typedef unsigned short bf16_t;
typedef short bf16x8 __attribute__((ext_vector_type(8)));
typedef float f32x4 __attribute__((ext_vector_type(4)));
typedef float f32x16 __attribute__((ext_vector_type(16)));
typedef unsigned u32x4 __attribute__((ext_vector_type(4)));
typedef unsigned u32x2 __attribute__((ext_vector_type(2)));

constexpr int DM = 2048, SEQ = 16384, CTX = 256, LT = SEQ + CTX;
constexpr int D_A = 1024, D_QK = 1024, D_V = 1024, D_IN = 5120;
constexpr int NH = 8, DQK = 64, DV = 128;
constexpr int NTILE = LT / 64;
constexpr int PEER_H = 8, NKEYS = 128, TOPK = 16;
constexpr float EPS = 1e-6f;
constexpr float LAM_INIT = 0.2f;
constexpr float LOG2E = 1.4426950408889634f;
constexpr float QSCALE = 0.125f * LOG2E;

constexpr size_t MiB = 1u << 20;
constexpr size_t WS_CTL = 0;
constexpr size_t WS_MODS = 1 * MiB;
constexpr size_t WS_WIN_T = 2 * MiB;
constexpr size_t WS_WOUT_T = 22 * MiB;
constexpr size_t WS_WQ_T = 30 * MiB;
constexpr size_t WS_KEYS = 38 * MiB;
constexpr size_t WS_GWS = 38 * MiB + 512 * 1024;
constexpr size_t WS_UT = 39 * MiB;
constexpr size_t WS_VT = 103 * MiB;
constexpr size_t WS_R1 = 167 * MiB;
constexpr size_t WS_R2 = 232 * MiB;
constexpr size_t WS_R3 = 296 * MiB;
constexpr size_t WS_R4 = 394 * MiB;
constexpr size_t WS_R5 = 491 * MiB;
constexpr size_t WS_END = 507 * MiB;

struct Params {
    const float *x, *c, *ctx, *c_ctx, *w_ada, *b_ada, *norm1_g, *norm2_g, *w_in, *gmlp_ln_g, *gmlp_ws, *gmlp_bs, *q_norm_g, *k_norm_g,
        *lq1, *lk1, *lq2, *lk2, *subln_g, *w_out, *peer_wq, *peer_keys, *peer_u, *peer_v;
    float* out;
    unsigned char* ws;
};
#define P_MODS(p) ((float*)((p).ws + WS_MODS))
#define P_MODSC(p) ((float*)((p).ws + WS_MODS) + 12288)
#define P_SCAL(p) ((float*)((p).ws + WS_MODS) + 16384)
#define P_G2V(p) ((float*)((p).ws + WS_MODS + 196608))
#define P_S2V(p) ((float*)((p).ws + WS_MODS + 204800))
#define P_BQ(p) ((float*)((p).ws + WS_MODS + 212992))
#define P_RSS(p) ((float*)((p).ws + WS_R2))
#define P_ROPE(p) ((float*)((p).ws + WS_MODS + 131072))
#define P_HB(p) ((bf16_t*)((p).ws + WS_R1))
#define P_HB8(p) ((unsigned char*)((p).ws + WS_R3))
#define P_A2(p) ((bf16_t*)((p).ws + WS_R1))
#define P_UG(p) ((bf16_t*)((p).ws + WS_R2))
#define P_VG(p) ((bf16_t*)((p).ws + WS_R2 + 32 * MiB))
#define P_XB(p) ((bf16_t*)((p).ws + WS_R2))
#define P_QKV(p) ((bf16_t*)((p).ws + WS_R3))
#define P_QP(p) ((bf16_t*)((p).ws + WS_R3))
#define P_QS(p) ((bf16_t*)((p).ws + WS_R4))
#define P_KIMG(p) ((bf16_t*)((p).ws + WS_R4 + 32 * MiB))
#define P_QS8(p) ((unsigned char*)((p).ws + WS_R4))
#define P_KIMG8(p) ((unsigned char*)((p).ws + WS_R4 + 32 * MiB))
#define P_VIMG8(p) ((unsigned char*)((p).ws + WS_R4 + 32 * MiB + 33 * MiB))
#define P_VIMG(p) ((bf16_t*)((p).ws + WS_R4 + 32 * MiB + 33 * MiB))
#define P_XN(p) ((bf16_t*)((p).ws + WS_R4))
#define P_IDX(p) ((int*)((p).ws + WS_R5))
#define P_GATE(p) ((float*)((p).ws + WS_R5 + 8 * MiB))

__device__ __forceinline__ float bf2f(bf16_t b) { return __uint_as_float((unsigned)b << 16); }
__device__ __forceinline__ unsigned f2bf(float f) { unsigned u = __float_as_uint(f); return (u + 0x7fffu + ((u >> 16) & 1u)) >> 16; }
__device__ __forceinline__ unsigned pk2(float lo, float hi) { return f2bf(lo) | (f2bf(hi) << 16); }
__device__ __forceinline__ float wave_sum(float v) {
#pragma unroll
    for (int o = 1; o < 64; o <<= 1) v += __shfl_xor(v, o);
    return v;
}
__device__ __forceinline__ float gelu_erf(float v) { return 0.5f * v * (1.0f + erff(v * 0.70710678118654752f)); }
__device__ __forceinline__ int k8_off(int key, int colbyte) { const int c_ = colbyte >> 6, d_ = colbyte & 63; return c_ * 4096 + key * 64 + ((((d_ >> 4) ^ ((key >> 2) & 3)) << 4) | (d_ & 15)); }
__device__ __forceinline__ int v8_off(int k, int c) { const int p_ = (((k >> 2) & 1) << 5) | ((k >> 5) << 4) | (((k >> 3) & 3) << 2) | (k & 3); return c * 64 + ((((p_ >> 4) ^ ((c >> 2) & 3)) << 4) | (p_ & 15)); }
__device__ __forceinline__ int k_img_off(int key, int colbyte) { return key * 256 + (colbyte ^ ((key & 15) << 4)); }
__device__ __forceinline__ int v_img_off(int k, int c) { const int kk = (k & ~0xC) | ((k & 4) << 1) | ((k & 8) >> 1); return ((kk >> 3) * 4 + (c >> 5)) * 512 + ((kk & 7) * 32 + (c & 31)) * 2; }

__device__ __forceinline__ void p0_adaln(const Params& p, float* lds, int b, int nb) {
    const int tid = threadIdx.x, lane = tid & 63, wave = tid >> 6;
    float* sc = lds; float* scc = lds + 2048; float* red = lds + 4096;
    for (int k = tid; k < 2048; k += 512) { float v = p.c[k]; sc[k] = v / (1.0f + expf(-v)); v = p.c_ctx[k]; scc[k] = v / (1.0f + expf(-v)); }
    __syncthreads();
    float* mods = P_MODS(p); float* modsc = P_MODSC(p);
    for (int item = b; item < 192; item += nb) {
        const int col = item * 64 + lane;
        const float* w = p.w_ada + col;
        float a0 = 0.f, a1 = 0.f;
        const int k0 = wave * 256;
#pragma unroll 8
        for (int k = 0; k < 256; ++k) { const float wv = w[(size_t)(k0 + k) * 12288]; a0 += sc[k0 + k] * wv; a1 += scc[k0 + k] * wv; }
        red[(wave * 2 + 0) * 64 + lane] = a0; red[(wave * 2 + 1) * 64 + lane] = a1;
        __syncthreads();
        if (wave == 0) {
            float s0 = 0.f, s1 = 0.f;
#pragma unroll
            for (int w8 = 0; w8 < 8; ++w8) { s0 += red[(w8 * 2 + 0) * 64 + lane]; s1 += red[(w8 * 2 + 1) * 64 + lane]; }
            const float bb = p.b_ada[col];
            mods[col] = s0 + bb; if (col < 4096) modsc[col] = s1 + bb;
        }
        __syncthreads();
    }
    if (b == 0 && wave == 0) {
        float d1 = wave_sum(p.lq1[lane] * p.lk1[lane]), d2 = wave_sum(p.lq2[lane] * p.lk2[lane]);
        float gq = fabsf(p.q_norm_g[lane]), gk = fabsf(p.k_norm_g[lane]);
#pragma unroll
        for (int o = 1; o < 64; o <<= 1) { gq = fmaxf(gq, __shfl_xor(gq, o)); gk = fmaxf(gk, __shfl_xor(gk, o)); }
        if (lane == 0) { float* s = P_SCAL(p); s[0] = expf(d1) - expf(d2) + LAM_INIT; s[1] = 8.0f * gq * gk * LOG2E * 1.0001f + 0.01f; }
    }
}
__device__ __forceinline__ void cvt_range(const float* __restrict__ src, bf16_t* __restrict__ dst, size_t n8, size_t gtid, size_t gthreads) {
    for (size_t i = gtid; i < n8; i += gthreads) {
        const f32x4 a = *(const f32x4*)(src + i * 8), b = *(const f32x4*)(src + i * 8 + 4);
        u32x4 o; o.x = pk2(a.x, a.y); o.y = pk2(a.z, a.w); o.z = pk2(b.x, b.y); o.w = pk2(b.z, b.w);
        *(u32x4*)(dst + i * 8) = o;
    }
}
#ifndef FP6_INTERLEAVED
#define FP6_INTERLEAVED 1
#endif
constexpr float U6_SCALE = 72.0f, V6_SCALE = 3.2f, H6_SCALE = 1.0f;
typedef unsigned u32x6 __attribute__((ext_vector_type(6)));
typedef _Float16 h16x2 __attribute__((ext_vector_type(2)));
typedef _Float16 h16x32 __attribute__((ext_vector_type(32)));
__device__ __forceinline__ unsigned pk4_fp8(f32x4 a, float sc) {
    int w = 0; w = __builtin_amdgcn_cvt_pk_fp8_f32(a.x * sc, a.y * sc, w, false); w = __builtin_amdgcn_cvt_pk_fp8_f32(a.z * sc, a.w * sc, w, true); return (unsigned)w;
}
__device__ __forceinline__ void cvt_range_fp8(const float* __restrict__ src, unsigned char* __restrict__ dst, size_t n16, float sc, size_t gtid, size_t gthreads) {
    for (size_t i = gtid; i < n16; i += gthreads) {
        const f32x4 a = *(const f32x4*)(src + i * 16), b = *(const f32x4*)(src + i * 16 + 4), c = *(const f32x4*)(src + i * 16 + 8), d = *(const f32x4*)(src + i * 16 + 12);
        u32x4 o; o.x = pk4_fp8(a, sc); o.y = pk4_fp8(b, sc); o.z = pk4_fp8(c, sc); o.w = pk4_fp8(d, sc);
        *(u32x4*)(dst + i * 16) = o;
    }
}
__device__ __forceinline__ void transpose_item(const float* W, int K, int N, bf16_t* WT, float* scr, int item, int lane, const float* kscale = nullptr) {
    const int nblk = N / 32, kb = item / nblk, nbk = item % nblk, k0 = 64 * kb, n0 = 32 * nbk;
#pragma unroll 8
    for (int i = 0; i < 32; ++i) { const int kk = 2 * i + (lane >> 5); const float w_ = W[(size_t)(k0 + kk) * N + n0 + (lane & 31)]; scr[kk * 33 + (lane & 31)] = kscale ? w_ * kscale[k0 + kk] : w_; }
    __builtin_amdgcn_s_waitcnt(0xC07F); __builtin_amdgcn_wave_barrier();
    const int c8 = lane & 7;
#pragma unroll
    for (int j = 0; j < 4; ++j) { const int n = (lane >> 3) + 8 * j; const float* s = scr + (8 * c8) * 33 + n;
        u32x4 o; o.x = pk2(s[0 * 33], s[1 * 33]); o.y = pk2(s[2 * 33], s[3 * 33]); o.z = pk2(s[4 * 33], s[5 * 33]); o.w = pk2(s[6 * 33], s[7 * 33]);
        *(u32x4*)(WT + (size_t)(n0 + n) * K + k0 + 8 * c8) = o; }
    __builtin_amdgcn_s_waitcnt(0xC07F); __builtin_amdgcn_wave_barrier();
}
constexpr float W8_SCALE = 64.0f;
__device__ __forceinline__ void transpose_item8(const float* W, int K, int N, unsigned char* WT, float* scr, int item, int lane, float sc) {
    const int nblk = N / 32, kb = item / nblk, nbk = item % nblk, k0 = 64 * kb, n0 = 32 * nbk;
#pragma unroll 8
    for (int i = 0; i < 32; ++i) { const int kk = 2 * i + (lane >> 5); scr[kk * 33 + (lane & 31)] = W[(size_t)(k0 + kk) * N + n0 + (lane & 31)]; }
    __builtin_amdgcn_s_waitcnt(0xC07F); __builtin_amdgcn_wave_barrier();
    const int c8 = lane & 7;
#pragma unroll
    for (int j = 0; j < 4; ++j) { const int n = (lane >> 3) + 8 * j; const float* s = scr + (8 * c8) * 33 + n;
        u32x2 o; o.x = pk4_fp8((f32x4){s[0 * 33], s[1 * 33], s[2 * 33], s[3 * 33]}, sc); o.y = pk4_fp8((f32x4){s[4 * 33], s[5 * 33], s[6 * 33], s[7 * 33]}, sc);
        *(u32x2*)(WT + (size_t)(n0 + n) * K + k0 + 8 * c8) = o; }
    __builtin_amdgcn_s_waitcnt(0xC07F); __builtin_amdgcn_wave_barrier();
}
__device__ __forceinline__ void norm_row_dual(const float* xrow, const float* g, const float* sh, const float* sc, bf16_t* orow, unsigned char* orow8, int lane) {
    f32x4 v[8]; float ss = 0.f;
#pragma unroll
    for (int j = 0; j < 8; ++j) { v[j] = *(const f32x4*)(xrow + j * 256 + lane * 4); ss += (v[j].x * v[j].x + v[j].y * v[j].y) + (v[j].z * v[j].z + v[j].w * v[j].w); }
    ss = wave_sum(ss);
    const float r = 1.0f / sqrtf(ss * (1.0f / 2048.0f) + EPS);
#pragma unroll
    for (int j = 0; j < 8; ++j) {
        const int o = j * 256 + lane * 4;
        const f32x4 gg = *(const f32x4*)(g + o), s4 = *(const f32x4*)(sh + o), c4 = *(const f32x4*)(sc + o);
        const f32x4 y = (v[j] * r * gg) * (1.0f + c4) + s4;
        u32x2 w; w.x = pk2(y.x, y.y); w.y = pk2(y.z, y.w);
        *(u32x2*)(orow + o) = w;
        *(unsigned*)(orow8 + o) = pk4_fp8(y, 1.0f);
    }
}

namespace pg8 {
#define PG8_LAS __attribute__((address_space(3)))
typedef unsigned short bf16_t;
typedef short bf16x8 __attribute__((ext_vector_type(8)));
typedef float f32x4 __attribute__((ext_vector_type(4)));
typedef unsigned u32x4 __attribute__((ext_vector_type(4)));
constexpr int BM = 256, BK = 64, HALF = 128, HTB = HALF * BK * 2  , STAGE_BYTES = 8 * HTB, NXCD = 8, WGM = 8;

__host__ __device__ __forceinline__ int lds_byte(int r, int c) { const int st = (r >> 4) * 2 + (c >> 5), rr = r & 15, cc = c & 31, ob = rr * 64 + cc * 2; return st * 1024 + (ob ^ (((ob >> 9) & 1) << 5)); }
__host__ __device__ __forceinline__ void stage_rc(int b, int& R, int& C) { const int st = b / 1024, sb = b % 1024, swz = sb ^ (((sb >> 9) & 1) << 5); R = (st >> 1) * 16 + swz / 64; C = (st & 1) * 32 + (swz % 64) / 2; }
__host__ __device__ __forceinline__ int perm32(int rho) { const int n = rho >> 4, i = rho & 15; return 8 * (i >> 2) + 4 * n + (i & 3); }

struct Unit { int pm, pn; };
struct Gemm { const bf16_t* A; const bf16_t* Bt; int M, N, K; };

struct StaticOrder {
    int nM, nN, nwg, G, c;
    __host__ __device__ void init(int M, int N, int G_, int c_) { nM = M / BM; nN = N / BM; nwg = nM * nN; G = G_; c = c_; }
    __host__ __device__ bool next(int i, Unit& u) const {
        const long L = (long)i * G + c; if (L >= nwg) return false;
        int wgid = (int)L; { const int q = nwg / NXCD, r = nwg % NXCD, xcd = wgid % NXCD, off = wgid / NXCD; wgid = (xcd < r ? xcd * (q + 1) : r * (q + 1) + (xcd - r) * q) + off; }
        const int nig = WGM * nN, gid = wgid / nig, fm = gid * WGM, gsz = (nM - fm) < WGM ? (nM - fm) : WGM;
        u.pm = fm + ((wgid % nig) % gsz); u.pn = (wgid % nig) / gsz; return true;
    }
    __device__ __forceinline__ void a_ready(const Unit&) const {}
    __device__ __forceinline__ void done(const Unit&) const {}
};

__device__ __forceinline__ unsigned cvt_pk_bf16(float lo, float hi) { unsigned r; asm volatile("v_cvt_pk_bf16_f32 %0, %1, %2" : "=v"(r) : "v"(lo), "v"(hi)); return r; }
typedef float f32x2 __attribute__((ext_vector_type(2)));
__device__ __forceinline__ f32x2 gelu_pk(f32x2 v) {
    const f32x2 av = __builtin_elementwise_abs(v), d = av * 0.2316418882f + 1.0f;
    f32x2 t; t.x = __builtin_amdgcn_rcpf(d.x); t.y = __builtin_amdgcn_rcpf(d.y);
    f32x2 q = t * 0.5307027145f + (-0.7265760135f); q = q * t + 0.7107068705f; q = q * t + (-0.142248368f); q = q * t + 0.127414796f; q = q * t;
    const f32x2 s = (v * v) * (-0.72134752044f);
    f32x2 e; e.x = __builtin_amdgcn_exp2f(s.x); e.y = __builtin_amdgcn_exp2f(s.y);
    const f32x2 m = v * (q * e), r = v - m;
    f32x2 o; o.x = v.x < 0.f ? m.x : r.x; o.y = v.y < 0.f ? m.y : r.y; return o;
}

template <int ACT  > struct EpiBf16 {
    static constexpr bool PERM = true, AFTER_DRAIN = false; static_assert(ACT == 0 || ACT == 1, "EpiBf16: ACT is 0 (none) or 1 (gelu_pk)");
    bf16_t* O; int ldc; const float* bias; int split_cols; size_t split_stride; float scale0;
    __device__ __forceinline__ void operator()(const f32x4 (&acc)[2][2][4][2], const Unit& u, int wr, int wc, int fr, int fq) const {
        const int row0 = u.pm * BM + wr * 64 + fr; int colt = u.pn * BM; bf16_t* base = O;
        float sc = 1.f; if (split_cols) { const int t = colt / split_cols; base += (size_t)t * split_stride; colt -= t * split_cols; if (t == 0) sc = scale0; }
        const int col0 = colt + wc * 32 + 8 * fq, bcol0 = u.pn * BM + wc * 32 + 8 * fq;
        f32x4 bv[2][2];
#pragma unroll
        for (int bj = 0; bj < 2; ++bj)
#pragma unroll
            for (int n = 0; n < 2; ++n) bv[bj][n] = bias ? *(const f32x4*)(bias + bcol0 + bj * HALF + 4 * n) : (f32x4){0.f, 0.f, 0.f, 0.f};
#pragma unroll
        for (int ai = 0; ai < 2; ++ai)
#pragma unroll
            for (int m = 0; m < 4; ++m) { bf16_t* rowp = base + (size_t)(row0 + ai * HALF + m * 16) * ldc + col0;
#pragma unroll
                for (int bj = 0; bj < 2; ++bj) { f32x4 v0 = acc[ai][bj][m][0] + bv[bj][0], v1 = acc[ai][bj][m][1] + bv[bj][1];
                    if (ACT == 1) { f32x2 a = gelu_pk((f32x2){v0[0], v0[1]}), b = gelu_pk((f32x2){v0[2], v0[3]}), c = gelu_pk((f32x2){v1[0], v1[1]}), d = gelu_pk((f32x2){v1[2], v1[3]});
                        v0 = (f32x4){a.x, a.y, b.x, b.y}; v1 = (f32x4){c.x, c.y, d.x, d.y}; }
                    v0 = v0 * sc; v1 = v1 * sc; u32x4 w; w.x = cvt_pk_bf16(v0[0], v0[1]); w.y = cvt_pk_bf16(v0[2], v0[3]); w.z = cvt_pk_bf16(v1[0], v1[1]); w.w = cvt_pk_bf16(v1[2], v1[3]);
                    *(u32x4*)(rowp + bj * HALF) = w; } }
    }
};

struct EpiG1m {
    static constexpr bool PERM = true, AFTER_DRAIN = false;
    bf16_t *ug, *vg; unsigned char *qs, *kimg, *vimg; const float *qg, *kg, *rope; PG8_LAS float* xs; int pm_off, pn_off; float wi;
    __device__ __forceinline__ void operator()(const f32x4 (&acc)[2][2][4][2], const Unit& u_, int wr, int wc_, int fr_, int fq_) const {
        const Unit u{u_.pm + pm_off, u_.pn + pn_off}; const float WI = wi;
        int wc = wc_, fr = fr_, fq = fq_;
        asm volatile("" : "+s"(wc), "+v"(fr), "+v"(fq));
        const int colt = u.pn * BM;
        if (colt < 2048) {
            if (u.pm == 0) return;
            bf16_t* base = (colt < 1024) ? ug : vg; const int cbase = colt & 1023;
            const int row0 = u.pm * BM + wr * 64 + fr - 256, col0 = cbase + wc * 32 + 8 * fq;
#pragma unroll
            for (int ai = 0; ai < 2; ++ai)
#pragma unroll
                for (int m = 0; m < 4; ++m) { bf16_t* rowp = base + (size_t)(row0 + ai * HALF + m * 16) * 1024 + col0;
#pragma unroll
                    for (int bj = 0; bj < 2; ++bj) { const f32x4 v0 = acc[ai][bj][m][0], v1 = acc[ai][bj][m][1];
                        const f32x2 a = gelu_pk((f32x2){v0[0], v0[1]}), b = gelu_pk((f32x2){v0[2], v0[3]}), c = gelu_pk((f32x2){v1[0], v1[1]}), d = gelu_pk((f32x2){v1[2], v1[3]});
                        u32x4 w; w.x = cvt_pk_bf16(a.x, a.y); w.y = cvt_pk_bf16(b.x, b.y); w.z = cvt_pk_bf16(c.x, c.y); w.w = cvt_pk_bf16(d.x, d.y);
                        *(u32x4*)(rowp + bj * HALF) = w; } }
        } else if (colt < 4096) {
            const bool isq = colt < 3072;
            if (isq && u.pm == 0) return;
            const bool latent = u.pm != 0;
            const int head0 = (colt - (isq ? 2048 : 3072)) >> 7, comp = wc >> 1, cin = 32 * (wc & 1) + 8 * fq;
            const float* gn = (isq ? qg : kg) + cin;
            const f32x4 g0 = *(const f32x4*)gn, g1 = *(const f32x4*)(gn + 4);
#pragma unroll
            for (int ai = 0; ai < 2; ++ai)
#pragma unroll
                for (int m = 0; m < 4; ++m)
#pragma unroll
                    for (int bj = 0; bj < 2; ++bj) { const f32x4 v0 = acc[ai][bj][m][0], v1 = acc[ai][bj][m][1];
                        float s_ = ((v0[0] * v0[0] + v0[1] * v0[1]) + (v0[2] * v0[2] + v0[3] * v0[3])) + ((v1[0] * v1[0] + v1[1] * v1[1]) + (v1[2] * v1[2] + v1[3] * v1[3]));
                        s_ += __shfl_xor(s_, 16); s_ += __shfl_xor(s_, 32);
                        if (fq == 0) xs[((ai * HALF + wr * 64 + m * 16 + fr) * 2 + bj) * 4 + wc] = s_; }
            asm volatile("s_waitcnt lgkmcnt(0)" ::: "memory"); __builtin_amdgcn_s_barrier(); asm volatile("" ::: "memory");
            const float mul = isq ? QSCALE : 1.0f;
#pragma unroll
            for (int ai = 0; ai < 2; ++ai)
#pragma unroll
                for (int m = 0; m < 4; ++m) { const int rl = ai * HALF + wr * 64 + m * 16 + fr, row = u.pm * BM + rl, pos = row - CTX;
                    const int tp = (wc & 1) ? 256 + (pos & 63) : (pos >> 6);
                    const float* tb = rope + ((size_t)(latent ? tp : 0) * 16 + 4 * fq) * 2;
                    f32x4 t0 = *(const f32x4*)tb, t1 = *(const f32x4*)(tb + 4);
                    if (!latent) { t0 = (f32x4){1.f, 0.f, 1.f, 0.f}; t1 = t0; }
#pragma unroll
                    for (int bj = 0; bj < 2; ++bj) { const float tot = xs[(rl * 2 + bj) * 4 + wc] + xs[(rl * 2 + bj) * 4 + (wc ^ 1)];
                        const float r_ = WI / sqrtf(tot * (WI * WI / 64.0f) + EPS);
                        const f32x4 a0 = acc[ai][bj][m][0] * r_ * g0, a1 = acc[ai][bj][m][1] * r_ * g1;
                        const float e0 = (a0[0] * t0[0] - a0[1] * t0[1]) * mul, o0 = (a0[0] * t0[1] + a0[1] * t0[0]) * mul, e1 = (a0[2] * t0[2] - a0[3] * t0[3]) * mul, o1 = (a0[2] * t0[3] + a0[3] * t0[2]) * mul;
                        const float e2 = (a1[0] * t1[0] - a1[1] * t1[1]) * mul, o2 = (a1[0] * t1[1] + a1[1] * t1[0]) * mul, e3 = (a1[2] * t1[2] - a1[3] * t1[3]) * mul, o3 = (a1[2] * t1[3] + a1[3] * t1[2]) * mul;
                        int w0 = __builtin_amdgcn_cvt_pk_fp8_f32(e0, o0, 0, false); w0 = __builtin_amdgcn_cvt_pk_fp8_f32(e1, o1, w0, true);
                        int w1 = __builtin_amdgcn_cvt_pk_fp8_f32(e2, o2, 0, false); w1 = __builtin_amdgcn_cvt_pk_fp8_f32(e3, o3, w1, true);
                        const u32x2 w = {(unsigned)w0, (unsigned)w1};
                        const int head = head0 + bj;
                        if (isq) *(u32x2*)(qs + ((size_t)head * SEQ + pos) * 128 + comp * 64 + cin) = w;
                        else *(u32x2*)(kimg + ((size_t)head * NTILE + (row >> 6)) * 8192 + k8_off(row & 63, comp * 64 + cin)) = w; }
                    asm volatile("" ::: "memory"); }
        } else {
            const int row0 = u.pm * BM + wr * 64 + fr, c0 = wc * 32 + 8 * fq, head0 = (colt - 4096) >> 7;
#pragma unroll
            for (int ai = 0; ai < 2; ++ai)
#pragma unroll
                for (int m = 0; m < 4; ++m) { const int row = row0 + ai * HALF + m * 16;
#pragma unroll
                    for (int bj = 0; bj < 2; ++bj) { const f32x4 v0 = acc[ai][bj][m][0], v1 = acc[ai][bj][m][1];
                        int w0 = __builtin_amdgcn_cvt_pk_fp8_f32(v0[0] * WI, v0[1] * WI, 0, false); w0 = __builtin_amdgcn_cvt_pk_fp8_f32(v0[2] * WI, v0[3] * WI, w0, true);
                        int w1 = __builtin_amdgcn_cvt_pk_fp8_f32(v1[0] * WI, v1[1] * WI, 0, false); w1 = __builtin_amdgcn_cvt_pk_fp8_f32(v1[2] * WI, v1[3] * WI, w1, true);
                        unsigned char* ib = vimg + ((size_t)(head0 + bj) * NTILE + (row >> 6)) * 8192;
#pragma unroll
                        for (int i = 0; i < 4; ++i) { ib[v8_off(row & 63, c0 + i)] = (unsigned char)((unsigned)w0 >> (8 * i)); ib[v8_off(row & 63, c0 + 4 + i)] = (unsigned char)((unsigned)w1 >> (8 * i)); } } }
        }
    }
};
struct EpiOutm {
    static constexpr bool PERM = true, AFTER_DRAIN = false;
    const float* x; const float* g1; bf16_t* xn; float* rss;
    __device__ __forceinline__ void operator()(const f32x4 (&acc)[2][2][4][2], const Unit& u, int wr, int wc, int fr, int fq) const {
        const int row0 = u.pm * BM + wr * 64 + fr, col0 = u.pn * BM + wc * 32 + 8 * fq;
        f32x4 gv[2][2];
#pragma unroll
        for (int bj = 0; bj < 2; ++bj)
#pragma unroll
            for (int n = 0; n < 2; ++n) gv[bj][n] = *(const f32x4*)(g1 + col0 + bj * HALF + 4 * n);
#pragma unroll
        for (int ai = 0; ai < 2; ++ai)
#pragma unroll
            for (int m = 0; m < 4; ++m) { const int row = row0 + ai * HALF + m * 16; const size_t off = (size_t)row * 2048 + col0; float ss = 0.f;
#pragma unroll
                for (int bj = 0; bj < 2; ++bj) {
                    const f32x4 v0 = *(const f32x4*)(x + off + bj * HALF) + gv[bj][0] * acc[ai][bj][m][0], v1 = *(const f32x4*)(x + off + bj * HALF + 4) + gv[bj][1] * acc[ai][bj][m][1];
                    ss += ((v0[0] * v0[0] + v0[1] * v0[1]) + (v0[2] * v0[2] + v0[3] * v0[3])) + ((v1[0] * v1[0] + v1[1] * v1[1]) + (v1[2] * v1[2] + v1[3] * v1[3]));
                    u32x4 w; w.x = cvt_pk_bf16(v0[0], v0[1]); w.y = cvt_pk_bf16(v0[2], v0[3]); w.z = cvt_pk_bf16(v1[0], v1[1]); w.w = cvt_pk_bf16(v1[2], v1[3]);
                    *(u32x4*)(xn + off + bj * HALF) = w; }
                ss += __shfl_xor(ss, 16); ss += __shfl_xor(ss, 32);
                if (fq == 0) rss[(size_t)row * 32 + u.pn * 4 + wc] = ss; }
    }
};
struct EpiQp {
    static constexpr bool PERM = true, AFTER_DRAIN = false;
    bf16_t* q; const float* rss; const float* bq;
    __device__ __forceinline__ void operator()(const f32x4 (&acc)[2][2][4][2], const Unit& u, int wr, int wc, int fr, int fq) const {
        const int row0 = u.pm * BM + wr * 64 + fr, col0 = u.pn * BM + wc * 32 + 8 * fq;
        f32x4 bv[2][2];
#pragma unroll
        for (int bj = 0; bj < 2; ++bj)
#pragma unroll
            for (int n = 0; n < 2; ++n) bv[bj][n] = *(const f32x4*)(bq + col0 + bj * HALF + 4 * n);
#pragma unroll
        for (int ai = 0; ai < 2; ++ai)
#pragma unroll
            for (int m = 0; m < 4; ++m) { const int row = row0 + ai * HALF + m * 16;
                const f32x4 p0 = *(const f32x4*)(rss + (size_t)row * 32 + fq * 8), p1 = *(const f32x4*)(rss + (size_t)row * 32 + fq * 8 + 4);
                float ss = ((p0[0] + p0[1]) + (p0[2] + p0[3])) + ((p1[0] + p1[1]) + (p1[2] + p1[3]));
                ss += __shfl_xor(ss, 16); ss += __shfl_xor(ss, 32);
                const float r_ = 1.0f / sqrtf(ss * (1.0f / 2048.0f) + EPS);
                bf16_t* rowp = q + (size_t)row * 2048 + col0;
#pragma unroll
                for (int bj = 0; bj < 2; ++bj) { const f32x4 v0 = acc[ai][bj][m][0] * r_ + bv[bj][0], v1 = acc[ai][bj][m][1] * r_ + bv[bj][1];
                    u32x4 w; w.x = cvt_pk_bf16(v0[0], v0[1]); w.y = cvt_pk_bf16(v0[2], v0[3]); w.z = cvt_pk_bf16(v1[0], v1[1]); w.w = cvt_pk_bf16(v1[2], v1[3]);
                    *(u32x4*)(rowp + bj * HALF) = w; } }
    }
};
typedef int pg8_i32x4 __attribute__((ext_vector_type(4)));
template <class Epi, class Sched, bool ALIGN_EPI = false, bool SP2 = false, bool FP8 = false>
__device__ __forceinline__ void gemm_phase(PG8_LAS unsigned char* lds, const Gemm g, const Sched& S, const Epi& E) {
    const int tid = threadIdx.x, wid = __builtin_amdgcn_readfirstlane(tid >> 6), lane = tid & 63, wr = wid >> 2, wc = wid & 3, fr = lane & 15, fq = lane >> 4;
    const int K = g.K, nt = K / BK;
    unsigned voffA[2], voffB[2];
#pragma unroll
    for (int i = 0; i < 2; ++i) { int R, C; stage_rc(tid * 16 + i * 8192, R, C); const int Rb = Epi::PERM ? ((R & ~31) + perm32(R & 31)) : R;
        voffA[i] = (unsigned)(R * K + C) * 2u; voffB[i] = (unsigned)(Rb * K + C) * 2u; }
    const size_t kstep = (size_t)(BK * 2);
    const size_t hstep = (size_t)HALF * K * 2;
    const size_t tstep = 2 * hstep;
    const unsigned ldsw = (unsigned)wid * 1024u;
    const int aoff = lds_byte(wr * 64 + fr, fq * 8), boff = lds_byte(wc * 32 + fr, fq * 8);
#define PG8_SA(b, h) (((b) * 2 + (h)) * HTB)
#define PG8_SB(b, h) ((4 + (b) * 2 + (h)) * HTB)
#define PG8_STAGE(bufoff, gbase, voff) do { _Pragma("unroll") for (int _i = 0; _i < 2; ++_i) \
        __builtin_amdgcn_global_load_lds((const unsigned*)((const char*)(gbase) + (voff)[_i]), (PG8_LAS unsigned*)(lds + (bufoff) + ldsw + _i * 8192), 16, 0, 0); } while (0)
#define PG8_LDA(dst, b, h) do { _Pragma("unroll") for (int m = 0; m < 4; ++m) _Pragma("unroll") for (int k = 0; k < 2; ++k) dst[m][k] = *(const PG8_LAS bf16x8*)(lds + PG8_SA(b, h) + aoff + m * 2048 + k * 1024); } while (0)
#define PG8_LDB(dst, b, h) do { _Pragma("unroll") for (int n = 0; n < 2; ++n) _Pragma("unroll") for (int k = 0; k < 2; ++k) dst[n][k] = *(const PG8_LAS bf16x8*)(lds + PG8_SB(b, h) + boff + n * 2048 + k * 1024); } while (0)
#define PG8_CAT(X) __builtin_shufflevector(__builtin_bit_cast(pg8_i32x4, X[0]), __builtin_bit_cast(pg8_i32x4, X[1]), 0, 1, 2, 3, 4, 5, 6, 7)
#define PG8_MMA(ai, bj, At, Bt) do { __builtin_amdgcn_s_setprio(1); _Pragma("unroll") for (int m = 0; m < 4; ++m) _Pragma("unroll") for (int n = 0; n < 2; ++n) { \
        if constexpr (FP8) asm volatile("v_mfma_f32_16x16x128_f8f6f4 %0, %1, %2, %0" : "+v"(acc[ai][bj][m][n]) : "v"(PG8_CAT(Bt[n])), "v"(PG8_CAT(At[m])));   \
        else { _Pragma("unroll") for (int k = 0; k < 2; ++k) acc[ai][bj][m][n] = __builtin_amdgcn_mfma_f32_16x16x32_bf16(Bt[n][k], At[m][k], acc[ai][bj][m][n], 0, 0, 0); } } __builtin_amdgcn_s_setprio(0); } while (0)
#define PG8_WAIT_V(n) asm volatile("s_waitcnt vmcnt(" #n ")" ::: "memory")
#define PG8_WAIT_L(n) asm volatile("s_waitcnt lgkmcnt(" #n ")" ::: "memory")
#define PG8_BAR __builtin_amdgcn_s_barrier()
#define PG8_SCHED __builtin_amdgcn_sched_barrier(0)
    Unit cur, nxt; int ui = 0;
    if (!S.next(0, cur)) return;
    f32x4 acc[2][2][4][2];
#pragma unroll
    for (int a = 0; a < 2; ++a)
#pragma unroll
        for (int b = 0; b < 2; ++b)
#pragma unroll
            for (int m = 0; m < 4; ++m)
#pragma unroll
                for (int n = 0; n < 2; ++n) acc[a][b][m][n] = (f32x4){0.f, 0.f, 0.f, 0.f};
    bf16x8 At[4][2], B0[2][2], B1[2][2];
    const char* cA = (const char*)g.A + (size_t)cur.pm * tstep; const char* cB = (const char*)g.Bt + (size_t)cur.pn * tstep;
    S.a_ready(cur);
    if constexpr (SP2) {
        PG8_STAGE(PG8_SB(0, 0), cB, voffB); PG8_STAGE(PG8_SB(0, 1), cB + hstep, voffB); PG8_STAGE(PG8_SA(0, 0), cA, voffA); PG8_STAGE(PG8_SA(0, 1), cA + hstep, voffA);
        if (wr == 1) PG8_BAR;
        PG8_WAIT_V(2); PG8_BAR;
        PG8_STAGE(PG8_SB(1, 0), cB + kstep, voffB); PG8_STAGE(PG8_SA(1, 0), cA + kstep, voffA); PG8_STAGE(PG8_SB(1, 1), cB + hstep + kstep, voffB);
        PG8_WAIT_V(6); PG8_BAR;
    } else {
        PG8_STAGE(PG8_SB(0, 0), cB, voffB); PG8_STAGE(PG8_SA(0, 0), cA, voffA); PG8_STAGE(PG8_SB(0, 1), cB + hstep, voffB); PG8_STAGE(PG8_SA(0, 1), cA + hstep, voffA);
        if (wr == 1) PG8_BAR;
        PG8_WAIT_V(4); PG8_BAR;
        PG8_STAGE(PG8_SB(1, 0), cB + kstep, voffB); PG8_STAGE(PG8_SA(1, 0), cA + kstep, voffA); PG8_STAGE(PG8_SB(1, 1), cB + hstep + kstep, voffB);
        PG8_WAIT_V(6); PG8_BAR;
    }
    for (;;) {
        const bool has_next = S.next(ui + 1, nxt);
        const char* nA = has_next ? (const char*)g.A + (size_t)nxt.pm * tstep : cA; const char* nB = has_next ? (const char*)g.Bt + (size_t)nxt.pn * tstep : cB;
        for (int t = 0; t < nt; t += 2) {
            const bool last = (t == nt - 2);
            const char* a1 = cA + (size_t)(t + 1) * kstep;
            const char* a2 = last ? nA : cA + (size_t)(t + 2) * kstep; const char* b2 = last ? nB : cB + (size_t)(t + 2) * kstep;
            const char* a3 = a2 + kstep; const char* b3 = b2 + kstep;
            if (last && has_next) S.a_ready(nxt);
            if constexpr (SP2) {
            PG8_LDB(B0, 0, 0); PG8_LDB(B1, 0, 1); PG8_SCHED; PG8_LDA(At, 0, 0); PG8_STAGE(PG8_SA(1, 1), a1 + hstep, voffA);
            PG8_WAIT_V(8); PG8_WAIT_L(0); PG8_BAR; PG8_MMA(0, 0, At, B0); PG8_MMA(0, 1, At, B1); PG8_BAR; PG8_SCHED;
            PG8_LDA(At, 0, 1); PG8_STAGE(PG8_SB(0, 0), b2, voffB); PG8_STAGE(PG8_SB(0, 1), b2 + hstep, voffB); PG8_STAGE(PG8_SA(0, 0), a2, voffA);
            PG8_WAIT_V(8); PG8_WAIT_L(0); PG8_BAR; PG8_MMA(1, 0, At, B0); PG8_MMA(1, 1, At, B1); PG8_BAR; PG8_SCHED;
            PG8_LDB(B0, 1, 0); PG8_LDB(B1, 1, 1); PG8_SCHED; PG8_LDA(At, 1, 0); PG8_STAGE(PG8_SA(0, 1), a2 + hstep, voffA);
            PG8_WAIT_V(8); PG8_WAIT_L(0); PG8_BAR; PG8_MMA(0, 0, At, B0); PG8_MMA(0, 1, At, B1); PG8_BAR; PG8_SCHED;
            PG8_LDA(At, 1, 1); PG8_STAGE(PG8_SB(1, 0), b3, voffB); PG8_STAGE(PG8_SB(1, 1), b3 + hstep, voffB); PG8_STAGE(PG8_SA(1, 0), a3, voffA);
            PG8_WAIT_V(8); PG8_WAIT_L(0); PG8_BAR; PG8_MMA(1, 0, At, B0); PG8_MMA(1, 1, At, B1); PG8_BAR; PG8_SCHED;
            } else {
            PG8_LDB(B0, 0, 0); PG8_SCHED; PG8_LDA(At, 0, 0); PG8_STAGE(PG8_SA(1, 1), a1 + hstep, voffA);
            PG8_WAIT_L(8); PG8_BAR; PG8_WAIT_L(0); PG8_MMA(0, 0, At, B0); PG8_BAR; PG8_SCHED;
            PG8_LDB(B1, 0, 1); PG8_STAGE(PG8_SB(0, 0), b2, voffB);
            PG8_BAR; PG8_WAIT_L(0); PG8_MMA(0, 1, At, B1); PG8_BAR;
            PG8_LDA(At, 0, 1); PG8_STAGE(PG8_SA(0, 0), a2, voffA);
            PG8_BAR; PG8_WAIT_L(0); PG8_MMA(1, 0, At, B0); PG8_BAR; PG8_SCHED;
            PG8_STAGE(PG8_SB(0, 1), b2 + hstep, voffB);
            PG8_WAIT_V(6); PG8_BAR; PG8_MMA(1, 1, At, B1); PG8_BAR;
            PG8_LDB(B0, 1, 0); PG8_SCHED; PG8_LDA(At, 1, 0); PG8_STAGE(PG8_SA(0, 1), a2 + hstep, voffA);
            PG8_WAIT_L(8); PG8_BAR; PG8_WAIT_L(0); PG8_MMA(0, 0, At, B0); PG8_BAR; PG8_SCHED;
            PG8_LDB(B1, 1, 1); PG8_STAGE(PG8_SB(1, 0), b3, voffB);
            PG8_BAR; PG8_WAIT_L(0); PG8_MMA(0, 1, At, B1); PG8_BAR;
            PG8_LDA(At, 1, 1); PG8_STAGE(PG8_SA(1, 0), a3, voffA);
            PG8_BAR; PG8_WAIT_L(0); PG8_MMA(1, 0, At, B0); PG8_BAR; PG8_SCHED;
            PG8_STAGE(PG8_SB(1, 1), b3 + hstep, voffB);
            PG8_WAIT_V(6); PG8_BAR; PG8_MMA(1, 1, At, B1); PG8_BAR;
            }
        }
        if constexpr (ALIGN_EPI) { if (wr == 0) PG8_BAR; }
        if constexpr (FP8) asm volatile("s_nop 15\n\ts_nop 15" ::: "memory");
        if constexpr (!Epi::AFTER_DRAIN) { E(acc, cur, wr, wc, fr, fq); S.done(cur); }
        if (!has_next) break;
#pragma unroll
        for (int a = 0; a < 2; ++a)
#pragma unroll
            for (int b = 0; b < 2; ++b)
#pragma unroll
                for (int m = 0; m < 4; ++m)
#pragma unroll
                    for (int n = 0; n < 2; ++n) acc[a][b][m][n] = (f32x4){0.f, 0.f, 0.f, 0.f};
        cur = nxt; cA = nA; cB = nB; ++ui;
        if constexpr (ALIGN_EPI) { if (wr == 1) PG8_BAR; }
    }
    PG8_WAIT_V(0);
    if constexpr (!ALIGN_EPI) { if (wr == 0) PG8_BAR; }
    PG8_BAR;
    if constexpr (Epi::AFTER_DRAIN) { E.fused(acc, cur, wr, wc, fr, fq, lds, wid, lane); S.done(cur); }
#undef PG8_SA
#undef PG8_SB
#undef PG8_STAGE
#undef PG8_LDA
#undef PG8_LDB
#undef PG8_MMA
#undef PG8_CAT
#undef PG8_WAIT_V
#undef PG8_WAIT_L
#undef PG8_BAR
#undef PG8_SCHED
}
}


#define LAS __attribute__((address_space(3)))
namespace att {
using bf16x8 = __attribute__((ext_vector_type(8))) short;
using s16x4 = __attribute__((ext_vector_type(4))) short;
#define KSWZ(row, colB) ((row) * 256 + ((colB) ^ (((row) & 15) << 4)))
__device__ __forceinline__ int crow(int r, int hi) { return (r & 3) + 8 * (r >> 2) + 4 * hi; }
__device__ __forceinline__ int v_rd_base(int lane) { return ((lane & 3) << 3) | (((lane >> 2) & 3) << 6) | (((lane >> 4) & 1) << 5) | (((lane >> 5) & 1) << 8); }
constexpr int v_rd_off(int d0, int ks, int half) { return d0 * 512 + ks * 4096 + half * 2048; }
template <int OFF> __device__ __forceinline__ s16x4 tr_read(int vb) { s16x4 r; asm volatile("ds_read_b64_tr_b16 %0, %1 offset:%2" : "=&v"(r) : "v"(vb), "i"(OFF) : "memory"); return r; }
typedef __attribute__((address_space(3))) const char* lds_cptr;
typedef short v4i16_t __attribute__((ext_vector_type(4)));
typedef float f32x2_t __attribute__((ext_vector_type(2)));
typedef __bf16 bf16x2_t __attribute__((ext_vector_type(2)));
__device__ __forceinline__ void glds16(const void* gsrc, unsigned lds_dst) { unsigned keep;
    asm volatile("s_mov_b32 %0, m0\n\ts_mov_b32 m0, %2\n\ts_nop 0\n\tglobal_load_lds_dwordx4 %1, off\n\ts_mov_b32 m0, %0" : "=&s"(keep) : "v"(gsrc), "s"(lds_dst) : "memory"); }
typedef int i32x8 __attribute__((ext_vector_type(8)));
typedef int i32x4v __attribute__((ext_vector_type(4)));
__device__ __forceinline__ i32x8 ld32(lds_cptr a, lds_cptr b) { const i32x4v x = *(const LAS i32x4v*)a, y = *(const LAS i32x4v*)b; return (i32x8){x[0], x[1], x[2], x[3], y[0], y[1], y[2], y[3]}; }
__device__ __forceinline__ void attn_unit8(const Params& p, int h, int qb, char* lds) {
    int tid = threadIdx.x;
    asm volatile("" : "+v"(tid));
    const int wid = tid >> 6, lane = tid & 63, r32 = lane & 31, hi = lane >> 5;
    constexpr int A8_V = 0, A8_K = 49152, A8_Q = 98304, A8_WS = 131072;
    const int vs = (r32 >> 2) & 3, lb = (int)(uintptr_t)lds;
    const int vo0 = lb + r32 * 64 + (((2 * hi) ^ vs) << 4), vo1 = lb + r32 * 64 + (((2 * hi + 1) ^ vs) << 4);
    const int qv0 = vo0 + A8_Q + wid * 4096, qv1 = vo1 + A8_Q + wid * 4096;
    {   const unsigned char* Qw = P_QS8(p) + ((size_t)h * SEQ + (size_t)qb * 256 + wid * 32 + r32) * 128 + hi * 32;
        const i32x4v a0 = *(const i32x4v*)Qw, a1 = *(const i32x4v*)(Qw + 16), b0 = *(const i32x4v*)(Qw + 64), b1 = *(const i32x4v*)(Qw + 80);
        *(LAS i32x4v*)(uintptr_t)(unsigned)qv0 = a0; *(LAS i32x4v*)(uintptr_t)(unsigned)qv1 = a1; *(LAS i32x4v*)(uintptr_t)(unsigned)(qv0 + 2048) = b0; *(LAS i32x4v*)(uintptr_t)(unsigned)(qv1 + 2048) = b1;
    }
    const unsigned char* kimg = P_KIMG8(p) + (size_t)h * NTILE * 8192 + tid * 16;
    const unsigned char* vimg = P_VIMG8(p) + (size_t)h * NTILE * 8192 + tid * 16;
    const unsigned ldsw = (unsigned)__builtin_amdgcn_readfirstlane(wid) * 1024u;
    const unsigned kdst = (unsigned)(uintptr_t)(lds + A8_K) + ldsw, vdst = (unsigned)(uintptr_t)(lds + A8_V) + ldsw;
#define GLDSK(t, b) do { const size_t o_ = (size_t)(t) * 16384; _Pragma("unroll") for (int i_ = 0; i_ < 2; ++i_) glds16(kimg + o_ + i_ * 8192, (unsigned)__builtin_amdgcn_readfirstlane(kdst + (b) * 16384 + i_ * 8192)); } while (0)
#define GLDSV(t, b) do { const size_t o_ = (size_t)(t) * 16384; _Pragma("unroll") for (int i_ = 0; i_ < 2; ++i_) glds16(vimg + o_ + i_ * 8192, (unsigned)__builtin_amdgcn_readfirstlane(vdst + (b) * 16384 + i_ * 8192)); } while (0)
    f32x16 oA[4], oB[4]; f32x4 lAc = {0.f, 0.f, 0.f, 0.f}, lBc = {0.f, 0.f, 0.f, 0.f};
    i32x8 onesB; { const int ow = (((lane & 15) == 0 && !((lane >> 4) & 1)) || ((lane & 15) == 1 && ((lane >> 4) & 1))) ? 0x38383838 : 0;
#pragma unroll
        for (int i = 0; i < 8; ++i) onesB[i] = ow; }
#pragma unroll
    for (int d = 0; d < 4; ++d) { oA[d] = f32x16{}; oB[d] = f32x16{}; }
    f32x16 sA0, sA1, sB0, sB1; i32x8 pA = {}, pB = {}, kx, ky, vx, vy, qA, qB;
#define SB() __builtin_amdgcn_sched_barrier(0)
#define RD(a0_, a1_, imm_) ld32((lds_cptr)(uintptr_t)(unsigned)((a0_) + (imm_)), (lds_cptr)(uintptr_t)(unsigned)((a1_) + (imm_)))
#define MMS(A_, B_) __builtin_amdgcn_mfma_scale_f32_32x32x64_f8f6f4(A_, B_, f32x16{}, 0, 0, 0, 0, 0, 0)
#define MMO(ACC, A_, B_) ACC = __builtin_amdgcn_mfma_scale_f32_32x32x64_f8f6f4(A_, B_, ACC, 1, 0, 0, 0, 0, 0)
#define EX4(S, B) do { S[B] = __builtin_amdgcn_exp2f(S[B]); S[B + 1] = __builtin_amdgcn_exp2f(S[B + 1]); S[B + 2] = __builtin_amdgcn_exp2f(S[B + 2]); S[B + 3] = __builtin_amdgcn_exp2f(S[B + 3]); } while (0)
#define MML(ACC, A_) ACC = __builtin_amdgcn_mfma_scale_f32_16x16x128_f8f6f4(A_, onesB, ACC, 1, 0, 0, 0, 0, 0)
#define PK4(S, B, OUT, I) do { OUT[I] = __builtin_amdgcn_cvt_pk_bf8_f32(S[B], S[B + 1], OUT[I], false); OUT[I] = __builtin_amdgcn_cvt_pk_bf8_f32(S[B + 2], S[B + 3], OUT[I], true); } while (0)
#define HALFE(S, O, P, I) do { EX4(S, O); EX4(S, (O) + 4); PK4(S, O, P, I); PK4(S, (O) + 4, P, (I) + 1); } while (0)
#define GROUPP(C0, C1, KI, VI, Q0, Q1, QI, N0, N1, NI, D1, D2, D3, D4) do { \
          vx = RD(Q0, Q1, (QI)); vy = RD(Q0, Q1, (QI) + 2048); SB(); sB0 = MMS(kx, qB); SB(); \
          MML(lBc, pB); MMO(oB[0], pB, vx); HALFE(sA0, 0, pA, 0); D1; SB(); \
          vx = RD(Q0, Q1, (QI) + 4096); SB(); MMO(oB[1], pB, vy); HALFE(sA0, 8, pA, 2); SB(); \
          vy = RD(Q0, Q1, (QI) + 6144); ky = RD(C0, C1, (KI) + 4096 + 2048); SB(); MMO(oB[2], pB, vx); HALFE(sA1, 0, pA, 4); D2; SB(); \
          vx = RD(C0, C1, (VI)); SB(); MMO(oB[3], pB, vy); sB1 = MMS(ky, qB); HALFE(sA1, 8, pA, 6); SB(); \
          vy = RD(C0, C1, (VI) + 2048); SB(); MML(lAc, pA); MMO(oA[0], pA, vx); D3; SB(); \
          vx = RD(C0, C1, (VI) + 4096); SB(); MMO(oA[1], pA, vy); HALFE(sB0, 0, pB, 0); SB(); \
          vy = RD(C0, C1, (VI) + 6144); kx = RD(N0, N1, (NI)); qA = RD(qv0, qv1, 0); SB(); MMO(oA[2], pA, vx); HALFE(sB0, 8, pB, 2); D4; SB(); \
          ky = RD(N0, N1, (NI) + 2048); SB(); MMO(oA[3], pA, vy); sA0 = MMS(kx, qA); HALFE(sB1, 0, pB, 4); SB(); \
          kx = RD(N0, N1, (NI) + 4096); qB = RD(qv0, qv1, 2048); SB(); sA1 = MMS(ky, qA); HALFE(sB1, 8, pB, 6); \
        asm volatile("" : "+v"(pB));        \
        SB(); } while (0)
    GLDSK(0, 0); GLDSV(0, 0); GLDSK(1, 1); GLDSV(1, 1);
    asm volatile("s_waitcnt vmcnt(0)" ::: "memory"); __syncthreads();
    int bcur = 0;
    int cb0 = vo0, cb1 = vo1;
    kx = RD(cb0, cb1, A8_K); ky = RD(cb0, cb1, A8_K + 2048); qA = RD(qv0, qv1, 0); sA0 = MMS(kx, qA); sA1 = MMS(ky, qA); SB();
    kx = RD(cb0, cb1, A8_K + 4096); qB = RD(qv0, qv1, 2048); SB();
    for (int j = 0; j < NTILE / 2; ++j) {
        const int bnx = (bcur == 2) ? 0 : bcur + 1, bn2 = (bnx == 2) ? 0 : bnx + 1;
        const int dprev = (j == 0) ? 0 : ((bcur == 0) ? 32768 : -16384), dnext = (bcur == 2) ? -32768 : 16384;
        {   int pb0 = cb0 + dprev, pb1 = cb1 + dprev;
            asm volatile("" : "+v"(pb0), "+v"(pb1));
            GROUPP(cb0, cb1, A8_K, A8_V, pb0, pb1, A8_V + 8192, cb0, cb1, A8_K + 8192, (void)0, (void)0, (void)0, (void)0); }
        asm volatile("s_waitcnt vmcnt(0)" ::: "memory"); __syncthreads();
        {
            const int tl = (j + 2 < NTILE / 2) ? j + 2 : NTILE / 2 - 1; const size_t to_ = (size_t)tl * 16384;
            const unsigned kd_ = (unsigned)__builtin_amdgcn_readfirstlane(kdst + bn2 * 16384), vd_ = (unsigned)__builtin_amdgcn_readfirstlane(vdst + bn2 * 16384);
            int nb0 = cb0 + dnext, nb1 = cb1 + dnext;
            asm volatile("" : "+v"(nb0), "+v"(nb1));
            GROUPP(cb0, cb1, A8_K + 8192, A8_V + 8192, cb0, cb1, A8_V, nb0, nb1, A8_K,
                   glds16(kimg + to_, kd_), glds16(kimg + to_ + 8192, kd_ + 8192), glds16(vimg + to_, vd_), glds16(vimg + to_ + 8192, vd_ + 8192));
            cb0 = nb0; cb1 = nb1; }
        bcur = bnx;
    }
    asm volatile("s_waitcnt vmcnt(0)" ::: "memory");
    {   const int dl = (bcur == 0) ? 32768 : -16384; const int pb0 = cb0 + dl, pb1 = cb1 + dl;
        vx = RD(pb0, pb1, A8_V + 8192); vy = RD(pb0, pb1, A8_V + 8192 + 2048); MML(lBc, pB); MMO(oB[0], pB, vx); MMO(oB[1], pB, vy); SB();
        vx = RD(pb0, pb1, A8_V + 8192 + 4096); vy = RD(pb0, pb1, A8_V + 8192 + 6144); MMO(oB[2], pB, vx); MMO(oB[3], pB, vy); }
    __syncthreads();
#undef SB
#undef RD
#undef MMS
#undef MMO
#undef EX4
#undef MML
#undef PK4
#undef HALFE
#undef GROUPP
#undef GLDSK
#undef GLDSV
    int tide = threadIdx.x;
    asm volatile("" : "+v"(tide));
    const int r32e = tide & 31, hie = (tide >> 5) & 1, wide = tide >> 6;
    const float lam = P_SCAL(p)[0];
    float* wsf = (float*)(lds + A8_WS) + wide * 64;
    {   const int lq = 16 * (r32e & 15) + 4 * ((r32e >> 4) + 2 * hie);
        if ((r32e & 15) <= 1) {
#pragma unroll
            for (int r = 0; r < 4; ++r) { wsf[lq + r] = __builtin_amdgcn_rcpf(lAc[r]); wsf[32 + lq + r] = lam * __builtin_amdgcn_rcpf(lBc[r]); } } }
    asm volatile("s_waitcnt lgkmcnt(0)" ::: "memory");
    const unsigned tb = (unsigned)(uintptr_t)lds + (unsigned)wide * 8192u;
    const float g0 = p.subln_g[r32e] * (1.0f - LAM_INIT), g1 = p.subln_g[32 + r32e] * (1.0f - LAM_INIT), g2 = p.subln_g[64 + r32e] * (1.0f - LAM_INIT), g3 = p.subln_g[96 + r32e] * (1.0f - LAM_INIT);
#define DPPQ(v_, ctl_) __builtin_bit_cast(float, __builtin_amdgcn_update_dpp(0, __builtin_bit_cast(int, v_), ctl_, 0xF, 0xF, true))
#pragma unroll
    for (int r = 0; r < 16; ++r) { const float ra = wsf[crow(r, hie)], rb2 = wsf[32 + crow(r, hie)];
        const float y0 = oA[0][r] * ra - oB[0][r] * rb2, y1 = oA[1][r] * ra - oB[1][r] * rb2, y2 = oA[2][r] * ra - oB[2][r] * rb2, y3 = oA[3][r] * ra - oB[3][r] * rb2;
        float q = (y0 * y0 + y1 * y1) + (y2 * y2 + y3 * y3);
        q += DPPQ(q, 0xB1); q += DPPQ(q, 0x4E); q += DPPQ(q, 0x141); q += DPPQ(q, 0x140);
        q += __builtin_bit_cast(float, __builtin_amdgcn_ds_swizzle(__builtin_bit_cast(int, q), 0x401F));
        const float rs = __builtin_amdgcn_rsqf(q * (1.0f / 128.0f) + EPS);
        const unsigned ta = tb + (unsigned)crow(r, hie) * 256u + (unsigned)r32e * 2u;
        *(LAS bf16_t*)(uintptr_t)ta = (bf16_t)f2bf(y0 * rs * g0); *(LAS bf16_t*)(uintptr_t)(ta + 64u) = (bf16_t)f2bf(y1 * rs * g1);
        *(LAS bf16_t*)(uintptr_t)(ta + 128u) = (bf16_t)f2bf(y2 * rs * g2); *(LAS bf16_t*)(uintptr_t)(ta + 192u) = (bf16_t)f2bf(y3 * rs * g3); }
#undef DPPQ
    asm volatile("s_waitcnt lgkmcnt(0)" ::: "memory");
    {   bf16_t* Ob = P_A2(p) + ((size_t)qb * 256 + (size_t)wide * 32) * 2048 + 1024 + h * 128;
        const int lanee = tide & 63;
#pragma unroll
        for (int i = 0; i < 8; ++i) { const int c = lanee + 64 * i, row = c >> 4, cc = c & 15;
            const u32x4 w_ = *(const LAS u32x4*)(uintptr_t)(tb + (unsigned)c * 16u);
            *(u32x4*)(Ob + (size_t)row * 2048 + cc * 8) = w_; } }
    __syncthreads();
}
#undef KSWZ
}

namespace gm {
using att::bf16x8; using att::s16x4;
template <int D0> __device__ __forceinline__ void mm_half(f32x16& o, int vb, const bf16x8* pa) {
    const s16x4 l0 = att::tr_read<att::v_rd_off(D0, 0, 0)>(vb), h0 = att::tr_read<att::v_rd_off(D0, 0, 1)>(vb), l1 = att::tr_read<att::v_rd_off(D0, 1, 0)>(vb), h1 = att::tr_read<att::v_rd_off(D0, 1, 1)>(vb);
    const s16x4 l2 = att::tr_read<att::v_rd_off(D0, 2, 0)>(vb), h2 = att::tr_read<att::v_rd_off(D0, 2, 1)>(vb), l3 = att::tr_read<att::v_rd_off(D0, 3, 0)>(vb), h3 = att::tr_read<att::v_rd_off(D0, 3, 1)>(vb);
    asm volatile("s_waitcnt lgkmcnt(0)" ::: "memory"); __builtin_amdgcn_sched_barrier(0);
#define PKV(L, H) (bf16x8){L[0], L[1], L[2], L[3], H[0], H[1], H[2], H[3]}
    o = __builtin_amdgcn_mfma_f32_32x32x16_bf16(pa[0], PKV(l0, h0), o, 0, 0, 0);
    o = __builtin_amdgcn_mfma_f32_32x32x16_bf16(pa[1], PKV(l1, h1), o, 0, 0, 0);
    o = __builtin_amdgcn_mfma_f32_32x32x16_bf16(pa[2], PKV(l2, h2), o, 0, 0, 0);
    o = __builtin_amdgcn_mfma_f32_32x32x16_bf16(pa[3], PKV(l3, h3), o, 0, 0, 0);
#undef PKV
}
__device__ __forceinline__ void gmlp_unit(const Params& p, int n, int g, char* lds) {
    int tid = threadIdx.x; asm volatile("" : "+v"(tid));
    const int wid = tid >> 6, lane = tid & 63, r32 = lane & 31, hi = lane >> 5;
    {
        const int q = tid >> 2, cq = tid & 3;
        const bf16_t* src = P_VG(p) + ((size_t)n * 128 + q) * 1024 + g * 128 + cq * 32;
        float xv[32];
#pragma unroll
        for (int i = 0; i < 4; ++i) { const u32x4 w = *(const u32x4*)(src + i * 8); const unsigned ws_[4] = {w.x, w.y, w.z, w.w};
#pragma unroll
            for (int k = 0; k < 4; ++k) { xv[i * 8 + 2 * k] = __uint_as_float(ws_[k] << 16); xv[i * 8 + 2 * k + 1] = __uint_as_float(ws_[k] & 0xffff0000u); } }
        float sm = 0.f;
#pragma unroll
        for (int i = 0; i < 32; ++i) sm += xv[i];
        sm += __shfl_xor(sm, 1); sm += __shfl_xor(sm, 2);
        const float mu = sm * (1.0f / 128.0f); float var = 0.f;
#pragma unroll
        for (int i = 0; i < 32; ++i) { xv[i] -= mu; var += xv[i] * xv[i]; }
        var += __shfl_xor(var, 1); var += __shfl_xor(var, 2);
        const float rs = 1.0f / sqrtf(var * (1.0f / 128.0f) + EPS);
        const float* lg = p.gmlp_ln_g + g * 128 + cq * 32;
        char* img = lds + (q >> 6) * 16384;
#pragma unroll
        for (int i = 0; i < 4; ++i) { u32x4 o;
            o.x = pk2(xv[i * 8 + 0] * rs * lg[i * 8 + 0], xv[i * 8 + 1] * rs * lg[i * 8 + 1]); o.y = pk2(xv[i * 8 + 2] * rs * lg[i * 8 + 2], xv[i * 8 + 3] * rs * lg[i * 8 + 3]);
            o.z = pk2(xv[i * 8 + 4] * rs * lg[i * 8 + 4], xv[i * 8 + 5] * rs * lg[i * 8 + 5]); o.w = pk2(xv[i * 8 + 6] * rs * lg[i * 8 + 6], xv[i * 8 + 7] * rs * lg[i * 8 + 7]);
            *(u32x4*)(img + v_img_off(q & 63, cq * 32 + i * 8)) = o; }
    }
    __syncthreads();
    const int pb = wid >> 1, d0b = (wid & 1) * 2;
    bf16x8 pa[8];
    const bf16_t* wsg = (const bf16_t*)(p.ws + WS_GWS) + ((size_t)g * 128 + pb * 32 + r32) * 128 + hi * 8;
#pragma unroll
    for (int ks = 0; ks < 8; ++ks) pa[ks] = *reinterpret_cast<const bf16x8*>(wsg + ks * 16);
    f32x16 o0 = f32x16{}, o1 = f32x16{};
    const int vb = (int)(uintptr_t)lds + att::v_rd_base(lane) + d0b * 512;
    mm_half<0>(o0, vb, pa); mm_half<1>(o1, vb, pa);
    mm_half<0>(o0, vb + 16384, pa + 4); mm_half<1>(o1, vb + 16384, pa + 4);
#pragma unroll
    for (int r = 0; r < 16; ++r) { const int prow = pb * 32 + att::crow(r, hi); const float bsv = p.gmlp_bs[g * 128 + prow];
        const size_t row = (size_t)n * 128 + prow; const int col = g * 128 + d0b * 32 + r32;
        const float u0 = bf2f(P_UG(p)[row * 1024 + col]), u1 = bf2f(P_UG(p)[row * 1024 + col + 32]);
        P_A2(p)[row * 2048 + col] = (bf16_t)f2bf(u0 * (o0[r] + bsv)); P_A2(p)[row * 2048 + col + 32] = (bf16_t)f2bf(u1 * (o1[r] + bsv)); }
    __syncthreads();
}
}

namespace peer {
typedef __bf16 bf16x2_t __attribute__((ext_vector_type(2)));
__device__ __forceinline__ float fmax_s(float a, float b) { float r; asm("v_max_f32 %0, %1, %2" : "=v"(r) : "v"(a), "v"(b)); return r; }
__device__ __forceinline__ float fmin_s(float a, float b) { float r; asm("v_min_f32 %0, %1, %2" : "=v"(r) : "v"(a), "v"(b)); return r; }
__device__ __forceinline__ void ce_desc(float& a, float& b) { const float mx = fmax_s(a, b), mn = fmin_s(a, b); a = mx; b = mn; }
__device__ __forceinline__ void ce_asc(float& a, float& b) { const float mx = fmax_s(a, b), mn = fmin_s(a, b); a = mn; b = mx; }
__device__ __forceinline__ void sort16_desc(float* v) {
#pragma unroll
    for (int k = 2; k <= 16; k <<= 1)
#pragma unroll
        for (int j = k >> 1; j > 0; j >>= 1)
#pragma unroll
            for (int i = 0; i < 16; ++i) { const int l = i ^ j; if (l > i) { if ((i & k) == 0) ce_desc(v[i], v[l]); else ce_asc(v[i], v[l]); } }
}
__device__ __forceinline__ void merge_top16(float* a, const float* b) {
#pragma unroll
    for (int i = 0; i < 16; ++i) a[i] = fmax_s(a[i], b[15 - i]);
#pragma unroll
    for (int j = 8; j > 0; j >>= 1)
#pragma unroll
        for (int i = 0; i < 16; ++i) { const int l = i ^ j; if (l > i) ce_desc(a[i], a[l]); }
}
__device__ __forceinline__ void top16_of_64(float* v) {
    sort16_desc(v); sort16_desc(v + 16); sort16_desc(v + 32); sort16_desc(v + 48);
    merge_top16(v, v + 16); merge_top16(v + 32, v + 48); merge_top16(v, v + 32);
}
__device__ __forceinline__ float dot2(unsigned a, unsigned b, float acc) { return __builtin_amdgcn_fdot2_f32_bf16(__builtin_bit_cast(bf16x2_t, a), __builtin_bit_cast(bf16x2_t, b), acc, false); }
__device__ __forceinline__ float wave_sum_dpp(float v) {
    v += __builtin_bit_cast(float, __builtin_amdgcn_update_dpp(0, __builtin_bit_cast(int, v), 0xB1, 0xF, 0xF, true));
    v += __builtin_bit_cast(float, __builtin_amdgcn_update_dpp(0, __builtin_bit_cast(int, v), 0x4E, 0xF, 0xF, true));
    v += __builtin_bit_cast(float, __builtin_amdgcn_update_dpp(0, __builtin_bit_cast(int, v), 0x141, 0xF, 0xF, true));
    v += __builtin_bit_cast(float, __builtin_amdgcn_update_dpp(0, __builtin_bit_cast(int, v), 0x140, 0xF, 0xF, true));
    const int vi = __builtin_bit_cast(int, v);
    const float a = __builtin_bit_cast(float, __builtin_amdgcn_readlane(vi, 0)), b = __builtin_bit_cast(float, __builtin_amdgcn_readlane(vi, 16));
    const float c = __builtin_bit_cast(float, __builtin_amdgcn_readlane(vi, 32)), d = __builtin_bit_cast(float, __builtin_amdgcn_readlane(vi, 48));
    return (a + b) + (c + d);
}
__device__ __forceinline__ float gelu_as(float v) {
    const float av = fabsf(v), t = __builtin_amdgcn_rcpf(av * 0.2316418882f + 1.0f);
    float q = t * 0.5307027145f + (-0.7265760135f); q = q * t + 0.7107068705f; q = q * t + (-0.142248368f); q = q * t + 0.127414796f; q = q * t;
    const float e = __builtin_amdgcn_exp2f((v * v) * (-0.72134752044f));
    const float m = v * (q * e);
    return v < 0.f ? m : v - m;
}
constexpr int PEER_TOK = 32;
__device__ __forceinline__ void peer_unit(const Params& p, int u, char* lds) {
    int tid = threadIdx.x; asm volatile("" : "+v"(tid));
    const int wid = tid >> 6, lane = tid & 63, r32 = lane & 31, hi = lane >> 5;
    constexpr int KS = 136;
    int* IDXl = (int*)lds; float* GATEl = (float*)(lds + 32 * KS * 4); int* SCR = (int*)(lds + 2 * 32 * KS * 4) + wid * 1024;
    const int t0 = u * PEER_TOK;
    {
        const int h = wid;
        float sab[2][16];
#pragma unroll
        for (int c = 0; c < 2; ++c) {
            f32x16 acc[4];
#pragma unroll
            for (int nb = 0; nb < 4; ++nb) acc[nb] = f32x16{};
            const bf16_t* qrow = P_QP(p) + (size_t)(t0 + r32) * 2048 + h * 256 + c * 128 + hi * 8;
            const bf16_t* krow = (const bf16_t*)(p.ws + WS_KEYS) + ((size_t)(h * 2 + c) * 128 + r32) * 128 + hi * 8;
#pragma unroll
            for (int ks = 0; ks < 8; ++ks) {
                const bf16x8 bq = *reinterpret_cast<const bf16x8*>(qrow + ks * 16);
#pragma unroll
                for (int nb = 0; nb < 4; ++nb) { const bf16x8 ak = *reinterpret_cast<const bf16x8*>(krow + nb * 32 * 128 + ks * 16);
                    acc[nb] = __builtin_amdgcn_mfma_f32_32x32x16_bf16(ak, bq, acc[nb], 0, 0, 0); }
            }
            float v[64];
#pragma unroll
            for (int nb = 0; nb < 4; ++nb)
#pragma unroll
                for (int r = 0; r < 16; ++r) { const unsigned cn = (unsigned)(32 * nb + (r & 3) + 8 * (r >> 2));
                    v[nb * 16 + r] = __uint_as_float((__float_as_uint(acc[nb][r]) & ~0x7Fu) | cn | ((unsigned)hi << 2)); }
            top16_of_64(v);
            float o[16];
#pragma unroll
            for (int i = 0; i < 16; ++i) o[i] = __shfl_xor(v[i], 32);
            merge_top16(v, o);
#pragma unroll
            for (int i = 0; i < 16; ++i) sab[c][i] = v[i];
        }
        if (hi == 0) {
#pragma unroll
            for (int i = 0; i < 16; ++i) { SCR[r32 * 32 + i] = (int)(__float_as_uint(sab[0][i]) & 0x7Fu); SCR[r32 * 32 + 16 + i] = (int)(__float_as_uint(sab[1][i]) & 0x7Fu); }
        }
        float cnd[64];
        {   int n = 0;
#pragma unroll
            for (int i = 0; i < 16; ++i)
#pragma unroll
                for (int j = 0; j < 16; ++j) if ((i + 1) * (j + 1) <= 16) { cnd[n] = __uint_as_float((__float_as_uint(sab[0][i] + sab[1][j]) & ~0xFFu) | (unsigned)(i * 16 + j)); ++n; }
#pragma unroll
            for (int k = 50; k < 64; ++k) cnd[k] = -INFINITY;
        }
        top16_of_64(cnd);
        float ex[16]; float sum = 0.f;
#pragma unroll
        for (int k = 0; k < 16; ++k) { ex[k] = __builtin_amdgcn_exp2f((cnd[k] - cnd[0]) * LOG2E); sum += ex[k]; }
        const float rsum = 1.0f / sum;
        asm volatile("s_waitcnt lgkmcnt(0)" ::: "memory");
        if (hi == 0) {
#pragma unroll
            for (int k = 0; k < 16; ++k) { const unsigned pos = __float_as_uint(cnd[k]) & 0xFFu;
                const int ia = SCR[r32 * 32 + (pos >> 4)], ib = SCR[r32 * 32 + 16 + (pos & 15)];
                IDXl[r32 * KS + h * 16 + k] = ia * 128 + ib; GATEl[r32 * KS + h * 16 + k] = ex[k] * rsum; }
            IDXl[r32 * KS + 128 + h] = 0; GATEl[r32 * KS + 128 + h] = 0.f;
        }
    }
    __syncthreads();
    {
#pragma unroll 1
        for (int tt = 0; tt < 4; ++tt) {
            const int tl = wid * 4 + tt;
            unsigned a0 = ((unsigned)IDXl[tl * KS + lane] << 7) | (unsigned)lane, a1 = ((unsigned)IDXl[tl * KS + 64 + lane] << 7) | (unsigned)(64 + lane);
#pragma unroll
            for (int k = 2; k <= 128; k <<= 1)
#pragma unroll
                for (int j = k >> 1; j > 0; j >>= 1) {
                    if (j == 64) { const unsigned mn = a0 < a1 ? a0 : a1, mx = a0 < a1 ? a1 : a0; a0 = mn; a1 = mx; }
                    else {
                        const unsigned o0 = (unsigned)__shfl_xor((int)a0, j), o1 = (unsigned)__shfl_xor((int)a1, j);
                        const bool lower = (lane & j) == 0;
                        const bool up0 = ((lane & k) == 0), up1 = (((64 + lane) & k) == 0);
                        const unsigned mn0 = a0 < o0 ? a0 : o0, mx0 = a0 < o0 ? o0 : a0, mn1 = a1 < o1 ? a1 : o1, mx1 = a1 < o1 ? o1 : a1;
                        a0 = (up0 == lower) ? mn0 : mx0; a1 = (up1 == lower) ? mn1 : mx1;
                    }
                }
            const float g0 = GATEl[tl * KS + (a0 & 127u)], g1 = GATEl[tl * KS + (a1 & 127u)];
            asm volatile("s_waitcnt lgkmcnt(0)" ::: "memory");
            IDXl[tl * KS + lane] = (int)(a0 >> 7); IDXl[tl * KS + 64 + lane] = (int)(a1 >> 7);
            GATEl[tl * KS + lane] = g0; GATEl[tl * KS + 64 + lane] = g1;
        }
        asm volatile("s_waitcnt lgkmcnt(0)" ::: "memory");
    }
    {
        typedef float f32x2 __attribute__((ext_vector_type(2)));
        const unsigned char* UT = p.ws + WS_UT;
        const float* g2 = P_MODS(p) + 5 * 2048;
        for (int tt = 0; tt < 4; ++tt) {
            const int tl = wid * 4 + tt; const size_t t = (size_t)t0 + tl;
            int lane_t = lane; asm volatile("" : "+v"(lane_t));
            const unsigned wbase = (unsigned)(uintptr_t)(lds + 2 * 32 * KS * 4) + (unsigned)__builtin_amdgcn_readfirstlane(wid) * 16000u;
            const unsigned h2b = wbase + 13824u;
            {
                float ps = (lane_t < 32) ? P_RSS(p)[t * 32 + lane_t] : 0.f;
                const float rstd = 1.0f / sqrtf(wave_sum_dpp(ps) * (1.0f / 2048.0f) + EPS) * H6_SCALE;
                const bf16_t* hp = P_XN(p) + t * 2048 + lane_t * 32;
                f32x16 lo_, hi_;
#pragma unroll
                for (int c = 0; c < 4; ++c) { const u32x4 w_ = *(const u32x4*)(hp + 8 * c); const unsigned ws_[4] = {w_.x, w_.y, w_.z, w_.w};
#pragma unroll
                    for (int q = 0; q < 2; ++q) { const int e0 = 8 * c + 4 * q; const f32x4 gg = *(const f32x4*)(P_G2V(p) + lane_t * 32 + e0), s4 = *(const f32x4*)(P_S2V(p) + lane_t * 32 + e0) * H6_SCALE;
                        const float v0 = __uint_as_float(ws_[2 * q] << 16) * rstd * gg[0] + s4[0], v1 = __uint_as_float(ws_[2 * q] & 0xffff0000u) * rstd * gg[1] + s4[1];
                        const float v2 = __uint_as_float(ws_[2 * q + 1] << 16) * rstd * gg[2] + s4[2], v3 = __uint_as_float(ws_[2 * q + 1] & 0xffff0000u) * rstd * gg[3] + s4[3];
                        if (c < 2) { lo_[e0] = v0; lo_[e0 + 1] = v1; lo_[e0 + 2] = v2; lo_[e0 + 3] = v3; } else { hi_[e0 - 16] = v0; hi_[e0 - 15] = v1; hi_[e0 - 14] = v2; hi_[e0 - 13] = v3; } } }
                const u32x6 pk = __builtin_amdgcn_cvt_scalef32_2xpk16_fp6_f32(lo_, hi_, 1.0f);
                const unsigned ha_ = h2b + (unsigned)lane_t * 32u;
                *(LAS u32x4*)(uintptr_t)ha_ = (u32x4){pk[0], pk[1], pk[2], pk[3]}; *(LAS u32x2*)(uintptr_t)(ha_ + 16u) = (u32x2){pk[4], pk[5]};
                asm volatile("s_waitcnt lgkmcnt(0)" ::: "memory");
            }
            f32x2 acc[16];
#pragma unroll
            for (int i = 0; i < 16; ++i) acc[i] = (f32x2){0.f, 0.f};
            const int l16 = lane & 15;
#if FP6_INTERLEAVED
#define FK(k_) ((((k_) & 15) << 1) | ((k_) >> 4))
#else
#define FK(k_) (k_)
#endif
#define DEC6(P_) __builtin_amdgcn_cvt_scalef32_pk32_f16_fp6(P_, 1.0f)
#define SBAR() __builtin_amdgcn_sched_barrier(0)
            constexpr int NBV = 4;
            u32x4 Aq[NBV], Bq[NBV]; u32x2 Ar[NBV], Br[NBV];
#define LOADV(S_, iv_, base_) do { _Pragma("unroll") for (int i_ = 0; i_ < NBV; ++i_) { \
                const int e_ = __builtin_amdgcn_readlane(iv_, (base_) + i_); const unsigned char* r_ = UT + (size_t)e_ * 3072 + 1536 + lane * 24; \
                S_##q[i_] = *(const u32x4*)r_; S_##r[i_] = *(const u32x2*)(r_ + 16); } } while (0)
#define COMPV(S_, base_) do { _Pragma("unroll") for (int i_ = 0; i_ < NBV; ++i_) { \
                const _Float16 wh_ = (_Float16)__builtin_bit_cast(float, __builtin_amdgcn_readlane(__builtin_bit_cast(int, wv), (base_) + i_)); const h16x2 w2_ = {wh_, wh_}; \
                const h16x32 dv_ = DEC6(((u32x6){S_##q[i_].x, S_##q[i_].y, S_##q[i_].z, S_##q[i_].w, S_##r[i_].x, S_##r[i_].y})); \
                _Pragma("unroll") for (int m_ = 0; m_ < 16; ++m_) acch[m_] = (h16x2){dv_[2 * m_], dv_[2 * m_ + 1]} * w2_ + acch[m_]; __builtin_amdgcn_sched_barrier(0); } } while (0)
            int idxv = IDXl[tl * KS + l16];
            LOADV(A, idxv, 0);
            u32x4 L0[3], L1[3], L2[3], L3[3];
            const unsigned char* ub = UT + (size_t)idxv * 3072 + (unsigned)(lane >> 4) * 16u;
#define LDU(L_, ub_, t8_) do { L_[0] = *(const u32x4*)((ub_) + (t8_) * 192); L_[1] = *(const u32x4*)((ub_) + (t8_) * 192 + 64); L_[2] = *(const u32x4*)((ub_) + (t8_) * 192 + 128); } while (0)
#define MMU(L_, t8_) do { const u32x4 a0_ = *(const LAS u32x4*)(uintptr_t)(hq + (unsigned)(2 * (t8_)) * 128u); const u32x2 a1_ = *(const LAS u32x2*)(uintptr_t)(hq + (unsigned)(2 * (t8_)) * 128u + 16u); \
                        const u32x4 c0_ = *(const LAS u32x4*)(uintptr_t)(hq + (unsigned)(2 * (t8_) + 1) * 128u); const u32x2 c1_ = *(const LAS u32x2*)(uintptr_t)(hq + (unsigned)(2 * (t8_) + 1) * 128u + 16u); \
                        const att::i32x8 A0_ = {(int)a0_.x, (int)a0_.y, (int)a0_.z, (int)a0_.w, (int)a1_.x, (int)a1_.y, 0, 0}, A1_ = {(int)c0_.x, (int)c0_.y, (int)c0_.z, (int)c0_.w, (int)c1_.x, (int)c1_.y, 0, 0}; \
                        const att::i32x8 B0_ = {(int)L_[0].x, (int)L_[0].y, (int)L_[0].z, (int)L_[0].w, (int)L_[1].x, (int)L_[1].y, 0, 0}, B1_ = {(int)L_[1].z, (int)L_[1].w, (int)L_[2].x, (int)L_[2].y, (int)L_[2].z, (int)L_[2].w, 0, 0}; \
                        dacc = __builtin_amdgcn_mfma_scale_f32_16x16x128_f8f6f4(A0_, B0_, dacc, 2, 2, 0, 0, 0, 0); dacc = __builtin_amdgcn_mfma_scale_f32_16x16x128_f8f6f4(A1_, B1_, dacc, 2, 2, 0, 0, 0, 0); } while (0)
            LDU(L0, ub, 0); LDU(L1, ub, 1); LDU(L2, ub, 2); LDU(L3, ub, 3);
            const unsigned hq = h2b + (unsigned)(lane >> 4) * 32u;
#pragma unroll 1
            for (int bt = 0; bt < 8; ++bt) {
                const float gatev = GATEl[tl * KS + bt * 16 + l16];
                const int idxn = IDXl[tl * KS + ((bt + 1) & 7) * 16 + l16];
                f32x4 dacc = {0.f, 0.f, 0.f, 0.f};
                {
                    MMU(L0, 0); LDU(L0, ub, 4); MMU(L1, 1); LDU(L1, ub, 5); MMU(L2, 2); LDU(L2, ub, 6); MMU(L3, 3); LDU(L3, ub, 7);
                    MMU(L0, 4); MMU(L1, 5); MMU(L2, 6); MMU(L3, 7);
                }
                const float wv = gatev * gelu_as(dacc[0] * (1.0f / (U6_SCALE * H6_SCALE)));
                h16x2 acch[16];
#pragma unroll
                for (int m = 0; m < 16; ++m) acch[m] = (h16x2){(_Float16)0.f, (_Float16)0.f};
                SBAR();
                LOADV(B, idxv, 4); SBAR(); COMPV(A, 0); SBAR();
                LOADV(A, idxv, 8); SBAR(); COMPV(B, 4); SBAR();
                LOADV(B, idxv, 12); SBAR(); COMPV(A, 8); SBAR();
                if (bt < 7) LOADV(A, idxn, 0);
                ub = UT + (size_t)idxn * 3072 + (unsigned)(lane >> 4) * 16u;
                if (bt < 7) { LDU(L0, ub, 0); LDU(L1, ub, 1); LDU(L2, ub, 2); LDU(L3, ub, 3); }
                SBAR(); COMPV(B, 12); SBAR();
#pragma unroll
                for (int m = 0; m < 16; ++m) { acc[m].x += (float)acch[m].x; acc[m].y += (float)acch[m].y; }
                idxv = idxn;
            }
#undef FK
#undef DEC6
#undef SBAR
#undef LOADV
#undef COMPV
#undef LDU
#undef MMU
            int lane_e = lane, tl_e = tl; asm volatile("" : "+v"(lane_e), "+v"(tl_e));
            const size_t t_e = (size_t)t0 + tl_e;
            float* orow = p.out + t_e * 2048; const bf16_t* xrow = P_XN(p) + t_e * 2048;
            const float fsc = 1.0f / V6_SCALE;
#pragma unroll
            for (int j = 0; j < 2; ++j) { const int ob = j * 1024 + lane_e * 16;
                const u32x4 xa = *(const u32x4*)(xrow + ob), xb = *(const u32x4*)(xrow + ob + 8);
                const unsigned xw[8] = {xa.x, xa.y, xa.z, xa.w, xb.x, xb.y, xb.z, xb.w};
#pragma unroll
                for (int q = 0; q < 4; ++q) { const int o = ob + q * 4;
                    const f32x4 x0 = {__uint_as_float(xw[2 * q] << 16), __uint_as_float(xw[2 * q] & 0xffff0000u), __uint_as_float(xw[2 * q + 1] << 16), __uint_as_float(xw[2 * q + 1] & 0xffff0000u)};
                    const f32x4 ga = *(const f32x4*)(g2 + o) * fsc;
                    const f32x4 r_ = x0 + ga * (j == 0 ? (f32x4){acc[4 * q].x, acc[4 * q + 1].x, acc[4 * q + 2].x, acc[4 * q + 3].x} : (f32x4){acc[4 * q].y, acc[4 * q + 1].y, acc[4 * q + 2].y, acc[4 * q + 3].y});
                    *(f32x4*)(orow + o) = r_; } }
        }
    }
    __syncthreads();
}
}

#define XB_TMO      128
#define XB_XCNT(j)  (256  + 64 * (j))
#define XB_XSUB(j)  (1280 + 64 * (j))
#define XB_XGEN(j)  (2304 + 64 * (j))
#define XB_TOP      3328
#define XB_TOPGEN   3392
#define XCD_BAR_WORDS 3456
#define XB_SPIN_CAP (1u << 18)

__device__ __forceinline__ unsigned xb_ld(unsigned* p)              { return __hip_atomic_load(p, __ATOMIC_RELAXED, __HIP_MEMORY_SCOPE_AGENT); }
__device__ __forceinline__ unsigned xb_add(unsigned* p, unsigned v) { return __hip_atomic_fetch_add(p, v, __ATOMIC_RELAXED, __HIP_MEMORY_SCOPE_AGENT); }
__device__ __forceinline__ unsigned xb_xcc_id() { return (unsigned)__builtin_amdgcn_s_getreg((3 << 11) | 20) & 0xFu; }
#define XB_SPIN(cond, bar) do { unsigned _sp = 0; while (cond) { __builtin_amdgcn_s_sleep(1); \
    if ((++_sp & 255u) == 0u) { if (xb_ld(&(bar)[XB_TMO])) break; if (_sp > XB_SPIN_CAP) { atomicAdd(&(bar)[XB_TMO], 1u); break; } } } } while (0)

struct XcdBarrier {
    unsigned* bar; unsigned x;
    volatile LAS unsigned* st;
};

__device__ __forceinline__ XcdBarrier xcd_barrier_post(unsigned* bar, volatile LAS unsigned* st) {
    XcdBarrier b; b.bar = bar; b.x = xb_xcc_id(); b.st = st;
    if (threadIdx.x == 0) (void)xb_add(&bar[XB_XCNT(b.x)], 1u);
    return b;
}
__device__ __forceinline__ void xcd_barrier_complete(unsigned* bar, unsigned x, unsigned& nloc, unsigned& nx) {
    const unsigned G = gridDim.x * gridDim.y * gridDim.z;
    unsigned sum, cnt, mine, sp = 0u;
    for (;;) {
        sum = 0u; cnt = 0u; mine = 0u;
#pragma unroll
        for (unsigned j = 0; j < 16; ++j) { const unsigned c = xb_ld(&bar[XB_XCNT(j)]); sum += c; cnt += (c > 0u) ? 1u : 0u; mine = (j == x) ? c : mine; }
        if (sum == G) break;
        __builtin_amdgcn_s_sleep(1);
        if ((++sp & 255u) == 0u) { if (xb_ld(&bar[XB_TMO])) break; if (sp > XB_SPIN_CAP) { atomicAdd(&bar[XB_TMO], 1u); break; } }
    }
    nloc = mine > 0u ? mine : 1u; nx = cnt > 0u ? cnt : 1u;
}

__device__ __forceinline__ void xcd_barrier(const XcdBarrier& b) {
    asm volatile("s_waitcnt vmcnt(0)" ::: "memory");
    __syncthreads();
    if (threadIdx.x == 0) {
        unsigned* bar = b.bar;
        __builtin_amdgcn_s_waitcnt(0);
        unsigned nloc = b.st[0], nx = b.st[1];
        if (nloc == 0u) { xcd_barrier_complete(bar, b.x, nloc, nx); b.st[0] = nloc; b.st[1] = nx; }
        const unsigned old = xb_add(&bar[XB_XSUB(b.x)], 1u);
        const unsigned gen = old / nloc;
        if (old + 1u == (gen + 1u) * nloc) {
            __builtin_amdgcn_fence(__ATOMIC_RELEASE, "agent");
            asm volatile("s_waitcnt vmcnt(0)" ::: "memory");
            const unsigned og = xb_add(&bar[XB_TOP], 1u);
            const unsigned tg = og / nx;
            if (og + 1u == (tg + 1u) * nx) xb_add(&bar[XB_TOPGEN], 1u);
            else XB_SPIN(xb_ld(&bar[XB_TOPGEN]) == tg, bar);
            __builtin_amdgcn_fence(__ATOMIC_ACQUIRE, "agent");
            xb_add(&bar[XB_XGEN(b.x)], 1u);
            asm volatile("s_waitcnt vmcnt(0)" ::: "memory");
        } else {
            XB_SPIN(xb_ld(&bar[XB_XGEN(b.x)]) == gen, bar);
            __builtin_amdgcn_fence(__ATOMIC_ACQUIRE, "agent");
            asm volatile("s_waitcnt vmcnt(0)" ::: "memory");
        }
    }
    __syncthreads();
}

namespace cg = cooperative_groups;
constexpr int MK_LDS = 163840;
enum { PH_PREP = 0, PH_HNORM, PH_GEMM1, PH_POST, PH_ATTN, PH_OUTP, PH_H2, PH_QP, PH_PEER, PH_N };
struct MkArgs { Params p; int ph_lo, ph_hi; };
__global__ __launch_bounds__(512, 2) void mk_fwd(MkArgs a) {
    extern __shared__ __attribute__((aligned(16))) unsigned char lds[];
    const Params& p = a.p;
    const int lo = a.ph_lo, hi = a.ph_hi;
    const int tid = threadIdx.x, lane = tid & 63, wave = __builtin_amdgcn_readfirstlane(tid >> 6);
    const int G = gridDim.x, bx = blockIdx.x;
    cg::grid_group grid = cg::this_grid();
    volatile LAS unsigned* xst = (volatile LAS unsigned*)((LAS unsigned char*)lds + MK_LDS - 64);
    if (tid < 16) xst[tid] = 0u;
    __syncthreads();
    const XcdBarrier xbar = xcd_barrier_post((unsigned*)(p.ws + WS_CTL) + 4096, xst);
#define IN(k) (lo <= (k) && (k) < hi)
#define SEAM(k) do { if (IN(k) && IN((k) + 1)) xcd_barrier(xbar); } while (0)
    if (lo < 0) grid.sync();
    if (IN(PH_PREP)) {
        float* fl = (float*)lds;
        p0_adaln(p, fl, bx, G);
        __syncthreads();
        const size_t gtid = (size_t)bx * 512 + tid, gthreads = (size_t)G * 512;
        cvt_range(p.peer_keys, (bf16_t*)(p.ws + WS_KEYS), 8 * 2 * 128 * 128 / 8, gtid, gthreads);
        cvt_range(p.gmlp_ws, (bf16_t*)(p.ws + WS_GWS), 8 * 128 * 128 / 8, gtid, gthreads);
        for (size_t i = gtid; i < 320 * 16; i += gthreads) { const int tp = (int)(i >> 4), f = (int)(i & 15);
            const float posf = (float)(tp < 256 ? tp : tp - 256), inv = exp2f(-(float)f * (13.287712379549449f / 16.0f)), ang = posf * inv;
            P_ROPE(p)[2 * i] = cosf(ang); P_ROPE(p)[2 * i + 1] = sinf(ang); }
        float* scr = fl + wave * (64 * 33);
        const int gw = bx * 8 + wave, ngw = G * 8;
        constexpr int I_IN = (2048 / 64) * (5120 / 32), I_SQ = (2048 / 64) * (2048 / 32);
        for (int it = gw; it < I_IN; it += ngw) {
            if ((it % 160) < 64) transpose_item(p.w_in, 2048, 5120, (bf16_t*)(p.ws + WS_WIN_T), scr, it, lane);
            else transpose_item8(p.w_in, 2048, 5120, p.ws + WS_WIN_T + 8 * MiB - (size_t)2048 * 2048, scr, it, lane, W8_SCALE); }
    }
    SEAM(PH_PREP);
    if (IN(PH_HNORM)) {
        const int gw = bx * 8 + wave, ngw = G * 8;
        const float* mods = P_MODS(p); const float* modsc = P_MODSC(p);
        if (bx == 0) for (int i = tid; i < 2048; i += 512) { P_G2V(p)[i] = p.norm2_g[i] * (1.0f + mods[4 * 2048 + i]); P_S2V(p)[i] = mods[3 * 2048 + i]; }
        for (int row = gw; row < LT; row += ngw) {
            if (row < CTX) norm_row_dual(p.ctx + (size_t)row * DM, p.norm1_g, modsc, modsc + 2048, P_HB(p) + (size_t)row * DM, P_HB8(p) + (size_t)row * DM, lane);
            else norm_row_dual(p.x + (size_t)(row - CTX) * DM, p.norm1_g, mods, mods + 2048, P_HB(p) + (size_t)row * DM, P_HB8(p) + (size_t)row * DM, lane);
        }
    }
    SEAM(PH_HNORM);
    if (IN(PH_GEMM1)) {
        {
            pg8::Gemm g{P_HB(p) + (size_t)CTX * DM, (const bf16_t*)(p.ws + WS_WIN_T), SEQ, 2048, DM}; pg8::StaticOrder S; S.init(SEQ, 2048, G, bx);
            pg8::EpiG1m E{P_UG(p), P_VG(p), P_QS8(p), P_KIMG8(p), P_VIMG8(p), p.q_norm_g, p.k_norm_g, P_ROPE(p), (LAS float*)((LAS unsigned char*)lds + 131072), 1, 0, 1.0f};
            pg8::gemm_phase<pg8::EpiG1m, pg8::StaticOrder, true, true, false>((LAS unsigned char*)lds, g, S, E); }
        {
            pg8::Gemm g{(const bf16_t*)P_HB8(p), (const bf16_t*)(p.ws + WS_WIN_T + 8 * MiB), LT, 3072, DM / 2}; pg8::StaticOrder S; S.init(LT, 3072, G, bx);
            pg8::EpiG1m E{P_UG(p), P_VG(p), P_QS8(p), P_KIMG8(p), P_VIMG8(p), p.q_norm_g, p.k_norm_g, P_ROPE(p), (LAS float*)((LAS unsigned char*)lds + 131072), 0, 8, 1.0f / W8_SCALE};
            pg8::gemm_phase<pg8::EpiG1m, pg8::StaticOrder, true, true, true>((LAS unsigned char*)lds, g, S, E); }
        {
            unsigned* qctr = (unsigned*)(p.ws + WS_CTL) + 64;
            float* scr = (float*)lds + wave * (64 * 33);
            for (;;) {
                __syncthreads();
                if (tid == 0) xst[8] = atomicAdd(qctr, 1u);
                __syncthreads();
                const unsigned c = xst[8];
                if (c >= 2592u) break;
                if (c >= 2560u) {
                    const int n0 = (int)(c - 2560u) * 64; const float* w_ = p.peer_wq + n0 + lane; const float* s2 = P_S2V(p); float a_ = 0.f;
#pragma unroll 8
                    for (int k = wave * 256; k < wave * 256 + 256; ++k) a_ += s2[k] * w_[(size_t)k * 2048];
                    float* red = (float*)lds; red[wave * 64 + lane] = a_;
                    __syncthreads();
                    if (wave == 0) { float t_ = 0.f;
#pragma unroll
                        for (int w8 = 0; w8 < 8; ++w8) t_ += red[w8 * 64 + lane];
                        P_BQ(p)[n0 + lane] = t_; }
                    continue; }
                if (c < 2048u) { const bool isv = c >= 1024u; const size_t r0 = (size_t)(c & 1023u) * 16;
                    const float* src = (isv ? p.peer_v : p.peer_u) + r0 * 2048; unsigned char* dst = p.ws + WS_UT + r0 * 3072 + (isv ? 1536 : 0); const float sc = isv ? V6_SCALE : U6_SCALE;
                    for (int i = tid; i < 16 * 64; i += 512) { const int rr = i >> 6, cc = i & 63;
                        const float* s_ = isv ? src + (size_t)rr * 2048 + cc * 16 : src + (size_t)rr * 2048 + cc * 32;
                        const int o2 = isv ? 1024 : 16;
                        f32x16 a_, b_;
#pragma unroll
                        for (int k = 0; k < 4; ++k) { const f32x4 x_ = *(const f32x4*)(s_ + 4 * k) * sc, y_ = *(const f32x4*)(s_ + o2 + 4 * k) * sc;
                            a_[4 * k] = x_[0]; a_[4 * k + 1] = x_[1]; a_[4 * k + 2] = x_[2]; a_[4 * k + 3] = x_[3]; b_[4 * k] = y_[0]; b_[4 * k + 1] = y_[1]; b_[4 * k + 2] = y_[2]; b_[4 * k + 3] = y_[3]; }
                        const u32x6 pk = __builtin_amdgcn_cvt_scalef32_2xpk16_fp6_f32(a_, b_, 1.0f);
                        const int sg = cc >> 2, kq = cc & 3;
                        if (isv) { unsigned char* d_ = dst + (size_t)rr * 3072 + cc * 24;
                            *(u32x2*)d_ = (u32x2){pk[0], pk[1]}; *(u32x2*)(d_ + 8) = (u32x2){pk[2], pk[3]}; *(u32x2*)(d_ + 16) = (u32x2){pk[4], pk[5]}; }
                        else { unsigned char* d_ = dst + (size_t)rr * 3072 + (sg >> 1) * 192 + kq * 16;
                            if ((sg & 1) == 0) { *(u32x4*)d_ = (u32x4){pk[0], pk[1], pk[2], pk[3]}; *(u32x2*)(d_ + 64) = (u32x2){pk[4], pk[5]}; }
                            else { *(u32x2*)(d_ + 64 + 8) = (u32x2){pk[0], pk[1]}; *(u32x4*)(d_ + 128) = (u32x4){pk[2], pk[3], pk[4], pk[5]}; } } } }
                else { const int it = (int)(c - 2048u) * 8 + wave; constexpr int I_SQ = (2048 / 64) * (2048 / 32);
                    if (it < I_SQ) transpose_item(p.w_out, 2048, 2048, (bf16_t*)(p.ws + WS_WOUT_T), scr, it, lane);
                    else transpose_item(p.peer_wq, 2048, 2048, (bf16_t*)(p.ws + WS_WQ_T), scr, it - I_SQ, lane, P_G2V(p)); }
            }
        }
    }
    SEAM(PH_GEMM1);
    if (IN(PH_POST)) {
        for (int u = bx; u < 128 * 8; u += G) gm::gmlp_unit(p, u >> 3, u & 7, (char*)lds);
    }
    SEAM(PH_POST);
    if (IN(PH_ATTN)) {
        for (int u = bx; u < NH * (SEQ / 256); u += G) att::attn_unit8(p, u & 7, u >> 3, (char*)lds);
    }
    SEAM(PH_ATTN);
    if (IN(PH_OUTP)) {
        pg8::Gemm g{P_A2(p), (const bf16_t*)(p.ws + WS_WOUT_T), SEQ, DM, DM}; pg8::StaticOrder S; S.init(SEQ, DM, G, bx);
        pg8::EpiOutm E{p.x, P_MODS(p) + 2 * 2048, P_XN(p), P_RSS(p)};
        pg8::gemm_phase<pg8::EpiOutm, pg8::StaticOrder, true, true>((LAS unsigned char*)lds, g, S, E);
    }
    SEAM(PH_OUTP);
    if (IN(PH_QP)) {
        pg8::Gemm g{P_XN(p), (const bf16_t*)(p.ws + WS_WQ_T), SEQ, DM, DM}; pg8::StaticOrder S; S.init(SEQ, DM, G, bx);
        pg8::EpiQp E{P_QP(p), P_RSS(p), P_BQ(p)};
        pg8::gemm_phase<pg8::EpiQp, pg8::StaticOrder, true, true>((LAS unsigned char*)lds, g, S, E);
    }
    SEAM(PH_QP);
    if (IN(PH_PEER)) {
        for (int u = bx; u < SEQ / peer::PEER_TOK; u += G) peer::peer_unit(p, u, (char*)lds);
    }
#undef IN
#undef SEAM
}
static int g_grid = 0;
static void mk_launch(const Params& p, int lo, int hi, hipStream_t stream) {
    (void)hipMemsetAsync(p.ws + WS_CTL, 0, 65536, stream);
    MkArgs a{}; a.p = p; a.ph_lo = lo; a.ph_hi = hi;
    void* args[] = {&a};
    hipError_t e = hipLaunchCooperativeKernel((const void*)mk_fwd, dim3(g_grid), dim3(512), args, MK_LDS, stream);
    if (e != hipSuccess) fprintf(stderr, "mk_launch [%d,%d) failed: %s (grid %d)\n", lo, hi, hipGetErrorString(e), g_grid);
}

extern "C" void kernel_launch(void* const* d_in, const int* in_sizes, int n_in, void* d_out, int out_size, void* d_ws, size_t ws_size, hipStream_t stream) {
    static int init = 0;
    if (!init) {
        if (n_in != 24 || ws_size < WS_END) { fprintf(stderr, "kernel_launch: unexpected n_in %d / ws %zu\n", n_in, ws_size); }
        (void)hipFuncSetAttribute((const void*)mk_fwd, hipFuncAttributeMaxDynamicSharedMemorySize, MK_LDS);
        int dev = 0, cus = 0, per_cu = 0;
        (void)hipGetDevice(&dev); (void)hipDeviceGetAttribute(&cus, hipDeviceAttributeMultiprocessorCount, dev);
        (void)hipOccupancyMaxActiveBlocksPerMultiprocessor(&per_cu, (const void*)mk_fwd, 512, MK_LDS);
        if (per_cu < 1) { fprintf(stderr, "kernel_launch: occupancy query says %d blocks/CU\n", per_cu); per_cu = 1; }
        g_grid = cus * 1;
        init = 1;
    }
    Params p{};
    const float** f = (const float**)&p;
    for (int i = 0; i < 24; ++i) f[i] = (const float*)d_in[i];
    p.out = (float*)d_out; p.ws = (unsigned char*)d_ws;

    mk_launch(p, PH_PREP, PH_N, stream);
}
```

```cpp
#include <hip/hip_runtime.h>
#include <hip/hip_cooperative_groups.h>
#include <cstdint>
#include <cstdio>
#include <cmath>

typedef unsigned short bf16_t;
typedef short bf16x8 __attribute__((ext_vector_type(8)));
typedef float f32x4 __attribute__((ext_vector_type(4)));
typedef float f32x16 __attribute__((ext_vector_type(16)));
typedef unsigned u32x4 __attribute__((ext_vector_type(4)));
typedef unsigned u32x2 __attribute__((ext_vector_type(2)));

constexpr int DM = 2048, SEQ = 16384, CTX = 256, LT = SEQ + CTX;
constexpr int D_A = 1024, D_QK = 1024, D_V = 1024, D_IN = 5120;
constexpr int NH = 8, DQK = 64, DV = 128;
constexpr int NTILE = LT / 64;
constexpr int PEER_H = 8, NKEYS = 128, TOPK = 16;
constexpr float EPS = 1e-6f;
constexpr float LAM_INIT = 0.2f;
constexpr float LOG2E = 1.4426950408889634f;
constexpr float QSCALE = 0.125f * LOG2E;

constexpr size_t MiB = 1u << 20;
constexpr size_t WS_CTL = 0;
constexpr size_t WS_MODS = 1 * MiB;
constexpr size_t WS_WIN_T = 2 * MiB;
constexpr size_t WS_WOUT_T = 22 * MiB;
constexpr size_t WS_WQ_T = 30 * MiB;
constexpr size_t WS_KEYS = 38 * MiB;
constexpr size_t WS_GWS = 38 * MiB + 512 * 1024;
constexpr size_t WS_UT = 39 * MiB;
constexpr size_t WS_VT = 103 * MiB;
constexpr size_t WS_R1 = 167 * MiB;
constexpr size_t WS_R2 = 232 * MiB;
constexpr size_t WS_R3 = 296 * MiB;
constexpr size_t WS_R4 = 394 * MiB;
constexpr size_t WS_R5 = 491 * MiB;
constexpr size_t WS_END = 507 * MiB;

struct Params {
    const float *x, *c, *ctx, *c_ctx, *w_ada, *b_ada, *norm1_g, *norm2_g, *w_in, *gmlp_ln_g, *gmlp_ws, *gmlp_bs, *q_norm_g, *k_norm_g,
        *lq1, *lk1, *lq2, *lk2, *subln_g, *w_out, *peer_wq, *peer_keys, *peer_u, *peer_v;
    float* out;
    unsigned char* ws;
};
#define P_MODS(p) ((float*)((p).ws + WS_MODS))
#define P_MODSC(p) ((float*)((p).ws + WS_MODS) + 12288)
#define P_SCAL(p) ((float*)((p).ws + WS_MODS) + 16384)
#define P_G2V(p) ((float*)((p).ws + WS_MODS + 196608))
#define P_S2V(p) ((float*)((p).ws + WS_MODS + 204800))
#define P_BQ(p) ((float*)((p).ws + WS_MODS + 212992))
#define P_RSS(p) ((float*)((p).ws + WS_R2))
#define P_ROPE(p) ((float*)((p).ws + WS_MODS + 131072))
#define P_HB(p) ((bf16_t*)((p).ws + WS_R1))
#define P_HB8(p) ((unsigned char*)((p).ws + WS_R3))
#define P_A2(p) ((bf16_t*)((p).ws + WS_R1))
#define P_UG(p) ((bf16_t*)((p).ws + WS_R2))
#define P_VG(p) ((bf16_t*)((p).ws + WS_R2 + 32 * MiB))
#define P_XB(p) ((bf16_t*)((p).ws + WS_R2))
#define P_QKV(p) ((bf16_t*)((p).ws + WS_R3))
#define P_QP(p) ((bf16_t*)((p).ws + WS_R3))
#define P_QS(p) ((bf16_t*)((p).ws + WS_R4))
#define P_KIMG(p) ((bf16_t*)((p).ws + WS_R4 + 32 * MiB))
#define P_QS8(p) ((unsigned char*)((p).ws + WS_R4))
#define P_KIMG8(p) ((unsigned char*)((p).ws + WS_R4 + 32 * MiB))
#define P_VIMG8(p) ((unsigned char*)((p).ws + WS_R4 + 32 * MiB + 33 * MiB))
#define P_VIMG(p) ((bf16_t*)((p).ws + WS_R4 + 32 * MiB + 33 * MiB))
#define P_XN(p) ((bf16_t*)((p).ws + WS_R4))
#define P_IDX(p) ((int*)((p).ws + WS_R5))
#define P_GATE(p) ((float*)((p).ws + WS_R5 + 8 * MiB))

__device__ __forceinline__ float bf2f(bf16_t b) { return __uint_as_float((unsigned)b << 16); }
__device__ __forceinline__ unsigned f2bf(float f) { unsigned u = __float_as_uint(f); return (u + 0x7fffu + ((u >> 16) & 1u)) >> 16; }
__device__ __forceinline__ unsigned pk2(float lo, float hi) { return f2bf(lo) | (f2bf(hi) << 16); }
__device__ __forceinline__ float wave_sum(float v) {
#pragma unroll
    for (int o = 1; o < 64; o <<= 1) v += __shfl_xor(v, o);
    return v;
}
__device__ __forceinline__ float gelu_erf(float v) { return 0.5f * v * (1.0f + erff(v * 0.70710678118654752f)); }
__device__ __forceinline__ int k8_off(int key, int colbyte) { const int c_ = colbyte >> 6, d_ = colbyte & 63; return c_ * 4096 + key * 64 + ((((d_ >> 4) ^ ((key >> 2) & 3)) << 4) | (d_ & 15)); }
__device__ __forceinline__ int v8_off(int k, int c) { const int p_ = (((k >> 2) & 1) << 5) | ((k >> 5) << 4) | (((k >> 3) & 3) << 2) | (k & 3); return c * 64 + ((((p_ >> 4) ^ ((c >> 2) & 3)) << 4) | (p_ & 15)); }
__device__ __forceinline__ int k_img_off(int key, int colbyte) { return key * 256 + (colbyte ^ ((key & 15) << 4)); }
__device__ __forceinline__ int v_img_off(int k, int c) { const int kk = (k & ~0xC) | ((k & 4) << 1) | ((k & 8) >> 1); return ((kk >> 3) * 4 + (c >> 5)) * 512 + ((kk & 7) * 32 + (c & 31)) * 2; }

__device__ __forceinline__ void p0_adaln(const Params& p, float* lds, int b, int nb) {
    const int tid = threadIdx.x, lane = tid & 63, wave = tid >> 6;
    float* sc = lds; float* scc = lds + 2048; float* red = lds + 4096;
    for (int k = tid; k < 2048; k += 512) { float v = p.c[k]; sc[k] = v / (1.0f + expf(-v)); v = p.c_ctx[k]; scc[k] = v / (1.0f + expf(-v)); }
    __syncthreads();
    float* mods = P_MODS(p); float* modsc = P_MODSC(p);
    for (int item = b; item < 192; item += nb) {
        const int col = item * 64 + lane;
        const float* w = p.w_ada + col;
        float a0 = 0.f, a1 = 0.f;
        const int k0 = wave * 256;
#pragma unroll 8
        for (int k = 0; k < 256; ++k) { const float wv = w[(size_t)(k0 + k) * 12288]; a0 += sc[k0 + k] * wv; a1 += scc[k0 + k] * wv; }
        red[(wave * 2 + 0) * 64 + lane] = a0; red[(wave * 2 + 1) * 64 + lane] = a1;
        __syncthreads();
        if (wave == 0) {
            float s0 = 0.f, s1 = 0.f;
#pragma unroll
            for (int w8 = 0; w8 < 8; ++w8) { s0 += red[(w8 * 2 + 0) * 64 + lane]; s1 += red[(w8 * 2 + 1) * 64 + lane]; }
            const float bb = p.b_ada[col];
            mods[col] = s0 + bb; if (col < 4096) modsc[col] = s1 + bb;
        }
        __syncthreads();
    }
    if (b == 0 && wave == 0) {
        float d1 = wave_sum(p.lq1[lane] * p.lk1[lane]), d2 = wave_sum(p.lq2[lane] * p.lk2[lane]);
        float gq = fabsf(p.q_norm_g[lane]), gk = fabsf(p.k_norm_g[lane]);
#pragma unroll
        for (int o = 1; o < 64; o <<= 1) { gq = fmaxf(gq, __shfl_xor(gq, o)); gk = fmaxf(gk, __shfl_xor(gk, o)); }
        if (lane == 0) { float* s = P_SCAL(p); s[0] = expf(d1) - expf(d2) + LAM_INIT; s[1] = 8.0f * gq * gk * LOG2E * 1.0001f + 0.01f; }
    }
}
__device__ __forceinline__ void cvt_range(const float* __restrict__ src, bf16_t* __restrict__ dst, size_t n8, size_t gtid, size_t gthreads) {
    for (size_t i = gtid; i < n8; i += gthreads) {
        const f32x4 a = *(const f32x4*)(src + i * 8), b = *(const f32x4*)(src + i * 8 + 4);
        u32x4 o; o.x = pk2(a.x, a.y); o.y = pk2(a.z, a.w); o.z = pk2(b.x, b.y); o.w = pk2(b.z, b.w);
        *(u32x4*)(dst + i * 8) = o;
    }
}
#ifndef FP6_INTERLEAVED
#define FP6_INTERLEAVED 1
#endif
constexpr float U6_SCALE = 72.0f, V6_SCALE = 3.2f, H6_SCALE = 1.0f;
typedef unsigned u32x6 __attribute__((ext_vector_type(6)));
typedef _Float16 h16x2 __attribute__((ext_vector_type(2)));
typedef _Float16 h16x32 __attribute__((ext_vector_type(32)));
__device__ __forceinline__ unsigned pk4_fp8(f32x4 a, float sc) {
    int w = 0; w = __builtin_amdgcn_cvt_pk_fp8_f32(a.x * sc, a.y * sc, w, false); w = __builtin_amdgcn_cvt_pk_fp8_f32(a.z * sc, a.w * sc, w, true); return (unsigned)w;
}
__device__ __forceinline__ void cvt_range_fp8(const float* __restrict__ src, unsigned char* __restrict__ dst, size_t n16, float sc, size_t gtid, size_t gthreads) {
    for (size_t i = gtid; i < n16; i += gthreads) {
        const f32x4 a = *(const f32x4*)(src + i * 16), b = *(const f32x4*)(src + i * 16 + 4), c = *(const f32x4*)(src + i * 16 + 8), d = *(const f32x4*)(src + i * 16 + 12);
        u32x4 o; o.x = pk4_fp8(a, sc); o.y = pk4_fp8(b, sc); o.z = pk4_fp8(c, sc); o.w = pk4_fp8(d, sc);
        *(u32x4*)(dst + i * 16) = o;
    }
}
__device__ __forceinline__ void transpose_item(const float* W, int K, int N, bf16_t* WT, float* scr, int item, int lane, const float* kscale = nullptr) {
    const int nblk = N / 32, kb = item / nblk, nbk = item % nblk, k0 = 64 * kb, n0 = 32 * nbk;
#pragma unroll 8
    for (int i = 0; i < 32; ++i) { const int kk = 2 * i + (lane >> 5); const float w_ = W[(size_t)(k0 + kk) * N + n0 + (lane & 31)]; scr[kk * 33 + (lane & 31)] = kscale ? w_ * kscale[k0 + kk] : w_; }
    __builtin_amdgcn_s_waitcnt(0xC07F); __builtin_amdgcn_wave_barrier();
    const int c8 = lane & 7;
#pragma unroll
    for (int j = 0; j < 4; ++j) { const int n = (lane >> 3) + 8 * j; const float* s = scr + (8 * c8) * 33 + n;
        u32x4 o; o.x = pk2(s[0 * 33], s[1 * 33]); o.y = pk2(s[2 * 33], s[3 * 33]); o.z = pk2(s[4 * 33], s[5 * 33]); o.w = pk2(s[6 * 33], s[7 * 33]);
        *(u32x4*)(WT + (size_t)(n0 + n) * K + k0 + 8 * c8) = o; }
    __builtin_amdgcn_s_waitcnt(0xC07F); __builtin_amdgcn_wave_barrier();
}
constexpr float W8_SCALE = 64.0f;
__device__ __forceinline__ void transpose_item8(const float* W, int K, int N, unsigned char* WT, float* scr, int item, int lane, float sc) {
    const int nblk = N / 32, kb = item / nblk, nbk = item % nblk, k0 = 64 * kb, n0 = 32 * nbk;
#pragma unroll 8
    for (int i = 0; i < 32; ++i) { const int kk = 2 * i + (lane >> 5); scr[kk * 33 + (lane & 31)] = W[(size_t)(k0 + kk) * N + n0 + (lane & 31)]; }
    __builtin_amdgcn_s_waitcnt(0xC07F); __builtin_amdgcn_wave_barrier();
    const int c8 = lane & 7;
#pragma unroll
    for (int j = 0; j < 4; ++j) { const int n = (lane >> 3) + 8 * j; const float* s = scr + (8 * c8) * 33 + n;
        u32x2 o; o.x = pk4_fp8((f32x4){s[0 * 33], s[1 * 33], s[2 * 33], s[3 * 33]}, sc); o.y = pk4_fp8((f32x4){s[4 * 33], s[5 * 33], s[6 * 33], s[7 * 33]}, sc);
        *(u32x2*)(WT + (size_t)(n0 + n) * K + k0 + 8 * c8) = o; }
    __builtin_amdgcn_s_waitcnt(0xC07F); __builtin_amdgcn_wave_barrier();
}
__device__ __forceinline__ void norm_row_dual(const float* xrow, const float* g, const float* sh, const float* sc, bf16_t* orow, unsigned char* orow8, int lane) {
    f32x4 v[8]; float ss = 0.f;
#pragma unroll
    for (int j = 0; j < 8; ++j) { v[j] = *(const f32x4*)(xrow + j * 256 + lane * 4); ss += (v[j].x * v[j].x + v[j].y * v[j].y) + (v[j].z * v[j].z + v[j].w * v[j].w); }
    ss = wave_sum(ss);
    const float r = 1.0f / sqrtf(ss * (1.0f / 2048.0f) + EPS);
#pragma unroll
    for (int j = 0; j < 8; ++j) {
        const int o = j * 256 + lane * 4;
        const f32x4 gg = *(const f32x4*)(g + o), s4 = *(const f32x4*)(sh + o), c4 = *(const f32x4*)(sc + o);
        const f32x4 y = (v[j] * r * gg) * (1.0f + c4) + s4;
        u32x2 w; w.x = pk2(y.x, y.y); w.y = pk2(y.z, y.w);
        *(u32x2*)(orow + o) = w;
        *(unsigned*)(orow8 + o) = pk4_fp8(y, 1.0f);
    }
}

namespace pg8 {
#define PG8_LAS __attribute__((address_space(3)))
typedef unsigned short bf16_t;
typedef short bf16x8 __attribute__((ext_vector_type(8)));
typedef float f32x4 __attribute__((ext_vector_type(4)));
typedef unsigned u32x4 __attribute__((ext_vector_type(4)));
constexpr int BM = 256, BK = 64, HALF = 128, HTB = HALF * BK * 2  , STAGE_BYTES = 8 * HTB, NXCD = 8, WGM = 8;

__host__ __device__ __forceinline__ int lds_byte(int r, int c) { const int st = (r >> 4) * 2 + (c >> 5), rr = r & 15, cc = c & 31, ob = rr * 64 + cc * 2; return st * 1024 + (ob ^ (((ob >> 9) & 1) << 5)); }
__host__ __device__ __forceinline__ void stage_rc(int b, int& R, int& C) { const int st = b / 1024, sb = b % 1024, swz = sb ^ (((sb >> 9) & 1) << 5); R = (st >> 1) * 16 + swz / 64; C = (st & 1) * 32 + (swz % 64) / 2; }
__host__ __device__ __forceinline__ int perm32(int rho) { const int n = rho >> 4, i = rho & 15; return 8 * (i >> 2) + 4 * n + (i & 3); }

struct Unit { int pm, pn; };
struct Gemm { const bf16_t* A; const bf16_t* Bt; int M, N, K; };

struct StaticOrder {
    int nM, nN, nwg, G, c;
    __host__ __device__ void init(int M, int N, int G_, int c_) { nM = M / BM; nN = N / BM; nwg = nM * nN; G = G_; c = c_; }
    __host__ __device__ bool next(int i, Unit& u) const {
        const long L = (long)i * G + c; if (L >= nwg) return false;
        int wgid = (int)L; { const int q = nwg / NXCD, r = nwg % NXCD, xcd = wgid % NXCD, off = wgid / NXCD; wgid = (xcd < r ? xcd * (q + 1) : r * (q + 1) + (xcd - r) * q) + off; }
        const int nig = WGM * nN, gid = wgid / nig, fm = gid * WGM, gsz = (nM - fm) < WGM ? (nM - fm) : WGM;
        u.pm = fm + ((wgid % nig) % gsz); u.pn = (wgid % nig) / gsz; return true;
    }
    __device__ __forceinline__ void a_ready(const Unit&) const {}
    __device__ __forceinline__ void done(const Unit&) const {}
};

__device__ __forceinline__ unsigned cvt_pk_bf16(float lo, float hi) { unsigned r; asm volatile("v_cvt_pk_bf16_f32 %0, %1, %2" : "=v"(r) : "v"(lo), "v"(hi)); return r; }
typedef float f32x2 __attribute__((ext_vector_type(2)));
__device__ __forceinline__ f32x2 gelu_pk(f32x2 v) {
    const f32x2 av = __builtin_elementwise_abs(v), d = av * 0.2316418882f + 1.0f;
    f32x2 t; t.x = __builtin_amdgcn_rcpf(d.x); t.y = __builtin_amdgcn_rcpf(d.y);
    f32x2 q = t * 0.5307027145f + (-0.7265760135f); q = q * t + 0.7107068705f; q = q * t + (-0.142248368f); q = q * t + 0.127414796f; q = q * t;
    const f32x2 s = (v * v) * (-0.72134752044f);
    f32x2 e; e.x = __builtin_amdgcn_exp2f(s.x); e.y = __builtin_amdgcn_exp2f(s.y);
    const f32x2 m = v * (q * e), r = v - m;
    f32x2 o; o.x = v.x < 0.f ? m.x : r.x; o.y = v.y < 0.f ? m.y : r.y; return o;
}

template <int ACT  > struct EpiBf16 {
    static constexpr bool PERM = true, AFTER_DRAIN = false; static_assert(ACT == 0 || ACT == 1, "EpiBf16: ACT is 0 (none) or 1 (gelu_pk)");
    bf16_t* O; int ldc; const float* bias; int split_cols; size_t split_stride; float scale0;
    __device__ __forceinline__ void operator()(const f32x4 (&acc)[2][2][4][2], const Unit& u, int wr, int wc, int fr, int fq) const {
        const int row0 = u.pm * BM + wr * 64 + fr; int colt = u.pn * BM; bf16_t* base = O;
        float sc = 1.f; if (split_cols) { const int t = colt / split_cols; base += (size_t)t * split_stride; colt -= t * split_cols; if (t == 0) sc = scale0; }
        const int col0 = colt + wc * 32 + 8 * fq, bcol0 = u.pn * BM + wc * 32 + 8 * fq;
        f32x4 bv[2][2];
#pragma unroll
        for (int bj = 0; bj < 2; ++bj)
#pragma unroll
            for (int n = 0; n < 2; ++n) bv[bj][n] = bias ? *(const f32x4*)(bias + bcol0 + bj * HALF + 4 * n) : (f32x4){0.f, 0.f, 0.f, 0.f};
#pragma unroll
        for (int ai = 0; ai < 2; ++ai)
#pragma unroll
            for (int m = 0; m < 4; ++m) { bf16_t* rowp = base + (size_t)(row0 + ai * HALF + m * 16) * ldc + col0;
#pragma unroll
                for (int bj = 0; bj < 2; ++bj) { f32x4 v0 = acc[ai][bj][m][0] + bv[bj][0], v1 = acc[ai][bj][m][1] + bv[bj][1];
                    if (ACT == 1) { f32x2 a = gelu_pk((f32x2){v0[0], v0[1]}), b = gelu_pk((f32x2){v0[2], v0[3]}), c = gelu_pk((f32x2){v1[0], v1[1]}), d = gelu_pk((f32x2){v1[2], v1[3]});
                        v0 = (f32x4){a.x, a.y, b.x, b.y}; v1 = (f32x4){c.x, c.y, d.x, d.y}; }
                    v0 = v0 * sc; v1 = v1 * sc; u32x4 w; w.x = cvt_pk_bf16(v0[0], v0[1]); w.y = cvt_pk_bf16(v0[2], v0[3]); w.z = cvt_pk_bf16(v1[0], v1[1]); w.w = cvt_pk_bf16(v1[2], v1[3]);
                    *(u32x4*)(rowp + bj * HALF) = w; } }
    }
};

struct EpiG1m {
    static constexpr bool PERM = true, AFTER_DRAIN = false;
    bf16_t *ug, *vg; unsigned char *qs, *kimg, *vimg; const float *qg, *kg, *rope; PG8_LAS float* xs; int pm_off, pn_off; float wi;
    __device__ __forceinline__ void operator()(const f32x4 (&acc)[2][2][4][2], const Unit& u_, int wr, int wc_, int fr_, int fq_) const {
        const Unit u{u_.pm + pm_off, u_.pn + pn_off}; const float WI = wi;
        int wc = wc_, fr = fr_, fq = fq_;
        asm volatile("" : "+s"(wc), "+v"(fr), "+v"(fq));
        const int colt = u.pn * BM;
        if (colt < 2048) {
            if (u.pm == 0) return;
            bf16_t* base = (colt < 1024) ? ug : vg; const int cbase = colt & 1023;
            const int row0 = u.pm * BM + wr * 64 + fr - 256, col0 = cbase + wc * 32 + 8 * fq;
#pragma unroll
            for (int ai = 0; ai < 2; ++ai)
#pragma unroll
                for (int m = 0; m < 4; ++m) { bf16_t* rowp = base + (size_t)(row0 + ai * HALF + m * 16) * 1024 + col0;
#pragma unroll
                    for (int bj = 0; bj < 2; ++bj) { const f32x4 v0 = acc[ai][bj][m][0], v1 = acc[ai][bj][m][1];
                        const f32x2 a = gelu_pk((f32x2){v0[0], v0[1]}), b = gelu_pk((f32x2){v0[2], v0[3]}), c = gelu_pk((f32x2){v1[0], v1[1]}), d = gelu_pk((f32x2){v1[2], v1[3]});
                        u32x4 w; w.x = cvt_pk_bf16(a.x, a.y); w.y = cvt_pk_bf16(b.x, b.y); w.z = cvt_pk_bf16(c.x, c.y); w.w = cvt_pk_bf16(d.x, d.y);
                        *(u32x4*)(rowp + bj * HALF) = w; } }
        } else if (colt < 4096) {
            const bool isq = colt < 3072;
            if (isq && u.pm == 0) return;
            const bool latent = u.pm != 0;
            const int head0 = (colt - (isq ? 2048 : 3072)) >> 7, comp = wc >> 1, cin = 32 * (wc & 1) + 8 * fq;
            const float* gn = (isq ? qg : kg) + cin;
            const f32x4 g0 = *(const f32x4*)gn, g1 = *(const f32x4*)(gn + 4);
#pragma unroll
            for (int ai = 0; ai < 2; ++ai)
#pragma unroll
                for (int m = 0; m < 4; ++m)
#pragma unroll
                    for (int bj = 0; bj < 2; ++bj) { const f32x4 v0 = acc[ai][bj][m][0], v1 = acc[ai][bj][m][1];
                        float s_ = ((v0[0] * v0[0] + v0[1] * v0[1]) + (v0[2] * v0[2] + v0[3] * v0[3])) + ((v1[0] * v1[0] + v1[1] * v1[1]) + (v1[2] * v1[2] + v1[3] * v1[3]));
                        s_ += __shfl_xor(s_, 16); s_ += __shfl_xor(s_, 32);
                        if (fq == 0) xs[((ai * HALF + wr * 64 + m * 16 + fr) * 2 + bj) * 4 + wc] = s_; }
            asm volatile("s_waitcnt lgkmcnt(0)" ::: "memory"); __builtin_amdgcn_s_barrier(); asm volatile("" ::: "memory");
            const float mul = isq ? QSCALE : 1.0f;
#pragma unroll
            for (int ai = 0; ai < 2; ++ai)
#pragma unroll
                for (int m = 0; m < 4; ++m) { const int rl = ai * HALF + wr * 64 + m * 16 + fr, row = u.pm * BM + rl, pos = row - CTX;
                    const int tp = (wc & 1) ? 256 + (pos & 63) : (pos >> 6);
                    const float* tb = rope + ((size_t)(latent ? tp : 0) * 16 + 4 * fq) * 2;
                    f32x4 t0 = *(const f32x4*)tb, t1 = *(const f32x4*)(tb + 4);
                    if (!latent) { t0 = (f32x4){1.f, 0.f, 1.f, 0.f}; t1 = t0; }
#pragma unroll
                    for (int bj = 0; bj < 2; ++bj) { const float tot = xs[(rl * 2 + bj) * 4 + wc] + xs[(rl * 2 + bj) * 4 + (wc ^ 1)];
                        const float r_ = WI / sqrtf(tot * (WI * WI / 64.0f) + EPS);
                        const f32x4 a0 = acc[ai][bj][m][0] * r_ * g0, a1 = acc[ai][bj][m][1] * r_ * g1;
                        const float e0 = (a0[0] * t0[0] - a0[1] * t0[1]) * mul, o0 = (a0[0] * t0[1] + a0[1] * t0[0]) * mul, e1 = (a0[2] * t0[2] - a0[3] * t0[3]) * mul, o1 = (a0[2] * t0[3] + a0[3] * t0[2]) * mul;
                        const float e2 = (a1[0] * t1[0] - a1[1] * t1[1]) * mul, o2 = (a1[0] * t1[1] + a1[1] * t1[0]) * mul, e3 = (a1[2] * t1[2] - a1[3] * t1[3]) * mul, o3 = (a1[2] * t1[3] + a1[3] * t1[2]) * mul;
                        int w0 = __builtin_amdgcn_cvt_pk_fp8_f32(e0, o0, 0, false); w0 = __builtin_amdgcn_cvt_pk_fp8_f32(e1, o1, w0, true);
                        int w1 = __builtin_amdgcn_cvt_pk_fp8_f32(e2, o2, 0, false); w1 = __builtin_amdgcn_cvt_pk_fp8_f32(e3, o3, w1, true);
                        const u32x2 w = {(unsigned)w0, (unsigned)w1};
                        const int head = head0 + bj;
                        if (isq) *(u32x2*)(qs + ((size_t)head * SEQ + pos) * 128 + comp * 64 + cin) = w;
                        else *(u32x2*)(kimg + ((size_t)head * NTILE + (row >> 6)) * 8192 + k8_off(row & 63, comp * 64 + cin)) = w; }
                    asm volatile("" ::: "memory"); }
        } else {
            const int row0 = u.pm * BM + wr * 64 + fr, c0 = wc * 32 + 8 * fq, head0 = (colt - 4096) >> 7;
#pragma unroll
            for (int ai = 0; ai < 2; ++ai)
#pragma unroll
                for (int m = 0; m < 4; ++m) { const int row = row0 + ai * HALF + m * 16;
#pragma unroll
                    for (int bj = 0; bj < 2; ++bj) { const f32x4 v0 = acc[ai][bj][m][0], v1 = acc[ai][bj][m][1];
                        int w0 = __builtin_amdgcn_cvt_pk_fp8_f32(v0[0] * WI, v0[1] * WI, 0, false); w0 = __builtin_amdgcn_cvt_pk_fp8_f32(v0[2] * WI, v0[3] * WI, w0, true);
                        int w1 = __builtin_amdgcn_cvt_pk_fp8_f32(v1[0] * WI, v1[1] * WI, 0, false); w1 = __builtin_amdgcn_cvt_pk_fp8_f32(v1[2] * WI, v1[3] * WI, w1, true);
                        unsigned char* ib = vimg + ((size_t)(head0 + bj) * NTILE + (row >> 6)) * 8192;
#pragma unroll
                        for (int i = 0; i < 4; ++i) { ib[v8_off(row & 63, c0 + i)] = (unsigned char)((unsigned)w0 >> (8 * i)); ib[v8_off(row & 63, c0 + 4 + i)] = (unsigned char)((unsigned)w1 >> (8 * i)); } } }
        }
    }
};
struct EpiOutm {
    static constexpr bool PERM = true, AFTER_DRAIN = false;
    const float* x; const float* g1; bf16_t* xn; float* rss;
    __device__ __forceinline__ void operator()(const f32x4 (&acc)[2][2][4][2], const Unit& u, int wr, int wc, int fr, int fq) const {
        const int row0 = u.pm * BM + wr * 64 + fr, col0 = u.pn * BM + wc * 32 + 8 * fq;
        f32x4 gv[2][2];
#pragma unroll
        for (int bj = 0; bj < 2; ++bj)
#pragma unroll
            for (int n = 0; n < 2; ++n) gv[bj][n] = *(const f32x4*)(g1 + col0 + bj * HALF + 4 * n);
#pragma unroll
        for (int ai = 0; ai < 2; ++ai)
#pragma unroll
            for (int m = 0; m < 4; ++m) { const int row = row0 + ai * HALF + m * 16; const size_t off = (size_t)row * 2048 + col0; float ss = 0.f;
#pragma unroll
                for (int bj = 0; bj < 2; ++bj) {
                    const f32x4 v0 = *(const f32x4*)(x + off + bj * HALF) + gv[bj][0] * acc[ai][bj][m][0], v1 = *(const f32x4*)(x + off + bj * HALF + 4) + gv[bj][1] * acc[ai][bj][m][1];
                    ss += ((v0[0] * v0[0] + v0[1] * v0[1]) + (v0[2] * v0[2] + v0[3] * v0[3])) + ((v1[0] * v1[0] + v1[1] * v1[1]) + (v1[2] * v1[2] + v1[3] * v1[3]));
                    u32x4 w; w.x = cvt_pk_bf16(v0[0], v0[1]); w.y = cvt_pk_bf16(v0[2], v0[3]); w.z = cvt_pk_bf16(v1[0], v1[1]); w.w = cvt_pk_bf16(v1[2], v1[3]);
                    *(u32x4*)(xn + off + bj * HALF) = w; }
                ss += __shfl_xor(ss, 16); ss += __shfl_xor(ss, 32);
                if (fq == 0) rss[(size_t)row * 32 + u.pn * 4 + wc] = ss; }
    }
};
struct EpiQp {
    static constexpr bool PERM = true, AFTER_DRAIN = false;
    bf16_t* q; const float* rss; const float* bq;
    __device__ __forceinline__ void operator()(const f32x4 (&acc)[2][2][4][2], const Unit& u, int wr, int wc, int fr, int fq) const {
        const int row0 = u.pm * BM + wr * 64 + fr, col0 = u.pn * BM + wc * 32 + 8 * fq;
        f32x4 bv[2][2];
#pragma unroll
        for (int bj = 0; bj < 2; ++bj)
#pragma unroll
            for (int n = 0; n < 2; ++n) bv[bj][n] = *(const f32x4*)(bq + col0 + bj * HALF + 4 * n);
#pragma unroll
        for (int ai = 0; ai < 2; ++ai)
#pragma unroll
            for (int m = 0; m < 4; ++m) { const int row = row0 + ai * HALF + m * 16;
                const f32x4 p0 = *(const f32x4*)(rss + (size_t)row * 32 + fq * 8), p1 = *(const f32x4*)(rss + (size_t)row * 32 + fq * 8 + 4);
                float ss = ((p0[0] + p0[1]) + (p0[2] + p0[3])) + ((p1[0] + p1[1]) + (p1[2] + p1[3]));
                ss += __shfl_xor(ss, 16); ss += __shfl_xor(ss, 32);
                const float r_ = 1.0f / sqrtf(ss * (1.0f / 2048.0f) + EPS);
                bf16_t* rowp = q + (size_t)row * 2048 + col0;
#pragma unroll
                for (int bj = 0; bj < 2; ++bj) { const f32x4 v0 = acc[ai][bj][m][0] * r_ + bv[bj][0], v1 = acc[ai][bj][m][1] * r_ + bv[bj][1];
                    u32x4 w; w.x = cvt_pk_bf16(v0[0], v0[1]); w.y = cvt_pk_bf16(v0[2], v0[3]); w.z = cvt_pk_bf16(v1[0], v1[1]); w.w = cvt_pk_bf16(v1[2], v1[3]);
                    *(u32x4*)(rowp + bj * HALF) = w; } }
    }
};
typedef int pg8_i32x4 __attribute__((ext_vector_type(4)));
template <class Epi, class Sched, bool ALIGN_EPI = false, bool SP2 = false, bool FP8 = false>
__device__ __forceinline__ void gemm_phase(PG8_LAS unsigned char* lds, const Gemm g, const Sched& S, const Epi& E) {
    const int tid = threadIdx.x, wid = __builtin_amdgcn_readfirstlane(tid >> 6), lane = tid & 63, wr = wid >> 2, wc = wid & 3, fr = lane & 15, fq = lane >> 4;
    const int K = g.K, nt = K / BK;
    unsigned voffA[2], voffB[2];
#pragma unroll
    for (int i = 0; i < 2; ++i) { int R, C; stage_rc(tid * 16 + i * 8192, R, C); const int Rb = Epi::PERM ? ((R & ~31) + perm32(R & 31)) : R;
        voffA[i] = (unsigned)(R * K + C) * 2u; voffB[i] = (unsigned)(Rb * K + C) * 2u; }
    const size_t kstep = (size_t)(BK * 2);
    const size_t hstep = (size_t)HALF * K * 2;
    const size_t tstep = 2 * hstep;
    const unsigned ldsw = (unsigned)wid * 1024u;
    const int aoff = lds_byte(wr * 64 + fr, fq * 8), boff = lds_byte(wc * 32 + fr, fq * 8);
#define PG8_SA(b, h) (((b) * 2 + (h)) * HTB)
#define PG8_SB(b, h) ((4 + (b) * 2 + (h)) * HTB)
#define PG8_STAGE(bufoff, gbase, voff) do { _Pragma("unroll") for (int _i = 0; _i < 2; ++_i) \
        __builtin_amdgcn_global_load_lds((const unsigned*)((const char*)(gbase) + (voff)[_i]), (PG8_LAS unsigned*)(lds + (bufoff) + ldsw + _i * 8192), 16, 0, 0); } while (0)
#define PG8_LDA(dst, b, h) do { _Pragma("unroll") for (int m = 0; m < 4; ++m) _Pragma("unroll") for (int k = 0; k < 2; ++k) dst[m][k] = *(const PG8_LAS bf16x8*)(lds + PG8_SA(b, h) + aoff + m * 2048 + k * 1024); } while (0)
#define PG8_LDB(dst, b, h) do { _Pragma("unroll") for (int n = 0; n < 2; ++n) _Pragma("unroll") for (int k = 0; k < 2; ++k) dst[n][k] = *(const PG8_LAS bf16x8*)(lds + PG8_SB(b, h) + boff + n * 2048 + k * 1024); } while (0)
#define PG8_CAT(X) __builtin_shufflevector(__builtin_bit_cast(pg8_i32x4, X[0]), __builtin_bit_cast(pg8_i32x4, X[1]), 0, 1, 2, 3, 4, 5, 6, 7)
#define PG8_MMA(ai, bj, At, Bt) do { __builtin_amdgcn_s_setprio(1); _Pragma("unroll") for (int m = 0; m < 4; ++m) _Pragma("unroll") for (int n = 0; n < 2; ++n) { \
        if constexpr (FP8) asm volatile("v_mfma_f32_16x16x128_f8f6f4 %0, %1, %2, %0" : "+v"(acc[ai][bj][m][n]) : "v"(PG8_CAT(Bt[n])), "v"(PG8_CAT(At[m])));   \
        else { _Pragma("unroll") for (int k = 0; k < 2; ++k) acc[ai][bj][m][n] = __builtin_amdgcn_mfma_f32_16x16x32_bf16(Bt[n][k], At[m][k], acc[ai][bj][m][n], 0, 0, 0); } } __builtin_amdgcn_s_setprio(0); } while (0)
#define PG8_WAIT_V(n) asm volatile("s_waitcnt vmcnt(" #n ")" ::: "memory")
#define PG8_WAIT_L(n) asm volatile("s_waitcnt lgkmcnt(" #n ")" ::: "memory")
#define PG8_BAR __builtin_amdgcn_s_barrier()
#define PG8_SCHED __builtin_amdgcn_sched_barrier(0)
    Unit cur, nxt; int ui = 0;
    if (!S.next(0, cur)) return;
    f32x4 acc[2][2][4][2];
#pragma unroll
    for (int a = 0; a < 2; ++a)
#pragma unroll
        for (int b = 0; b < 2; ++b)
#pragma unroll
            for (int m = 0; m < 4; ++m)
#pragma unroll
                for (int n = 0; n < 2; ++n) acc[a][b][m][n] = (f32x4){0.f, 0.f, 0.f, 0.f};
    bf16x8 At[4][2], B0[2][2], B1[2][2];
    const char* cA = (const char*)g.A + (size_t)cur.pm * tstep; const char* cB = (const char*)g.Bt + (size_t)cur.pn * tstep;
    S.a_ready(cur);
    if constexpr (SP2) {
        PG8_STAGE(PG8_SB(0, 0), cB, voffB); PG8_STAGE(PG8_SB(0, 1), cB + hstep, voffB); PG8_STAGE(PG8_SA(0, 0), cA, voffA); PG8_STAGE(PG8_SA(0, 1), cA + hstep, voffA);
        if (wr == 1) PG8_BAR;
        PG8_WAIT_V(2); PG8_BAR;
        PG8_STAGE(PG8_SB(1, 0), cB + kstep, voffB); PG8_STAGE(PG8_SA(1, 0), cA + kstep, voffA); PG8_STAGE(PG8_SB(1, 1), cB + hstep + kstep, voffB);
        PG8_WAIT_V(6); PG8_BAR;
    } else {
        PG8_STAGE(PG8_SB(0, 0), cB, voffB); PG8_STAGE(PG8_SA(0, 0), cA, voffA); PG8_STAGE(PG8_SB(0, 1), cB + hstep, voffB); PG8_STAGE(PG8_SA(0, 1), cA + hstep, voffA);
        if (wr == 1) PG8_BAR;
        PG8_WAIT_V(4); PG8_BAR;
        PG8_STAGE(PG8_SB(1, 0), cB + kstep, voffB); PG8_STAGE(PG8_SA(1, 0), cA + kstep, voffA); PG8_STAGE(PG8_SB(1, 1), cB + hstep + kstep, voffB);
        PG8_WAIT_V(6); PG8_BAR;
    }
    for (;;) {
        const bool has_next = S.next(ui + 1, nxt);
        const char* nA = has_next ? (const char*)g.A + (size_t)nxt.pm * tstep : cA; const char* nB = has_next ? (const char*)g.Bt + (size_t)nxt.pn * tstep : cB;
        for (int t = 0; t < nt; t += 2) {
            const bool last = (t == nt - 2);
            const char* a1 = cA + (size_t)(t + 1) * kstep;
            const char* a2 = last ? nA : cA + (size_t)(t + 2) * kstep; const char* b2 = last ? nB : cB + (size_t)(t + 2) * kstep;
            const char* a3 = a2 + kstep; const char* b3 = b2 + kstep;
            if (last && has_next) S.a_ready(nxt);
            if constexpr (SP2) {
            PG8_LDB(B0, 0, 0); PG8_LDB(B1, 0, 1); PG8_SCHED; PG8_LDA(At, 0, 0); PG8_STAGE(PG8_SA(1, 1), a1 + hstep, voffA);
            PG8_WAIT_V(8); PG8_WAIT_L(0); PG8_BAR; PG8_MMA(0, 0, At, B0); PG8_MMA(0, 1, At, B1); PG8_BAR; PG8_SCHED;
            PG8_LDA(At, 0, 1); PG8_STAGE(PG8_SB(0, 0), b2, voffB); PG8_STAGE(PG8_SB(0, 1), b2 + hstep, voffB); PG8_STAGE(PG8_SA(0, 0), a2, voffA);
            PG8_WAIT_V(8); PG8_WAIT_L(0); PG8_BAR; PG8_MMA(1, 0, At, B0); PG8_MMA(1, 1, At, B1); PG8_BAR; PG8_SCHED;
            PG8_LDB(B0, 1, 0); PG8_LDB(B1, 1, 1); PG8_SCHED; PG8_LDA(At, 1, 0); PG8_STAGE(PG8_SA(0, 1), a2 + hstep, voffA);
            PG8_WAIT_V(8); PG8_WAIT_L(0); PG8_BAR; PG8_MMA(0, 0, At, B0); PG8_MMA(0, 1, At, B1); PG8_BAR; PG8_SCHED;
            PG8_LDA(At, 1, 1); PG8_STAGE(PG8_SB(1, 0), b3, voffB); PG8_STAGE(PG8_SB(1, 1), b3 + hstep, voffB); PG8_STAGE(PG8_SA(1, 0), a3, voffA);
            PG8_WAIT_V(8); PG8_WAIT_L(0); PG8_BAR; PG8_MMA(1, 0, At, B0); PG8_MMA(1, 1, At, B1); PG8_BAR; PG8_SCHED;
            } else {
            PG8_LDB(B0, 0, 0); PG8_SCHED; PG8_LDA(At, 0, 0); PG8_STAGE(PG8_SA(1, 1), a1 + hstep, voffA);
            PG8_WAIT_L(8); PG8_BAR; PG8_WAIT_L(0); PG8_MMA(0, 0, At, B0); PG8_BAR; PG8_SCHED;
            PG8_LDB(B1, 0, 1); PG8_STAGE(PG8_SB(0, 0), b2, voffB);
            PG8_BAR; PG8_WAIT_L(0); PG8_MMA(0, 1, At, B1); PG8_BAR;
            PG8_LDA(At, 0, 1); PG8_STAGE(PG8_SA(0, 0), a2, voffA);
            PG8_BAR; PG8_WAIT_L(0); PG8_MMA(1, 0, At, B0); PG8_BAR; PG8_SCHED;
            PG8_STAGE(PG8_SB(0, 1), b2 + hstep, voffB);
            PG8_WAIT_V(6); PG8_BAR; PG8_MMA(1, 1, At, B1); PG8_BAR;
            PG8_LDB(B0, 1, 0); PG8_SCHED; PG8_LDA(At, 1, 0); PG8_STAGE(PG8_SA(0, 1), a2 + hstep, voffA);
            PG8_WAIT_L(8); PG8_BAR; PG8_WAIT_L(0); PG8_MMA(0, 0, At, B0); PG8_BAR; PG8_SCHED;
            PG8_LDB(B1, 1, 1); PG8_STAGE(PG8_SB(1, 0), b3, voffB);
            PG8_BAR; PG8_WAIT_L(0); PG8_MMA(0, 1, At, B1); PG8_BAR;
            PG8_LDA(At, 1, 1); PG8_STAGE(PG8_SA(1, 0), a3, voffA);
            PG8_BAR; PG8_WAIT_L(0); PG8_MMA(1, 0, At, B0); PG8_BAR; PG8_SCHED;
            PG8_STAGE(PG8_SB(1, 1), b3 + hstep, voffB);
            PG8_WAIT_V(6); PG8_BAR; PG8_MMA(1, 1, At, B1); PG8_BAR;
            }
        }
        if constexpr (ALIGN_EPI) { if (wr == 0) PG8_BAR; }
        if constexpr (FP8) asm volatile("s_nop 15\n\ts_nop 15" ::: "memory");
        if constexpr (!Epi::AFTER_DRAIN) { E(acc, cur, wr, wc, fr, fq); S.done(cur); }
        if (!has_next) break;
#pragma unroll
        for (int a = 0; a < 2; ++a)
#pragma unroll
            for (int b = 0; b < 2; ++b)
#pragma unroll
                for (int m = 0; m < 4; ++m)
#pragma unroll
                    for (int n = 0; n < 2; ++n) acc[a][b][m][n] = (f32x4){0.f, 0.f, 0.f, 0.f};
        cur = nxt; cA = nA; cB = nB; ++ui;
        if constexpr (ALIGN_EPI) { if (wr == 1) PG8_BAR; }
    }
    PG8_WAIT_V(0);
    if constexpr (!ALIGN_EPI) { if (wr == 0) PG8_BAR; }
    PG8_BAR;
    if constexpr (Epi::AFTER_DRAIN) { E.fused(acc, cur, wr, wc, fr, fq, lds, wid, lane); S.done(cur); }
#undef PG8_SA
#undef PG8_SB
#undef PG8_STAGE
#undef PG8_LDA
#undef PG8_LDB
#undef PG8_MMA
#undef PG8_CAT
#undef PG8_WAIT_V
#undef PG8_WAIT_L
#undef PG8_BAR
#undef PG8_SCHED
}
}


#define LAS __attribute__((address_space(3)))
namespace att {
using bf16x8 = __attribute__((ext_vector_type(8))) short;
using s16x4 = __attribute__((ext_vector_type(4))) short;
#define KSWZ(row, colB) ((row) * 256 + ((colB) ^ (((row) & 15) << 4)))
__device__ __forceinline__ int crow(int r, int hi) { return (r & 3) + 8 * (r >> 2) + 4 * hi; }
__device__ __forceinline__ int v_rd_base(int lane) { return ((lane & 3) << 3) | (((lane >> 2) & 3) << 6) | (((lane >> 4) & 1) << 5) | (((lane >> 5) & 1) << 8); }
constexpr int v_rd_off(int d0, int ks, int half) { return d0 * 512 + ks * 4096 + half * 2048; }
template <int OFF> __device__ __forceinline__ s16x4 tr_read(int vb) { s16x4 r; asm volatile("ds_read_b64_tr_b16 %0, %1 offset:%2" : "=&v"(r) : "v"(vb), "i"(OFF) : "memory"); return r; }
typedef __attribute__((address_space(3))) const char* lds_cptr;
typedef short v4i16_t __attribute__((ext_vector_type(4)));
typedef float f32x2_t __attribute__((ext_vector_type(2)));
typedef __bf16 bf16x2_t __attribute__((ext_vector_type(2)));
__device__ __forceinline__ void glds16(const void* gsrc, unsigned lds_dst) { unsigned keep;
    asm volatile("s_mov_b32 %0, m0\n\ts_mov_b32 m0, %2\n\ts_nop 0\n\tglobal_load_lds_dwordx4 %1, off\n\ts_mov_b32 m0, %0" : "=&s"(keep) : "v"(gsrc), "s"(lds_dst) : "memory"); }
typedef int i32x8 __attribute__((ext_vector_type(8)));
typedef int i32x4v __attribute__((ext_vector_type(4)));
__device__ __forceinline__ i32x8 ld32(lds_cptr a, lds_cptr b) { const i32x4v x = *(const LAS i32x4v*)a, y = *(const LAS i32x4v*)b; return (i32x8){x[0], x[1], x[2], x[3], y[0], y[1], y[2], y[3]}; }
__device__ __forceinline__ void attn_unit8(const Params& p, int h, int qb, char* lds) {
    int tid = threadIdx.x;
    asm volatile("" : "+v"(tid));
    const int wid = tid >> 6, lane = tid & 63, r32 = lane & 31, hi = lane >> 5;
    constexpr int A8_V = 0, A8_K = 49152, A8_Q = 98304, A8_WS = 131072;
    const int vs = (r32 >> 2) & 3, lb = (int)(uintptr_t)lds;
    const int vo0 = lb + r32 * 64 + (((2 * hi) ^ vs) << 4), vo1 = lb + r32 * 64 + (((2 * hi + 1) ^ vs) << 4);
    const int qv0 = vo0 + A8_Q + wid * 4096, qv1 = vo1 + A8_Q + wid * 4096;
    {   const unsigned char* Qw = P_QS8(p) + ((size_t)h * SEQ + (size_t)qb * 256 + wid * 32 + r32) * 128 + hi * 32;
        const i32x4v a0 = *(const i32x4v*)Qw, a1 = *(const i32x4v*)(Qw + 16), b0 = *(const i32x4v*)(Qw + 64), b1 = *(const i32x4v*)(Qw + 80);
        *(LAS i32x4v*)(uintptr_t)(unsigned)qv0 = a0; *(LAS i32x4v*)(uintptr_t)(unsigned)qv1 = a1; *(LAS i32x4v*)(uintptr_t)(unsigned)(qv0 + 2048) = b0; *(LAS i32x4v*)(uintptr_t)(unsigned)(qv1 + 2048) = b1;
    }
    const unsigned char* kimg = P_KIMG8(p) + (size_t)h * NTILE * 8192 + tid * 16;
    const unsigned char* vimg = P_VIMG8(p) + (size_t)h * NTILE * 8192 + tid * 16;
    const unsigned ldsw = (unsigned)__builtin_amdgcn_readfirstlane(wid) * 1024u;
    const unsigned kdst = (unsigned)(uintptr_t)(lds + A8_K) + ldsw, vdst = (unsigned)(uintptr_t)(lds + A8_V) + ldsw;
#define GLDSK(t, b) do { const size_t o_ = (size_t)(t) * 16384; _Pragma("unroll") for (int i_ = 0; i_ < 2; ++i_) glds16(kimg + o_ + i_ * 8192, (unsigned)__builtin_amdgcn_readfirstlane(kdst + (b) * 16384 + i_ * 8192)); } while (0)
#define GLDSV(t, b) do { const size_t o_ = (size_t)(t) * 16384; _Pragma("unroll") for (int i_ = 0; i_ < 2; ++i_) glds16(vimg + o_ + i_ * 8192, (unsigned)__builtin_amdgcn_readfirstlane(vdst + (b) * 16384 + i_ * 8192)); } while (0)
    f32x16 oA[4], oB[4]; f32x4 lAc = {0.f, 0.f, 0.f, 0.f}, lBc = {0.f, 0.f, 0.f, 0.f};
    i32x8 onesB; { const int ow = (((lane & 15) == 0 && !((lane >> 4) & 1)) || ((lane & 15) == 1 && ((lane >> 4) & 1))) ? 0x38383838 : 0;
#pragma unroll
        for (int i = 0; i < 8; ++i) onesB[i] = ow; }
#pragma unroll
    for (int d = 0; d < 4; ++d) { oA[d] = f32x16{}; oB[d] = f32x16{}; }
    f32x16 sA0, sA1, sB0, sB1; i32x8 pA = {}, pB = {}, kx, ky, vx, vy, qA, qB;
#define SB() __builtin_amdgcn_sched_barrier(0)
#define RD(a0_, a1_, imm_) ld32((lds_cptr)(uintptr_t)(unsigned)((a0_) + (imm_)), (lds_cptr)(uintptr_t)(unsigned)((a1_) + (imm_)))
#define MMS(A_, B_) __builtin_amdgcn_mfma_scale_f32_32x32x64_f8f6f4(A_, B_, f32x16{}, 0, 0, 0, 0, 0, 0)
#define MMO(ACC, A_, B_) ACC = __builtin_amdgcn_mfma_scale_f32_32x32x64_f8f6f4(A_, B_, ACC, 1, 0, 0, 0, 0, 0)
#define EX4(S, B) do { S[B] = __builtin_amdgcn_exp2f(S[B]); S[B + 1] = __builtin_amdgcn_exp2f(S[B + 1]); S[B + 2] = __builtin_amdgcn_exp2f(S[B + 2]); S[B + 3] = __builtin_amdgcn_exp2f(S[B + 3]); } while (0)
#define MML(ACC, A_) ACC = __builtin_amdgcn_mfma_scale_f32_16x16x128_f8f6f4(A_, onesB, ACC, 1, 0, 0, 0, 0, 0)
#define PK4(S, B, OUT, I) do { OUT[I] = __builtin_amdgcn_cvt_pk_bf8_f32(S[B], S[B + 1], OUT[I], false); OUT[I] = __builtin_amdgcn_cvt_pk_bf8_f32(S[B + 2], S[B + 3], OUT[I], true); } while (0)
#define HALFE(S, O, P, I) do { EX4(S, O); EX4(S, (O) + 4); PK4(S, O, P, I); PK4(S, (O) + 4, P, (I) + 1); } while (0)
#define GROUPP(C0, C1, KI, VI, Q0, Q1, QI, N0, N1, NI, D1, D2, D3, D4) do { \
          vx = RD(Q0, Q1, (QI)); vy = RD(Q0, Q1, (QI) + 2048); SB(); sB0 = MMS(kx, qB); SB(); \
          MML(lBc, pB); MMO(oB[0], pB, vx); HALFE(sA0, 0, pA, 0); D1; SB(); \
          vx = RD(Q0, Q1, (QI) + 4096); SB(); MMO(oB[1], pB, vy); HALFE(sA0, 8, pA, 2); SB(); \
          vy = RD(Q0, Q1, (QI) + 6144); ky = RD(C0, C1, (KI) + 4096 + 2048); SB(); MMO(oB[2], pB, vx); HALFE(sA1, 0, pA, 4); D2; SB(); \
          vx = RD(C0, C1, (VI)); SB(); MMO(oB[3], pB, vy); sB1 = MMS(ky, qB); HALFE(sA1, 8, pA, 6); SB(); \
          vy = RD(C0, C1, (VI) + 2048); SB(); MML(lAc, pA); MMO(oA[0], pA, vx); D3; SB(); \
          vx = RD(C0, C1, (VI) + 4096); SB(); MMO(oA[1], pA, vy); HALFE(sB0, 0, pB, 0); SB(); \
          vy = RD(C0, C1, (VI) + 6144); kx = RD(N0, N1, (NI)); qA = RD(qv0, qv1, 0); SB(); MMO(oA[2], pA, vx); HALFE(sB0, 8, pB, 2); D4; SB(); \
          ky = RD(N0, N1, (NI) + 2048); SB(); MMO(oA[3], pA, vy); sA0 = MMS(kx, qA); HALFE(sB1, 0, pB, 4); SB(); \
          kx = RD(N0, N1, (NI) + 4096); qB = RD(qv0, qv1, 2048); SB(); sA1 = MMS(ky, qA); HALFE(sB1, 8, pB, 6); \
        asm volatile("" : "+v"(pB));        \
        SB(); } while (0)
    GLDSK(0, 0); GLDSV(0, 0); GLDSK(1, 1); GLDSV(1, 1);
    asm volatile("s_waitcnt vmcnt(0)" ::: "memory"); __syncthreads();
    int bcur = 0;
    int cb0 = vo0, cb1 = vo1;
    kx = RD(cb0, cb1, A8_K); ky = RD(cb0, cb1, A8_K + 2048); qA = RD(qv0, qv1, 0); sA0 = MMS(kx, qA); sA1 = MMS(ky, qA); SB();
    kx = RD(cb0, cb1, A8_K + 4096); qB = RD(qv0, qv1, 2048); SB();
    for (int j = 0; j < NTILE / 2; ++j) {
        const int bnx = (bcur == 2) ? 0 : bcur + 1, bn2 = (bnx == 2) ? 0 : bnx + 1;
        const int dprev = (j == 0) ? 0 : ((bcur == 0) ? 32768 : -16384), dnext = (bcur == 2) ? -32768 : 16384;
        {   int pb0 = cb0 + dprev, pb1 = cb1 + dprev;
            asm volatile("" : "+v"(pb0), "+v"(pb1));
            GROUPP(cb0, cb1, A8_K, A8_V, pb0, pb1, A8_V + 8192, cb0, cb1, A8_K + 8192, (void)0, (void)0, (void)0, (void)0); }
        asm volatile("s_waitcnt vmcnt(0)" ::: "memory"); __syncthreads();
        {
            const int tl = (j + 2 < NTILE / 2) ? j + 2 : NTILE / 2 - 1; const size_t to_ = (size_t)tl * 16384;
            const unsigned kd_ = (unsigned)__builtin_amdgcn_readfirstlane(kdst + bn2 * 16384), vd_ = (unsigned)__builtin_amdgcn_readfirstlane(vdst + bn2 * 16384);
            int nb0 = cb0 + dnext, nb1 = cb1 + dnext;
            asm volatile("" : "+v"(nb0), "+v"(nb1));
            GROUPP(cb0, cb1, A8_K + 8192, A8_V + 8192, cb0, cb1, A8_V, nb0, nb1, A8_K,
                   glds16(kimg + to_, kd_), glds16(kimg + to_ + 8192, kd_ + 8192), glds16(vimg + to_, vd_), glds16(vimg + to_ + 8192, vd_ + 8192));
            cb0 = nb0; cb1 = nb1; }
        bcur = bnx;
    }
    asm volatile("s_waitcnt vmcnt(0)" ::: "memory");
    {   const int dl = (bcur == 0) ? 32768 : -16384; const int pb0 = cb0 + dl, pb1 = cb1 + dl;
        vx = RD(pb0, pb1, A8_V + 8192); vy = RD(pb0, pb1, A8_V + 8192 + 2048); MML(lBc, pB); MMO(oB[0], pB, vx); MMO(oB[1], pB, vy); SB();
        vx = RD(pb0, pb1, A8_V + 8192 + 4096); vy = RD(pb0, pb1, A8_V + 8192 + 6144); MMO(oB[2], pB, vx); MMO(oB[3], pB, vy); }
    __syncthreads();
#undef SB
#undef RD
#undef MMS
#undef MMO
#undef EX4
#undef MML
#undef PK4
#undef HALFE
#undef GROUPP
#undef GLDSK
#undef GLDSV
    int tide = threadIdx.x;
    asm volatile("" : "+v"(tide));
    const int r32e = tide & 31, hie = (tide >> 5) & 1, wide = tide >> 6;
    const float lam = P_SCAL(p)[0];
    float* wsf = (float*)(lds + A8_WS) + wide * 64;
    {   const int lq = 16 * (r32e & 15) + 4 * ((r32e >> 4) + 2 * hie);
        if ((r32e & 15) <= 1) {
#pragma unroll
            for (int r = 0; r < 4; ++r) { wsf[lq + r] = __builtin_amdgcn_rcpf(lAc[r]); wsf[32 + lq + r] = lam * __builtin_amdgcn_rcpf(lBc[r]); } } }
    asm volatile("s_waitcnt lgkmcnt(0)" ::: "memory");
    const unsigned tb = (unsigned)(uintptr_t)lds + (unsigned)wide * 8192u;
    const float g0 = p.subln_g[r32e] * (1.0f - LAM_INIT), g1 = p.subln_g[32 + r32e] * (1.0f - LAM_INIT), g2 = p.subln_g[64 + r32e] * (1.0f - LAM_INIT), g3 = p.subln_g[96 + r32e] * (1.0f - LAM_INIT);
#define DPPQ(v_, ctl_) __builtin_bit_cast(float, __builtin_amdgcn_update_dpp(0, __builtin_bit_cast(int, v_), ctl_, 0xF, 0xF, true))
#pragma unroll
    for (int r = 0; r < 16; ++r) { const float ra = wsf[crow(r, hie)], rb2 = wsf[32 + crow(r, hie)];
        const float y0 = oA[0][r] * ra - oB[0][r] * rb2, y1 = oA[1][r] * ra - oB[1][r] * rb2, y2 = oA[2][r] * ra - oB[2][r] * rb2, y3 = oA[3][r] * ra - oB[3][r] * rb2;
        float q = (y0 * y0 + y1 * y1) + (y2 * y2 + y3 * y3);
        q += DPPQ(q, 0xB1); q += DPPQ(q, 0x4E); q += DPPQ(q, 0x141); q += DPPQ(q, 0x140);
        q += __builtin_bit_cast(float, __builtin_amdgcn_ds_swizzle(__builtin_bit_cast(int, q), 0x401F));
        const float rs = __builtin_amdgcn_rsqf(q * (1.0f / 128.0f) + EPS);
        const unsigned ta = tb + (unsigned)crow(r, hie) * 256u + (unsigned)r32e * 2u;
        *(LAS bf16_t*)(uintptr_t)ta = (bf16_t)f2bf(y0 * rs * g0); *(LAS bf16_t*)(uintptr_t)(ta + 64u) = (bf16_t)f2bf(y1 * rs * g1);
        *(LAS bf16_t*)(uintptr_t)(ta + 128u) = (bf16_t)f2bf(y2 * rs * g2); *(LAS bf16_t*)(uintptr_t)(ta + 192u) = (bf16_t)f2bf(y3 * rs * g3); }
#undef DPPQ
    asm volatile("s_waitcnt lgkmcnt(0)" ::: "memory");
    {   bf16_t* Ob = P_A2(p) + ((size_t)qb * 256 + (size_t)wide * 32) * 2048 + 1024 + h * 128;
        const int lanee = tide & 63;
#pragma unroll
        for (int i = 0; i < 8; ++i) { const int c = lanee + 64 * i, row = c >> 4, cc = c & 15;
            const u32x4 w_ = *(const LAS u32x4*)(uintptr_t)(tb + (unsigned)c * 16u);
            *(u32x4*)(Ob + (size_t)row * 2048 + cc * 8) = w_; } }
    __syncthreads();
}
#undef KSWZ
}

namespace gm {
using att::bf16x8; using att::s16x4;
template <int D0> __device__ __forceinline__ void mm_half(f32x16& o, int vb, const bf16x8* pa) {
    const s16x4 l0 = att::tr_read<att::v_rd_off(D0, 0, 0)>(vb), h0 = att::tr_read<att::v_rd_off(D0, 0, 1)>(vb), l1 = att::tr_read<att::v_rd_off(D0, 1, 0)>(vb), h1 = att::tr_read<att::v_rd_off(D0, 1, 1)>(vb);
    const s16x4 l2 = att::tr_read<att::v_rd_off(D0, 2, 0)>(vb), h2 = att::tr_read<att::v_rd_off(D0, 2, 1)>(vb), l3 = att::tr_read<att::v_rd_off(D0, 3, 0)>(vb), h3 = att::tr_read<att::v_rd_off(D0, 3, 1)>(vb);
    asm volatile("s_waitcnt lgkmcnt(0)" ::: "memory"); __builtin_amdgcn_sched_barrier(0);
#define PKV(L, H) (bf16x8){L[0], L[1], L[2], L[3], H[0], H[1], H[2], H[3]}
    o = __builtin_amdgcn_mfma_f32_32x32x16_bf16(pa[0], PKV(l0, h0), o, 0, 0, 0);
    o = __builtin_amdgcn_mfma_f32_32x32x16_bf16(pa[1], PKV(l1, h1), o, 0, 0, 0);
    o = __builtin_amdgcn_mfma_f32_32x32x16_bf16(pa[2], PKV(l2, h2), o, 0, 0, 0);
    o = __builtin_amdgcn_mfma_f32_32x32x16_bf16(pa[3], PKV(l3, h3), o, 0, 0, 0);
#undef PKV
}
__device__ __forceinline__ void gmlp_unit(const Params& p, int n, int g, char* lds) {
    int tid = threadIdx.x; asm volatile("" : "+v"(tid));
    const int wid = tid >> 6, lane = tid & 63, r32 = lane & 31, hi = lane >> 5;
    {
        const int q = tid >> 2, cq = tid & 3;
        const bf16_t* src = P_VG(p) + ((size_t)n * 128 + q) * 1024 + g * 128 + cq * 32;
        float xv[32];
#pragma unroll
        for (int i = 0; i < 4; ++i) { const u32x4 w = *(const u32x4*)(src + i * 8); const unsigned ws_[4] = {w.x, w.y, w.z, w.w};
#pragma unroll
            for (int k = 0; k < 4; ++k) { xv[i * 8 + 2 * k] = __uint_as_float(ws_[k] << 16); xv[i * 8 + 2 * k + 1] = __uint_as_float(ws_[k] & 0xffff0000u); } }
        float sm = 0.f;
#pragma unroll
        for (int i = 0; i < 32; ++i) sm += xv[i];
        sm += __shfl_xor(sm, 1); sm += __shfl_xor(sm, 2);
        const float mu = sm * (1.0f / 128.0f); float var = 0.f;
#pragma unroll
        for (int i = 0; i < 32; ++i) { xv[i] -= mu; var += xv[i] * xv[i]; }
        var += __shfl_xor(var, 1); var += __shfl_xor(var, 2);
        const float rs = 1.0f / sqrtf(var * (1.0f / 128.0f) + EPS);
        const float* lg = p.gmlp_ln_g + g * 128 + cq * 32;
        char* img = lds + (q >> 6) * 16384;
#pragma unroll
        for (int i = 0; i < 4; ++i) { u32x4 o;
            o.x = pk2(xv[i * 8 + 0] * rs * lg[i * 8 + 0], xv[i * 8 + 1] * rs * lg[i * 8 + 1]); o.y = pk2(xv[i * 8 + 2] * rs * lg[i * 8 + 2], xv[i * 8 + 3] * rs * lg[i * 8 + 3]);
            o.z = pk2(xv[i * 8 + 4] * rs * lg[i * 8 + 4], xv[i * 8 + 5] * rs * lg[i * 8 + 5]); o.w = pk2(xv[i * 8 + 6] * rs * lg[i * 8 + 6], xv[i * 8 + 7] * rs * lg[i * 8 + 7]);
            *(u32x4*)(img + v_img_off(q & 63, cq * 32 + i * 8)) = o; }
    }
    __syncthreads();
    const int pb = wid >> 1, d0b = (wid & 1) * 2;
    bf16x8 pa[8];
    const bf16_t* wsg = (const bf16_t*)(p.ws + WS_GWS) + ((size_t)g * 128 + pb * 32 + r32) * 128 + hi * 8;
#pragma unroll
    for (int ks = 0; ks < 8; ++ks) pa[ks] = *reinterpret_cast<const bf16x8*>(wsg + ks * 16);
    f32x16 o0 = f32x16{}, o1 = f32x16{};
    const int vb = (int)(uintptr_t)lds + att::v_rd_base(lane) + d0b * 512;
    mm_half<0>(o0, vb, pa); mm_half<1>(o1, vb, pa);
    mm_half<0>(o0, vb + 16384, pa + 4); mm_half<1>(o1, vb + 16384, pa + 4);
#pragma unroll
    for (int r = 0; r < 16; ++r) { const int prow = pb * 32 + att::crow(r, hi); const float bsv = p.gmlp_bs[g * 128 + prow];
        const size_t row = (size_t)n * 128 + prow; const int col = g * 128 + d0b * 32 + r32;
        const float u0 = bf2f(P_UG(p)[row * 1024 + col]), u1 = bf2f(P_UG(p)[row * 1024 + col + 32]);
        P_A2(p)[row * 2048 + col] = (bf16_t)f2bf(u0 * (o0[r] + bsv)); P_A2(p)[row * 2048 + col + 32] = (bf16_t)f2bf(u1 * (o1[r] + bsv)); }
    __syncthreads();
}
}

namespace peer {
typedef __bf16 bf16x2_t __attribute__((ext_vector_type(2)));
__device__ __forceinline__ float fmax_s(float a, float b) { float r; asm("v_max_f32 %0, %1, %2" : "=v"(r) : "v"(a), "v"(b)); return r; }
__device__ __forceinline__ float fmin_s(float a, float b) { float r; asm("v_min_f32 %0, %1, %2" : "=v"(r) : "v"(a), "v"(b)); return r; }
__device__ __forceinline__ void ce_desc(float& a, float& b) { const float mx = fmax_s(a, b), mn = fmin_s(a, b); a = mx; b = mn; }
__device__ __forceinline__ void ce_asc(float& a, float& b) { const float mx = fmax_s(a, b), mn = fmin_s(a, b); a = mn; b = mx; }
__device__ __forceinline__ void sort16_desc(float* v) {
#pragma unroll
    for (int k = 2; k <= 16; k <<= 1)
#pragma unroll
        for (int j = k >> 1; j > 0; j >>= 1)
#pragma unroll
            for (int i = 0; i < 16; ++i) { const int l = i ^ j; if (l > i) { if ((i & k) == 0) ce_desc(v[i], v[l]); else ce_asc(v[i], v[l]); } }
}
__device__ __forceinline__ void merge_top16(float* a, const float* b) {
#pragma unroll
    for (int i = 0; i < 16; ++i) a[i] = fmax_s(a[i], b[15 - i]);
#pragma unroll
    for (int j = 8; j > 0; j >>= 1)
#pragma unroll
        for (int i = 0; i < 16; ++i) { const int l = i ^ j; if (l > i) ce_desc(a[i], a[l]); }
}
__device__ __forceinline__ void top16_of_64(float* v) {
    sort16_desc(v); sort16_desc(v + 16); sort16_desc(v + 32); sort16_desc(v + 48);
    merge_top16(v, v + 16); merge_top16(v + 32, v + 48); merge_top16(v, v + 32);
}
__device__ __forceinline__ float dot2(unsigned a, unsigned b, float acc) { return __builtin_amdgcn_fdot2_f32_bf16(__builtin_bit_cast(bf16x2_t, a), __builtin_bit_cast(bf16x2_t, b), acc, false); }
__device__ __forceinline__ float wave_sum_dpp(float v) {
    v += __builtin_bit_cast(float, __builtin_amdgcn_update_dpp(0, __builtin_bit_cast(int, v), 0xB1, 0xF, 0xF, true));
    v += __builtin_bit_cast(float, __builtin_amdgcn_update_dpp(0, __builtin_bit_cast(int, v), 0x4E, 0xF, 0xF, true));
    v += __builtin_bit_cast(float, __builtin_amdgcn_update_dpp(0, __builtin_bit_cast(int, v), 0x141, 0xF, 0xF, true));
    v += __builtin_bit_cast(float, __builtin_amdgcn_update_dpp(0, __builtin_bit_cast(int, v), 0x140, 0xF, 0xF, true));
    const int vi = __builtin_bit_cast(int, v);
    const float a = __builtin_bit_cast(float, __builtin_amdgcn_readlane(vi, 0)), b = __builtin_bit_cast(float, __builtin_amdgcn_readlane(vi, 16));
    const float c = __builtin_bit_cast(float, __builtin_amdgcn_readlane(vi, 32)), d = __builtin_bit_cast(float, __builtin_amdgcn_readlane(vi, 48));
    return (a + b) + (c + d);
}
__device__ __forceinline__ float gelu_as(float v) {
    const float av = fabsf(v), t = __builtin_amdgcn_rcpf(av * 0.2316418882f + 1.0f);
    float q = t * 0.5307027145f + (-0.7265760135f); q = q * t + 0.7107068705f; q = q * t + (-0.142248368f); q = q * t + 0.127414796f; q = q * t;
    const float e = __builtin_amdgcn_exp2f((v * v) * (-0.72134752044f));
    const float m = v * (q * e);
    return v < 0.f ? m : v - m;
}
constexpr int PEER_TOK = 32;
__device__ __forceinline__ void peer_unit(const Params& p, int u, char* lds) {
    int tid = threadIdx.x; asm volatile("" : "+v"(tid));
    const int wid = tid >> 6, lane = tid & 63, r32 = lane & 31, hi = lane >> 5;
    constexpr int KS = 136;
    int* IDXl = (int*)lds; float* GATEl = (float*)(lds + 32 * KS * 4); int* SCR = (int*)(lds + 2 * 32 * KS * 4) + wid * 1024;
    const int t0 = u * PEER_TOK;
    {
        const int h = wid;
        float sab[2][16];
#pragma unroll
        for (int c = 0; c < 2; ++c) {
            f32x16 acc[4];
#pragma unroll
            for (int nb = 0; nb < 4; ++nb) acc[nb] = f32x16{};
            const bf16_t* qrow = P_QP(p) + (size_t)(t0 + r32) * 2048 + h * 256 + c * 128 + hi * 8;
            const bf16_t* krow = (const bf16_t*)(p.ws + WS_KEYS) + ((size_t)(h * 2 + c) * 128 + r32) * 128 + hi * 8;
#pragma unroll
            for (int ks = 0; ks < 8; ++ks) {
                const bf16x8 bq = *reinterpret_cast<const bf16x8*>(qrow + ks * 16);
#pragma unroll
                for (int nb = 0; nb < 4; ++nb) { const bf16x8 ak = *reinterpret_cast<const bf16x8*>(krow + nb * 32 * 128 + ks * 16);
                    acc[nb] = __builtin_amdgcn_mfma_f32_32x32x16_bf16(ak, bq, acc[nb], 0, 0, 0); }
            }
            float v[64];
#pragma unroll
            for (int nb = 0; nb < 4; ++nb)
#pragma unroll
                for (int r = 0; r < 16; ++r) { const unsigned cn = (unsigned)(32 * nb + (r & 3) + 8 * (r >> 2));
                    v[nb * 16 + r] = __uint_as_float((__float_as_uint(acc[nb][r]) & ~0x7Fu) | cn | ((unsigned)hi << 2)); }
            top16_of_64(v);
            float o[16];
#pragma unroll
            for (int i = 0; i < 16; ++i) o[i] = __shfl_xor(v[i], 32);
            merge_top16(v, o);
#pragma unroll
            for (int i = 0; i < 16; ++i) sab[c][i] = v[i];
        }
        if (hi == 0) {
#pragma unroll
            for (int i = 0; i < 16; ++i) { SCR[r32 * 32 + i] = (int)(__float_as_uint(sab[0][i]) & 0x7Fu); SCR[r32 * 32 + 16 + i] = (int)(__float_as_uint(sab[1][i]) & 0x7Fu); }
        }
        float cnd[64];
        {   int n = 0;
#pragma unroll
            for (int i = 0; i < 16; ++i)
#pragma unroll
                for (int j = 0; j < 16; ++j) if ((i + 1) * (j + 1) <= 16) { cnd[n] = __uint_as_float((__float_as_uint(sab[0][i] + sab[1][j]) & ~0xFFu) | (unsigned)(i * 16 + j)); ++n; }
#pragma unroll
            for (int k = 50; k < 64; ++k) cnd[k] = -INFINITY;
        }
        top16_of_64(cnd);
        float ex[16]; float sum = 0.f;
#pragma unroll
        for (int k = 0; k < 16; ++k) { ex[k] = __builtin_amdgcn_exp2f((cnd[k] - cnd[0]) * LOG2E); sum += ex[k]; }
        const float rsum = 1.0f / sum;
        asm volatile("s_waitcnt lgkmcnt(0)" ::: "memory");
        if (hi == 0) {
#pragma unroll
            for (int k = 0; k < 16; ++k) { const unsigned pos = __float_as_uint(cnd[k]) & 0xFFu;
                const int ia = SCR[r32 * 32 + (pos >> 4)], ib = SCR[r32 * 32 + 16 + (pos & 15)];
                IDXl[r32 * KS + h * 16 + k] = ia * 128 + ib; GATEl[r32 * KS + h * 16 + k] = ex[k] * rsum; }
            IDXl[r32 * KS + 128 + h] = 0; GATEl[r32 * KS + 128 + h] = 0.f;
        }
    }
    __syncthreads();
    const unsigned tabb = (unsigned)(uintptr_t)(lds + 2 * 32 * KS * 4);
    {   const int tc = tid >> 6, tlx = tid & 63;
        *(LAS f32x4*)(uintptr_t)(tabb + (unsigned)tid * 16u) = *(const f32x4*)(P_G2V(p) + tlx * 32 + tc * 4);
        *(LAS f32x4*)(uintptr_t)(tabb + 8192u + (unsigned)tid * 16u) = *(const f32x4*)(P_S2V(p) + tlx * 32 + tc * 4) * H6_SCALE;
        *(LAS f32x4*)(uintptr_t)(tabb + 16384u + (unsigned)tid * 16u) = *(const f32x4*)(P_MODS(p) + 5 * 2048 + (tc >> 2) * 1024 + tlx * 16 + (tc & 3) * 4) * (1.0f / V6_SCALE);
    }
    {
#pragma unroll 1
        for (int tt = 0; tt < 4; ++tt) {
            const int tl = wid * 4 + tt;
            unsigned a0 = ((unsigned)IDXl[tl * KS + lane] << 7) | (unsigned)lane, a1 = ((unsigned)IDXl[tl * KS + 64 + lane] << 7) | (unsigned)(64 + lane);
#pragma unroll
            for (int k = 2; k <= 128; k <<= 1)
#pragma unroll
                for (int j = k >> 1; j > 0; j >>= 1) {
                    if (j == 64) { const unsigned mn = a0 < a1 ? a0 : a1, mx = a0 < a1 ? a1 : a0; a0 = mn; a1 = mx; }
                    else {
                        const unsigned o0 = (unsigned)__shfl_xor((int)a0, j), o1 = (unsigned)__shfl_xor((int)a1, j);
                        const bool lower = (lane & j) == 0;
                        const bool up0 = ((lane & k) == 0), up1 = (((64 + lane) & k) == 0);
                        const unsigned mn0 = a0 < o0 ? a0 : o0, mx0 = a0 < o0 ? o0 : a0, mn1 = a1 < o1 ? a1 : o1, mx1 = a1 < o1 ? o1 : a1;
                        a0 = (up0 == lower) ? mn0 : mx0; a1 = (up1 == lower) ? mn1 : mx1;
                    }
                }
            const float g0 = GATEl[tl * KS + (a0 & 127u)], g1 = GATEl[tl * KS + (a1 & 127u)];
            asm volatile("s_waitcnt lgkmcnt(0)" ::: "memory");
            IDXl[tl * KS + lane] = (int)(a0 >> 7); IDXl[tl * KS + 64 + lane] = (int)(a1 >> 7);
            GATEl[tl * KS + lane] = g0; GATEl[tl * KS + 64 + lane] = g1;
        }
        asm volatile("s_waitcnt lgkmcnt(0)" ::: "memory");
    }
    __syncthreads();
    {
        typedef float f32x2 __attribute__((ext_vector_type(2)));
        const unsigned char* UT = p.ws + WS_UT;
        float nps;
        const unsigned xrb = tabb + 40960u + (unsigned)__builtin_amdgcn_readfirstlane(wid) * 4096u;
#define LOADTOK(tl_) do { const size_t tq_ = (size_t)t0 + (tl_); nps = (lane < 32) ? P_RSS(p)[tq_ * 32 + lane] : 0.f; const unsigned char* hp_ = (const unsigned char*)(P_XN(p) + tq_ * 2048) + lane * 16; \
            att::glds16(hp_, xrb); att::glds16(hp_ + 1024, xrb + 1024u); att::glds16(hp_ + 2048, xrb + 2048u); att::glds16(hp_ + 3072, xrb + 3072u); } while (0)
        LOADTOK(wid * 4);
        for (int tt = 0; tt < 4; ++tt) {
            const int tl = wid * 4 + tt; const size_t t = (size_t)t0 + tl;
            int lane_t = lane; asm volatile("" : "+v"(lane_t));
            const unsigned h2b = tabb + 24576u + (unsigned)__builtin_amdgcn_readfirstlane(wid) * 2048u;
            {
                const float rstd = 1.0f / sqrtf(wave_sum_dpp(nps) * (1.0f / 2048.0f) + EPS) * H6_SCALE;
                asm volatile("s_waitcnt vmcnt(0)" ::: "memory");
                f32x16 lo_, hi_;
#pragma unroll
                for (int c = 0; c < 4; ++c) { const u32x4 w_ = *(const LAS u32x4*)(uintptr_t)(xrb + (unsigned)lane_t * 64u + (unsigned)c * 16u); const unsigned ws_[4] = {w_.x, w_.y, w_.z, w_.w};
#pragma unroll
                    for (int q = 0; q < 2; ++q) { const int e0 = 8 * c + 4 * q; const unsigned ta_ = tabb + (unsigned)((2 * c + q) * 64 + lane_t) * 16u;
                        const f32x4 gg = *(const LAS f32x4*)(uintptr_t)ta_, s4 = *(const LAS f32x4*)(uintptr_t)(ta_ + 8192u);
                        const float v0 = __uint_as_float(ws_[2 * q] << 16) * rstd * gg[0] + s4[0], v1 = __uint_as_float(ws_[2 * q] & 0xffff0000u) * rstd * gg[1] + s4[1];
                        const float v2 = __uint_as_float(ws_[2 * q + 1] << 16) * rstd * gg[2] + s4[2], v3 = __uint_as_float(ws_[2 * q + 1] & 0xffff0000u) * rstd * gg[3] + s4[3];
                        if (c < 2) { lo_[e0] = v0; lo_[e0 + 1] = v1; lo_[e0 + 2] = v2; lo_[e0 + 3] = v3; } else { hi_[e0 - 16] = v0; hi_[e0 - 15] = v1; hi_[e0 - 14] = v2; hi_[e0 - 13] = v3; } } }
                const u32x6 pk = __builtin_amdgcn_cvt_scalef32_2xpk16_fp6_f32(lo_, hi_, 1.0f);
                const unsigned ha_ = h2b + (unsigned)lane_t * 32u;
                *(LAS u32x4*)(uintptr_t)ha_ = (u32x4){pk[0], pk[1], pk[2], pk[3]}; *(LAS u32x2*)(uintptr_t)(ha_ + 16u) = (u32x2){pk[4], pk[5]};
                asm volatile("s_waitcnt lgkmcnt(0)" ::: "memory");
            }
            if (tt < 3) LOADTOK(tl + 1);
            f32x2 acc[16];
#pragma unroll
            for (int i = 0; i < 16; ++i) acc[i] = (f32x2){0.f, 0.f};
            const int l16 = lane & 15;
#if FP6_INTERLEAVED
#define FK(k_) ((((k_) & 15) << 1) | ((k_) >> 4))
#else
#define FK(k_) (k_)
#endif
#define DEC6(P_) __builtin_amdgcn_cvt_scalef32_pk32_f16_fp6(P_, 1.0f)
#define SBAR() __builtin_amdgcn_sched_barrier(0)
            constexpr int NBV = 2;
            const unsigned vl16 = (unsigned)lane * 16u, vl8 = 1024u + (unsigned)lane * 8u;
            u32x4 Aq[NBV], Bq[NBV]; u32x2 Ar[NBV], Br[NBV];
#define LOADV(S_, iv_, base_) do { _Pragma("unroll") for (int i_ = 0; i_ < NBV; ++i_) { \
                const int e_ = __builtin_amdgcn_readlane(iv_, (base_) + i_); const unsigned char* r_ = UT + (size_t)e_ * 3072 + 1536;        \
                S_##q[i_] = *(const u32x4*)(r_ + vl16); S_##r[i_] = *(const u32x2*)(r_ + vl8); } } while (0)
#define COMPV(S_, base_) do { _Pragma("unroll") for (int i_ = 0; i_ < NBV; ++i_) { \
                const _Float16 wh_ = (_Float16)__builtin_bit_cast(float, __builtin_amdgcn_readlane(__builtin_bit_cast(int, wv), (base_) + i_)); const h16x2 w2_ = {wh_, wh_}; \
                const h16x32 dv_ = DEC6(((u32x6){S_##q[i_].x, S_##q[i_].y, S_##q[i_].z, S_##q[i_].w, S_##r[i_].x, S_##r[i_].y})); \
                _Pragma("unroll") for (int m_ = 0; m_ < 16; ++m_) acch[m_] = (h16x2){dv_[2 * m_], dv_[2 * m_ + 1]} * w2_ + acch[m_]; __builtin_amdgcn_sched_barrier(0); } } while (0)
            int idxv = IDXl[tl * KS + l16];
            LOADV(A, idxv, 0);
            u32x4 L0[3], L1[3];
            const unsigned char* ub = UT + (size_t)idxv * 3072 + (unsigned)(lane >> 4) * 16u;
#define LDU(L_, ub_, t8_) do { L_[0] = *(const u32x4*)((ub_) + (t8_) * 192); L_[1] = *(const u32x4*)((ub_) + (t8_) * 192 + 64); L_[2] = *(const u32x4*)((ub_) + (t8_) * 192 + 128); } while (0)
#define MMU(L_, t8_) do { const u32x4 a0_ = *(const LAS u32x4*)(uintptr_t)(hq + (unsigned)(2 * (t8_)) * 128u); const u32x2 a1_ = *(const LAS u32x2*)(uintptr_t)(hq + (unsigned)(2 * (t8_)) * 128u + 16u); \
                        const u32x4 c0_ = *(const LAS u32x4*)(uintptr_t)(hq + (unsigned)(2 * (t8_) + 1) * 128u); const u32x2 c1_ = *(const LAS u32x2*)(uintptr_t)(hq + (unsigned)(2 * (t8_) + 1) * 128u + 16u); \
                        const att::i32x8 A0_ = {(int)a0_.x, (int)a0_.y, (int)a0_.z, (int)a0_.w, (int)a1_.x, (int)a1_.y, 0, 0}, A1_ = {(int)c0_.x, (int)c0_.y, (int)c0_.z, (int)c0_.w, (int)c1_.x, (int)c1_.y, 0, 0}; \
                        const att::i32x8 B0_ = {(int)L_[0].x, (int)L_[0].y, (int)L_[0].z, (int)L_[0].w, (int)L_[1].x, (int)L_[1].y, 0, 0}, B1_ = {(int)L_[1].z, (int)L_[1].w, (int)L_[2].x, (int)L_[2].y, (int)L_[2].z, (int)L_[2].w, 0, 0}; \
                        dacc = __builtin_amdgcn_mfma_scale_f32_16x16x128_f8f6f4(A0_, B0_, dacc, 2, 2, 0, 0, 0, 0); dacc = __builtin_amdgcn_mfma_scale_f32_16x16x128_f8f6f4(A1_, B1_, dacc, 2, 2, 0, 0, 0, 0); } while (0)
            LDU(L0, ub, 0); LDU(L1, ub, 1);
            const unsigned hq = h2b + (unsigned)(lane >> 4) * 32u;
#pragma unroll 1
            for (int bt = 0; bt < 8; ++bt) {
                const float gatev = GATEl[tl * KS + bt * 16 + l16];
                const int idxn = IDXl[tl * KS + ((bt + 1) & 7) * 16 + l16];
                f32x4 dacc = {0.f, 0.f, 0.f, 0.f};
                {
                    MMU(L0, 0); LDU(L0, ub, 2); MMU(L1, 1); LDU(L1, ub, 3); MMU(L0, 2); LDU(L0, ub, 4); MMU(L1, 3); LDU(L1, ub, 5);
                    MMU(L0, 4); LDU(L0, ub, 6); MMU(L1, 5); LDU(L1, ub, 7); MMU(L0, 6); MMU(L1, 7);
                }
                const float wv = gatev * gelu_as(dacc[0] * (1.0f / (U6_SCALE * H6_SCALE)));
                h16x2 acch[16];
#pragma unroll
                for (int m = 0; m < 16; ++m) acch[m] = (h16x2){(_Float16)0.f, (_Float16)0.f};
                SBAR();
                LOADV(B, idxv, 2); SBAR(); COMPV(A, 0); SBAR();
                LOADV(A, idxv, 4); SBAR(); COMPV(B, 2); SBAR();
                LOADV(B, idxv, 6); SBAR(); COMPV(A, 4); SBAR();
                LOADV(A, idxv, 8); SBAR(); COMPV(B, 6); SBAR();
                LOADV(B, idxv, 10); SBAR(); COMPV(A, 8); SBAR();
                LOADV(A, idxv, 12); SBAR(); COMPV(B, 10); SBAR();
                LOADV(B, idxv, 14); SBAR(); COMPV(A, 12); SBAR();
                if (bt < 7) LOADV(A, idxn, 0);
                ub = UT + (size_t)idxn * 3072 + (unsigned)(lane >> 4) * 16u;
                if (bt < 7) { LDU(L0, ub, 0); LDU(L1, ub, 1); }
                SBAR(); COMPV(B, 14); SBAR();
#pragma unroll
                for (int m = 0; m < 16; ++m) { acc[m].x += (float)acch[m].x; acc[m].y += (float)acch[m].y; }
                idxv = idxn;
            }
#undef FK
#undef DEC6
#undef SBAR
#undef LOADV
#undef COMPV
#undef LDU
#undef MMU
            int lane_e = lane, tl_e = tl; asm volatile("" : "+v"(lane_e), "+v"(tl_e));
            const size_t t_e = (size_t)t0 + tl_e;
            float* orow = p.out + t_e * 2048;
            u32x4 ex[4];
            {   const bf16_t* xr_ = P_XN(p) + t_e * 2048 + lane_e * 16; ex[0] = *(const u32x4*)xr_; ex[1] = *(const u32x4*)(xr_ + 8); ex[2] = *(const u32x4*)(xr_ + 1024); ex[3] = *(const u32x4*)(xr_ + 1032); }
#pragma unroll
            for (int j = 0; j < 2; ++j) { const int ob = j * 1024 + lane_e * 16;
                const unsigned xw[8] = {ex[2 * j].x, ex[2 * j].y, ex[2 * j].z, ex[2 * j].w, ex[2 * j + 1].x, ex[2 * j + 1].y, ex[2 * j + 1].z, ex[2 * j + 1].w};
#pragma unroll
                for (int q = 0; q < 4; ++q) { const int o = ob + q * 4;
                    const f32x4 x0 = {__uint_as_float(xw[2 * q] << 16), __uint_as_float(xw[2 * q] & 0xffff0000u), __uint_as_float(xw[2 * q + 1] << 16), __uint_as_float(xw[2 * q + 1] & 0xffff0000u)};
                    const f32x4 ga = *(const LAS f32x4*)(uintptr_t)(tabb + 16384u + (unsigned)((j * 4 + q) * 64 + lane_e) * 16u);
                    const f32x4 r_ = x0 + ga * (j == 0 ? (f32x4){acc[4 * q].x, acc[4 * q + 1].x, acc[4 * q + 2].x, acc[4 * q + 3].x} : (f32x4){acc[4 * q].y, acc[4 * q + 1].y, acc[4 * q + 2].y, acc[4 * q + 3].y});
                    *(f32x4*)(orow + o) = r_; } }
        }
    }
    __syncthreads();
}
}

#define XB_TMO      128
#define XB_XCNT(j)  (256  + 64 * (j))
#define XB_XSUB(j)  (1280 + 64 * (j))
#define XB_XGEN(j)  (2304 + 64 * (j))
#define XB_TOP      3328
#define XB_TOPGEN   3392
#define XCD_BAR_WORDS 3456
#define XB_SPIN_CAP (1u << 18)

__device__ __forceinline__ unsigned xb_ld(unsigned* p)              { return __hip_atomic_load(p, __ATOMIC_RELAXED, __HIP_MEMORY_SCOPE_AGENT); }
__device__ __forceinline__ unsigned xb_add(unsigned* p, unsigned v) { return __hip_atomic_fetch_add(p, v, __ATOMIC_RELAXED, __HIP_MEMORY_SCOPE_AGENT); }
__device__ __forceinline__ unsigned xb_xcc_id() { return (unsigned)__builtin_amdgcn_s_getreg((3 << 11) | 20) & 0xFu; }
#define XB_SPIN(cond, bar) do { unsigned _sp = 0; while (cond) { __builtin_amdgcn_s_sleep(1); \
    if ((++_sp & 255u) == 0u) { if (xb_ld(&(bar)[XB_TMO])) break; if (_sp > XB_SPIN_CAP) { atomicAdd(&(bar)[XB_TMO], 1u); break; } } } } while (0)

struct XcdBarrier {
    unsigned* bar; unsigned x;
    volatile LAS unsigned* st;
};

__device__ __forceinline__ XcdBarrier xcd_barrier_post(unsigned* bar, volatile LAS unsigned* st) {
    XcdBarrier b; b.bar = bar; b.x = xb_xcc_id(); b.st = st;
    if (threadIdx.x == 0) (void)xb_add(&bar[XB_XCNT(b.x)], 1u);
    return b;
}
__device__ __forceinline__ void xcd_barrier_complete(unsigned* bar, unsigned x, unsigned& nloc, unsigned& nx) {
    const unsigned G = gridDim.x * gridDim.y * gridDim.z;
    unsigned sum, cnt, mine, sp = 0u;
    for (;;) {
        sum = 0u; cnt = 0u; mine = 0u;
#pragma unroll
        for (unsigned j = 0; j < 16; ++j) { const unsigned c = xb_ld(&bar[XB_XCNT(j)]); sum += c; cnt += (c > 0u) ? 1u : 0u; mine = (j == x) ? c : mine; }
        if (sum == G) break;
        __builtin_amdgcn_s_sleep(1);
        if ((++sp & 255u) == 0u) { if (xb_ld(&bar[XB_TMO])) break; if (sp > XB_SPIN_CAP) { atomicAdd(&bar[XB_TMO], 1u); break; } }
    }
    nloc = mine > 0u ? mine : 1u; nx = cnt > 0u ? cnt : 1u;
}

__device__ __forceinline__ void xcd_barrier(const XcdBarrier& b) {
    asm volatile("s_waitcnt vmcnt(0)" ::: "memory");
    __syncthreads();
    if (threadIdx.x == 0) {
        unsigned* bar = b.bar;
        __builtin_amdgcn_s_waitcnt(0);
        unsigned nloc = b.st[0], nx = b.st[1];
        if (nloc == 0u) { xcd_barrier_complete(bar, b.x, nloc, nx); b.st[0] = nloc; b.st[1] = nx; }
        const unsigned old = xb_add(&bar[XB_XSUB(b.x)], 1u);
        const unsigned gen = old / nloc;
        if (old + 1u == (gen + 1u) * nloc) {
            __builtin_amdgcn_fence(__ATOMIC_RELEASE, "agent");
            asm volatile("s_waitcnt vmcnt(0)" ::: "memory");
            const unsigned og = xb_add(&bar[XB_TOP], 1u);
            const unsigned tg = og / nx;
            if (og + 1u == (tg + 1u) * nx) xb_add(&bar[XB_TOPGEN], 1u);
            else XB_SPIN(xb_ld(&bar[XB_TOPGEN]) == tg, bar);
            __builtin_amdgcn_fence(__ATOMIC_ACQUIRE, "agent");
            xb_add(&bar[XB_XGEN(b.x)], 1u);
            asm volatile("s_waitcnt vmcnt(0)" ::: "memory");
        } else {
            XB_SPIN(xb_ld(&bar[XB_XGEN(b.x)]) == gen, bar);
            __builtin_amdgcn_fence(__ATOMIC_ACQUIRE, "agent");
            asm volatile("s_waitcnt vmcnt(0)" ::: "memory");
        }
    }
    __syncthreads();
}

namespace cg = cooperative_groups;
constexpr int MK_LDS = 163840;
enum { PH_PREP = 0, PH_HNORM, PH_GEMM1, PH_POST, PH_ATTN, PH_OUTP, PH_H2, PH_QP, PH_PEER, PH_N };
struct MkArgs { Params p; int ph_lo, ph_hi; };
__global__ __launch_bounds__(512, 2) void mk_fwd(MkArgs a) {
    extern __shared__ __attribute__((aligned(16))) unsigned char lds[];
    const Params& p = a.p;
    const int lo = a.ph_lo, hi = a.ph_hi;
    const int tid = threadIdx.x, lane = tid & 63, wave = __builtin_amdgcn_readfirstlane(tid >> 6);
    const int G = gridDim.x, bx = blockIdx.x;
    cg::grid_group grid = cg::this_grid();
    volatile LAS unsigned* xst = (volatile LAS unsigned*)((LAS unsigned char*)lds + MK_LDS - 64);
    if (tid < 16) xst[tid] = 0u;
    __syncthreads();
    const XcdBarrier xbar = xcd_barrier_post((unsigned*)(p.ws + WS_CTL) + 4096, xst);
#define IN(k) (lo <= (k) && (k) < hi)
#define SEAM(k) do { if (IN(k) && IN((k) + 1)) xcd_barrier(xbar); } while (0)
    if (lo < 0) grid.sync();
    if (IN(PH_PREP)) {
        float* fl = (float*)lds;
        p0_adaln(p, fl, bx, G);
        __syncthreads();
        const size_t gtid = (size_t)bx * 512 + tid, gthreads = (size_t)G * 512;
        cvt_range(p.peer_keys, (bf16_t*)(p.ws + WS_KEYS), 8 * 2 * 128 * 128 / 8, gtid, gthreads);
        cvt_range(p.gmlp_ws, (bf16_t*)(p.ws + WS_GWS), 8 * 128 * 128 / 8, gtid, gthreads);
        for (size_t i = gtid; i < 320 * 16; i += gthreads) { const int tp = (int)(i >> 4), f = (int)(i & 15);
            const float posf = (float)(tp < 256 ? tp : tp - 256), inv = exp2f(-(float)f * (13.287712379549449f / 16.0f)), ang = posf * inv;
            P_ROPE(p)[2 * i] = cosf(ang); P_ROPE(p)[2 * i + 1] = sinf(ang); }
        float* scr = fl + wave * (64 * 33);
        const int gw = bx * 8 + wave, ngw = G * 8;
        constexpr int I_IN = (2048 / 64) * (5120 / 32), I_SQ = (2048 / 64) * (2048 / 32);
        for (int it = gw; it < I_IN; it += ngw) {
            if ((it % 160) < 64) transpose_item(p.w_in, 2048, 5120, (bf16_t*)(p.ws + WS_WIN_T), scr, it, lane);
            else transpose_item8(p.w_in, 2048, 5120, p.ws + WS_WIN_T + 8 * MiB - (size_t)2048 * 2048, scr, it, lane, W8_SCALE); }
    }
    SEAM(PH_PREP);
    if (IN(PH_HNORM)) {
        const int gw = bx * 8 + wave, ngw = G * 8;
        const float* mods = P_MODS(p); const float* modsc = P_MODSC(p);
        if (bx == 0) for (int i = tid; i < 2048; i += 512) { P_G2V(p)[i] = p.norm2_g[i] * (1.0f + mods[4 * 2048 + i]); P_S2V(p)[i] = mods[3 * 2048 + i]; }
        for (int row = gw; row < LT; row += ngw) {
            if (row < CTX) norm_row_dual(p.ctx + (size_t)row * DM, p.norm1_g, modsc, modsc + 2048, P_HB(p) + (size_t)row * DM, P_HB8(p) + (size_t)row * DM, lane);
            else norm_row_dual(p.x + (size_t)(row - CTX) * DM, p.norm1_g, mods, mods + 2048, P_HB(p) + (size_t)row * DM, P_HB8(p) + (size_t)row * DM, lane);
        }
    }
    SEAM(PH_HNORM);
    if (IN(PH_GEMM1)) {
        {
            pg8::Gemm g{P_HB(p) + (size_t)CTX * DM, (const bf16_t*)(p.ws + WS_WIN_T), SEQ, 2048, DM}; pg8::StaticOrder S; S.init(SEQ, 2048, G, bx);
            pg8::EpiG1m E{P_UG(p), P_VG(p), P_QS8(p), P_KIMG8(p), P_VIMG8(p), p.q_norm_g, p.k_norm_g, P_ROPE(p), (LAS float*)((LAS unsigned char*)lds + 131072), 1, 0, 1.0f};
            pg8::gemm_phase<pg8::EpiG1m, pg8::StaticOrder, true, true, false>((LAS unsigned char*)lds, g, S, E); }
        {
            pg8::Gemm g{(const bf16_t*)P_HB8(p), (const bf16_t*)(p.ws + WS_WIN_T + 8 * MiB), LT, 3072, DM / 2}; pg8::StaticOrder S; S.init(LT, 3072, G, bx);
            pg8::EpiG1m E{P_UG(p), P_VG(p), P_QS8(p), P_KIMG8(p), P_VIMG8(p), p.q_norm_g, p.k_norm_g, P_ROPE(p), (LAS float*)((LAS unsigned char*)lds + 131072), 0, 8, 1.0f / W8_SCALE};
            pg8::gemm_phase<pg8::EpiG1m, pg8::StaticOrder, true, true, true>((LAS unsigned char*)lds, g, S, E); }
        {
            unsigned* qctr = (unsigned*)(p.ws + WS_CTL) + 64;
            float* scr = (float*)lds + wave * (64 * 33);
            for (;;) {
                __syncthreads();
                if (tid == 0) xst[8] = atomicAdd(qctr, 1u);
                __syncthreads();
                const unsigned c = xst[8];
                if (c >= 2592u) break;
                if (c >= 2560u) {
                    const int n0 = (int)(c - 2560u) * 64; const float* w_ = p.peer_wq + n0 + lane; const float* s2 = P_S2V(p); float a_ = 0.f;
#pragma unroll 8
                    for (int k = wave * 256; k < wave * 256 + 256; ++k) a_ += s2[k] * w_[(size_t)k * 2048];
                    float* red = (float*)lds; red[wave * 64 + lane] = a_;
                    __syncthreads();
                    if (wave == 0) { float t_ = 0.f;
#pragma unroll
                        for (int w8 = 0; w8 < 8; ++w8) t_ += red[w8 * 64 + lane];
                        P_BQ(p)[n0 + lane] = t_; }
                    continue; }
                if (c < 2048u) { const bool isv = c >= 1024u; const size_t r0 = (size_t)(c & 1023u) * 16;
                    const float* src = (isv ? p.peer_v : p.peer_u) + r0 * 2048; unsigned char* dst = p.ws + WS_UT + r0 * 3072 + (isv ? 1536 : 0); const float sc = isv ? V6_SCALE : U6_SCALE;
                    for (int i = tid; i < 16 * 64; i += 512) { const int rr = i >> 6, cc = i & 63;
                        const float* s_ = isv ? src + (size_t)rr * 2048 + cc * 16 : src + (size_t)rr * 2048 + cc * 32;
                        const int o2 = isv ? 1024 : 16;
                        f32x16 a_, b_;
#pragma unroll
                        for (int k = 0; k < 4; ++k) { const f32x4 x_ = *(const f32x4*)(s_ + 4 * k) * sc, y_ = *(const f32x4*)(s_ + o2 + 4 * k) * sc;
                            a_[4 * k] = x_[0]; a_[4 * k + 1] = x_[1]; a_[4 * k + 2] = x_[2]; a_[4 * k + 3] = x_[3]; b_[4 * k] = y_[0]; b_[4 * k + 1] = y_[1]; b_[4 * k + 2] = y_[2]; b_[4 * k + 3] = y_[3]; }
                        const u32x6 pk = __builtin_amdgcn_cvt_scalef32_2xpk16_fp6_f32(a_, b_, 1.0f);
                        const int sg = cc >> 2, kq = cc & 3;
                        if (isv) { unsigned char* d_ = dst + (size_t)rr * 3072;
                            *(u32x4*)(d_ + cc * 16) = (u32x4){pk[0], pk[1], pk[2], pk[3]}; *(u32x2*)(d_ + 1024 + cc * 8) = (u32x2){pk[4], pk[5]}; }
                        else { unsigned char* d_ = dst + (size_t)rr * 3072 + (sg >> 1) * 192 + kq * 16;
                            if ((sg & 1) == 0) { *(u32x4*)d_ = (u32x4){pk[0], pk[1], pk[2], pk[3]}; *(u32x2*)(d_ + 64) = (u32x2){pk[4], pk[5]}; }
                            else { *(u32x2*)(d_ + 64 + 8) = (u32x2){pk[0], pk[1]}; *(u32x4*)(d_ + 128) = (u32x4){pk[2], pk[3], pk[4], pk[5]}; } } } }
                else { const int it = (int)(c - 2048u) * 8 + wave; constexpr int I_SQ = (2048 / 64) * (2048 / 32);
                    if (it < I_SQ) transpose_item(p.w_out, 2048, 2048, (bf16_t*)(p.ws + WS_WOUT_T), scr, it, lane);
                    else transpose_item(p.peer_wq, 2048, 2048, (bf16_t*)(p.ws + WS_WQ_T), scr, it - I_SQ, lane, P_G2V(p)); }
            }
        }
    }
    SEAM(PH_GEMM1);
    if (IN(PH_POST)) {
        for (int u = bx; u < 128 * 8; u += G) gm::gmlp_unit(p, u >> 3, u & 7, (char*)lds);
    }
    SEAM(PH_POST);
    if (IN(PH_ATTN)) {
        for (int u = bx; u < NH * (SEQ / 256); u += G) att::attn_unit8(p, u & 7, u >> 3, (char*)lds);
    }
    SEAM(PH_ATTN);
    if (IN(PH_OUTP)) {
        pg8::Gemm g{P_A2(p), (const bf16_t*)(p.ws + WS_WOUT_T), SEQ, DM, DM}; pg8::StaticOrder S; S.init(SEQ, DM, G, bx);
        pg8::EpiOutm E{p.x, P_MODS(p) + 2 * 2048, P_XN(p), P_RSS(p)};
        pg8::gemm_phase<pg8::EpiOutm, pg8::StaticOrder, true, true>((LAS unsigned char*)lds, g, S, E);
    }
    SEAM(PH_OUTP);
    if (IN(PH_QP)) {
        pg8::Gemm g{P_XN(p), (const bf16_t*)(p.ws + WS_WQ_T), SEQ, DM, DM}; pg8::StaticOrder S; S.init(SEQ, DM, G, bx);
        pg8::EpiQp E{P_QP(p), P_RSS(p), P_BQ(p)};
        pg8::gemm_phase<pg8::EpiQp, pg8::StaticOrder, true, true>((LAS unsigned char*)lds, g, S, E);
    }
    SEAM(PH_QP);
    if (IN(PH_PEER)) {
        for (int u = bx; u < SEQ / peer::PEER_TOK; u += G) peer::peer_unit(p, u, (char*)lds);
    }
#undef IN
#undef SEAM
}
static int g_grid = 0;
static void mk_launch(const Params& p, int lo, int hi, hipStream_t stream) {
    (void)hipMemsetAsync(p.ws + WS_CTL, 0, 65536, stream);
    MkArgs a{}; a.p = p; a.ph_lo = lo; a.ph_hi = hi;
    void* args[] = {&a};
    hipError_t e = hipLaunchCooperativeKernel((const void*)mk_fwd, dim3(g_grid), dim3(512), args, MK_LDS, stream);
    if (e != hipSuccess) fprintf(stderr, "mk_launch [%d,%d) failed: %s (grid %d)\n", lo, hi, hipGetErrorString(e), g_grid);
}

extern "C" void kernel_launch(void* const* d_in, const int* in_sizes, int n_in, void* d_out, int out_size, void* d_ws, size_t ws_size, hipStream_t stream) {
    static int init = 0;
    if (!init) {
        if (n_in != 24 || ws_size < WS_END) { fprintf(stderr, "kernel_launch: unexpected n_in %d / ws %zu\n", n_in, ws_size); }
        (void)hipFuncSetAttribute((const void*)mk_fwd, hipFuncAttributeMaxDynamicSharedMemorySize, MK_LDS);
        int dev = 0, cus = 0, per_cu = 0;
        (void)hipGetDevice(&dev); (void)hipDeviceGetAttribute(&cus, hipDeviceAttributeMultiprocessorCount, dev);
        (void)hipOccupancyMaxActiveBlocksPerMultiprocessor(&per_cu, (const void*)mk_fwd, 512, MK_LDS);
        if (per_cu < 1) { fprintf(stderr, "kernel_launch: occupancy query says %d blocks/CU\n", per_cu); per_cu = 1; }
        g_grid = cus * 1;
        init = 1;
    }
    Params p{};
    const float** f = (const float**)&p;
    for (int i = 0; i < 24; ++i) f[i] = (const float*)d_in[i];
    p.out = (float*)d_out; p.ws = (unsigned char*)d_ws;

    mk_launch(p, PH_PREP, PH_N, stream);
}
```

```cpp
#include <hip/hip_runtime.h>
#include <hip/hip_cooperative_groups.h>
#include <cstdint>
#include <cstdio>
#include <cmath>

typedef unsigned short bf16_t;
typedef short bf16x8 __attribute__((ext_vector_type(8)));
typedef float f32x4 __attribute__((ext_vector_type(4)));
typedef float f32x16 __attribute__((ext_vector_type(16)));
typedef unsigned u32x4 __attribute__((ext_vector_type(4)));
typedef unsigned u32x2 __attribute__((ext_vector_type(2)));

constexpr int DM = 2048, SEQ = 16384, CTX = 256, LT = SEQ + CTX;
constexpr int D_A = 1024, D_QK = 1024, D_V = 1024, D_IN = 5120;
constexpr int NH = 8, DQK = 64, DV = 128;
constexpr int NTILE = LT / 64;
constexpr int PEER_H = 8, NKEYS = 128, TOPK = 16;
constexpr float EPS = 1e-6f;
constexpr float LAM_INIT = 0.2f;
constexpr float LOG2E = 1.4426950408889634f;
constexpr float QSCALE = 0.125f * LOG2E;

constexpr size_t MiB = 1u << 20;
constexpr size_t WS_CTL = 0;
constexpr size_t WS_MODS = 1 * MiB;
constexpr size_t WS_WIN_T = 2 * MiB;
constexpr size_t WS_WOUT_T = 22 * MiB;
constexpr size_t WS_WQ_T = 30 * MiB;
constexpr size_t WS_KEYS = 38 * MiB;
constexpr size_t WS_GWS = 38 * MiB + 512 * 1024;
constexpr size_t WS_UT = 39 * MiB;
constexpr size_t WS_VT = 103 * MiB;
constexpr size_t WS_R1 = 167 * MiB;
constexpr size_t WS_R2 = 232 * MiB;
constexpr size_t WS_R3 = 296 * MiB;
constexpr size_t WS_R4 = 394 * MiB;
constexpr size_t WS_R5 = 491 * MiB;
constexpr size_t WS_END = 507 * MiB;

struct Params {
    const float *x, *c, *ctx, *c_ctx, *w_ada, *b_ada, *norm1_g, *norm2_g, *w_in, *gmlp_ln_g, *gmlp_ws, *gmlp_bs, *q_norm_g, *k_norm_g,
        *lq1, *lk1, *lq2, *lk2, *subln_g, *w_out, *peer_wq, *peer_keys, *peer_u, *peer_v;
    float* out;
    unsigned char* ws;
};
#define P_MODS(p) ((float*)((p).ws + WS_MODS))
#define P_MODSC(p) ((float*)((p).ws + WS_MODS) + 12288)
#define P_SCAL(p) ((float*)((p).ws + WS_MODS) + 16384)
#define P_G2V(p) ((float*)((p).ws + WS_MODS + 196608))
#define P_S2V(p) ((float*)((p).ws + WS_MODS + 204800))
#define P_BQ(p) ((float*)((p).ws + WS_MODS + 212992))
#define P_RSS(p) ((float*)((p).ws + WS_R2))
#define P_ROPE(p) ((float*)((p).ws + WS_MODS + 131072))
#define P_HB(p) ((bf16_t*)((p).ws + WS_R1))
#define P_HB8(p) ((unsigned char*)((p).ws + WS_R3))
#define P_A2(p) ((bf16_t*)((p).ws + WS_R1))
#define P_UG(p) ((bf16_t*)((p).ws + WS_R2))
#define P_VG(p) ((bf16_t*)((p).ws + WS_R2 + 32 * MiB))
#define P_XB(p) ((bf16_t*)((p).ws + WS_R2))
#define P_QKV(p) ((bf16_t*)((p).ws + WS_R3))
#define P_QP(p) ((bf16_t*)((p).ws + WS_R3))
#define P_QS(p) ((bf16_t*)((p).ws + WS_R4))
#define P_KIMG(p) ((bf16_t*)((p).ws + WS_R4 + 32 * MiB))
#define P_QS8(p) ((unsigned char*)((p).ws + WS_R4))
#define P_KIMG8(p) ((unsigned char*)((p).ws + WS_R4 + 32 * MiB))
#define P_VIMG8(p) ((unsigned char*)((p).ws + WS_R4 + 32 * MiB + 33 * MiB))
#define P_VIMG(p) ((bf16_t*)((p).ws + WS_R4 + 32 * MiB + 33 * MiB))
#define P_XN(p) ((bf16_t*)((p).ws + WS_R4))
#define P_IDX(p) ((int*)((p).ws + WS_R5))
#define P_GATE(p) ((float*)((p).ws + WS_R5 + 8 * MiB))

__device__ __forceinline__ float bf2f(bf16_t b) { return __uint_as_float((unsigned)b << 16); }
__device__ __forceinline__ unsigned f2bf(float f) { unsigned u = __float_as_uint(f); return (u + 0x7fffu + ((u >> 16) & 1u)) >> 16; }
__device__ __forceinline__ unsigned pk2(float lo, float hi) { return f2bf(lo) | (f2bf(hi) << 16); }
__device__ __forceinline__ float wave_sum(float v) {
#pragma unroll
    for (int o = 1; o < 64; o <<= 1) v += __shfl_xor(v, o);
    return v;
}
__device__ __forceinline__ float gelu_erf(float v) { return 0.5f * v * (1.0f + erff(v * 0.70710678118654752f)); }
__device__ __forceinline__ int k8_off(int key, int colbyte) { const int c_ = colbyte >> 6, d_ = colbyte & 63; return c_ * 4096 + key * 64 + ((((d_ >> 4) ^ ((key >> 2) & 3)) << 4) | (d_ & 15)); }
__device__ __forceinline__ int v8_off(int k, int c) { const int p_ = (((k >> 2) & 1) << 5) | ((k >> 5) << 4) | (((k >> 3) & 3) << 2) | (k & 3); return c * 64 + ((((p_ >> 4) ^ ((c >> 2) & 3)) << 4) | (p_ & 15)); }
__device__ __forceinline__ int k_img_off(int key, int colbyte) { return key * 256 + (colbyte ^ ((key & 15) << 4)); }
__device__ __forceinline__ int v_img_off(int k, int c) { const int kk = (k & ~0xC) | ((k & 4) << 1) | ((k & 8) >> 1); return ((kk >> 3) * 4 + (c >> 5)) * 512 + ((kk & 7) * 32 + (c & 31)) * 2; }

__device__ __forceinline__ void p0_adaln(const Params& p, float* lds, int b, int nb) {
    const int tid = threadIdx.x, lane = tid & 63, wave = tid >> 6;
    float* sc = lds; float* scc = lds + 2048; float* red = lds + 4096;
    for (int k = tid; k < 2048; k += 512) { float v = p.c[k]; sc[k] = v / (1.0f + expf(-v)); v = p.c_ctx[k]; scc[k] = v / (1.0f + expf(-v)); }
    __syncthreads();
    float* mods = P_MODS(p); float* modsc = P_MODSC(p);
    for (int item = b; item < 192; item += nb) {
        const int col = item * 64 + lane;
        const float* w = p.w_ada + col;
        float a0 = 0.f, a1 = 0.f;
        const int k0 = wave * 256;
#pragma unroll 8
        for (int k = 0; k < 256; ++k) { const float wv = w[(size_t)(k0 + k) * 12288]; a0 += sc[k0 + k] * wv; a1 += scc[k0 + k] * wv; }
        red[(wave * 2 + 0) * 64 + lane] = a0; red[(wave * 2 + 1) * 64 + lane] = a1;
        __syncthreads();
        if (wave == 0) {
            float s0 = 0.f, s1 = 0.f;
#pragma unroll
            for (int w8 = 0; w8 < 8; ++w8) { s0 += red[(w8 * 2 + 0) * 64 + lane]; s1 += red[(w8 * 2 + 1) * 64 + lane]; }
            const float bb = p.b_ada[col];
            mods[col] = s0 + bb; if (col < 4096) modsc[col] = s1 + bb;
        }
        __syncthreads();
    }
    if (b == 0 && wave == 0) {
        float d1 = wave_sum(p.lq1[lane] * p.lk1[lane]), d2 = wave_sum(p.lq2[lane] * p.lk2[lane]);
        float gq = fabsf(p.q_norm_g[lane]), gk = fabsf(p.k_norm_g[lane]);
#pragma unroll
        for (int o = 1; o < 64; o <<= 1) { gq = fmaxf(gq, __shfl_xor(gq, o)); gk = fmaxf(gk, __shfl_xor(gk, o)); }
        if (lane == 0) { float* s = P_SCAL(p); s[0] = expf(d1) - expf(d2) + LAM_INIT; s[1] = 8.0f * gq * gk * LOG2E * 1.0001f + 0.01f; }
    }
}
__device__ __forceinline__ void cvt_range(const float* __restrict__ src, bf16_t* __restrict__ dst, size_t n8, size_t gtid, size_t gthreads) {
    for (size_t i = gtid; i < n8; i += gthreads) {
        const f32x4 a = *(const f32x4*)(src + i * 8), b = *(const f32x4*)(src + i * 8 + 4);
        u32x4 o; o.x = pk2(a.x, a.y); o.y = pk2(a.z, a.w); o.z = pk2(b.x, b.y); o.w = pk2(b.z, b.w);
        *(u32x4*)(dst + i * 8) = o;
    }
}
#ifndef FP6_INTERLEAVED
#define FP6_INTERLEAVED 1
#endif
constexpr float U6_SCALE = 72.0f, V6_SCALE = 3.2f, H6_SCALE = 1.0f;
typedef unsigned u32x6 __attribute__((ext_vector_type(6)));
typedef _Float16 h16x2 __attribute__((ext_vector_type(2)));
typedef _Float16 h16x32 __attribute__((ext_vector_type(32)));
__device__ __forceinline__ unsigned pk4_fp8(f32x4 a, float sc) {
    int w = 0; w = __builtin_amdgcn_cvt_pk_fp8_f32(a.x * sc, a.y * sc, w, false); w = __builtin_amdgcn_cvt_pk_fp8_f32(a.z * sc, a.w * sc, w, true); return (unsigned)w;
}
__device__ __forceinline__ void cvt_range_fp8(const float* __restrict__ src, unsigned char* __restrict__ dst, size_t n16, float sc, size_t gtid, size_t gthreads) {
    for (size_t i = gtid; i < n16; i += gthreads) {
        const f32x4 a = *(const f32x4*)(src + i * 16), b = *(const f32x4*)(src + i * 16 + 4), c = *(const f32x4*)(src + i * 16 + 8), d = *(const f32x4*)(src + i * 16 + 12);
        u32x4 o; o.x = pk4_fp8(a, sc); o.y = pk4_fp8(b, sc); o.z = pk4_fp8(c, sc); o.w = pk4_fp8(d, sc);
        *(u32x4*)(dst + i * 16) = o;
    }
}
__device__ __forceinline__ void transpose_item(const float* W, int K, int N, bf16_t* WT, float* scr, int item, int lane, const float* kscale = nullptr) {
    const int nblk = N / 32, kb = item / nblk, nbk = item % nblk, k0 = 64 * kb, n0 = 32 * nbk;
#pragma unroll 8
    for (int i = 0; i < 32; ++i) { const int kk = 2 * i + (lane >> 5); const float w_ = W[(size_t)(k0 + kk) * N + n0 + (lane & 31)]; scr[kk * 33 + (lane & 31)] = kscale ? w_ * kscale[k0 + kk] : w_; }
    __builtin_amdgcn_s_waitcnt(0xC07F); __builtin_amdgcn_wave_barrier();
    const int c8 = lane & 7;
#pragma unroll
    for (int j = 0; j < 4; ++j) { const int n = (lane >> 3) + 8 * j; const float* s = scr + (8 * c8) * 33 + n;
        u32x4 o; o.x = pk2(s[0 * 33], s[1 * 33]); o.y = pk2(s[2 * 33], s[3 * 33]); o.z = pk2(s[4 * 33], s[5 * 33]); o.w = pk2(s[6 * 33], s[7 * 33]);
        *(u32x4*)(WT + (size_t)(n0 + n) * K + k0 + 8 * c8) = o; }
    __builtin_amdgcn_s_waitcnt(0xC07F); __builtin_amdgcn_wave_barrier();
}
constexpr float W8_SCALE = 64.0f;
__device__ __forceinline__ void transpose_item8(const float* W, int K, int N, unsigned char* WT, float* scr, int item, int lane, float sc) {
    const int nblk = N / 32, kb = item / nblk, nbk = item % nblk, k0 = 64 * kb, n0 = 32 * nbk;
#pragma unroll 8
    for (int i = 0; i < 32; ++i) { const int kk = 2 * i + (lane >> 5); scr[kk * 33 + (lane & 31)] = W[(size_t)(k0 + kk) * N + n0 + (lane & 31)]; }
    __builtin_amdgcn_s_waitcnt(0xC07F); __builtin_amdgcn_wave_barrier();
    const int c8 = lane & 7;
#pragma unroll
    for (int j = 0; j < 4; ++j) { const int n = (lane >> 3) + 8 * j; const float* s = scr + (8 * c8) * 33 + n;
        u32x2 o; o.x = pk4_fp8((f32x4){s[0 * 33], s[1 * 33], s[2 * 33], s[3 * 33]}, sc); o.y = pk4_fp8((f32x4){s[4 * 33], s[5 * 33], s[6 * 33], s[7 * 33]}, sc);
        *(u32x2*)(WT + (size_t)(n0 + n) * K + k0 + 8 * c8) = o; }
    __builtin_amdgcn_s_waitcnt(0xC07F); __builtin_amdgcn_wave_barrier();
}
__device__ __forceinline__ void norm_row_dual(const float* xrow, const float* g, const float* sh, const float* sc, bf16_t* orow, unsigned char* orow8, int lane) {
    f32x4 v[8]; float ss = 0.f;
#pragma unroll
    for (int j = 0; j < 8; ++j) { v[j] = *(const f32x4*)(xrow + j * 256 + lane * 4); ss += (v[j].x * v[j].x + v[j].y * v[j].y) + (v[j].z * v[j].z + v[j].w * v[j].w); }
    ss = wave_sum(ss);
    const float r = 1.0f / sqrtf(ss * (1.0f / 2048.0f) + EPS);
#pragma unroll
    for (int j = 0; j < 8; ++j) {
        const int o = j * 256 + lane * 4;
        const f32x4 gg = *(const f32x4*)(g + o), s4 = *(const f32x4*)(sh + o), c4 = *(const f32x4*)(sc + o);
        const f32x4 y = (v[j] * r * gg) * (1.0f + c4) + s4;
        u32x2 w; w.x = pk2(y.x, y.y); w.y = pk2(y.z, y.w);
        *(u32x2*)(orow + o) = w;
        *(unsigned*)(orow8 + o) = pk4_fp8(y, 1.0f);
    }
}

namespace pg8 {
#define PG8_LAS __attribute__((address_space(3)))
typedef unsigned short bf16_t;
typedef short bf16x8 __attribute__((ext_vector_type(8)));
typedef float f32x4 __attribute__((ext_vector_type(4)));
typedef unsigned u32x4 __attribute__((ext_vector_type(4)));
constexpr int BM = 256, BK = 64, HALF = 128, HTB = HALF * BK * 2  , STAGE_BYTES = 8 * HTB, NXCD = 8, WGM = 8;

__host__ __device__ __forceinline__ int lds_byte(int r, int c) { const int st = (r >> 4) * 2 + (c >> 5), rr = r & 15, cc = c & 31, ob = rr * 64 + cc * 2; return st * 1024 + (ob ^ (((ob >> 9) & 1) << 5)); }
__host__ __device__ __forceinline__ void stage_rc(int b, int& R, int& C) { const int st = b / 1024, sb = b % 1024, swz = sb ^ (((sb >> 9) & 1) << 5); R = (st >> 1) * 16 + swz / 64; C = (st & 1) * 32 + (swz % 64) / 2; }
__host__ __device__ __forceinline__ int perm32(int rho) { const int n = rho >> 4, i = rho & 15; return 8 * (i >> 2) + 4 * n + (i & 3); }

struct Unit { int pm, pn; };
struct Gemm { const bf16_t* A; const bf16_t* Bt; int M, N, K; };

struct StaticOrder {
    int nM, nN, nwg, G, c;
    __host__ __device__ void init(int M, int N, int G_, int c_) { nM = M / BM; nN = N / BM; nwg = nM * nN; G = G_; c = c_; }
    __host__ __device__ bool next(int i, Unit& u) const {
        const long L = (long)i * G + c; if (L >= nwg) return false;
        int wgid = (int)L; { const int q = nwg / NXCD, r = nwg % NXCD, xcd = wgid % NXCD, off = wgid / NXCD; wgid = (xcd < r ? xcd * (q + 1) : r * (q + 1) + (xcd - r) * q) + off; }
        const int nig = WGM * nN, gid = wgid / nig, fm = gid * WGM, gsz = (nM - fm) < WGM ? (nM - fm) : WGM;
        u.pm = fm + ((wgid % nig) % gsz); u.pn = (wgid % nig) / gsz; return true;
    }
    __device__ __forceinline__ void a_ready(const Unit&) const {}
    __device__ __forceinline__ void done(const Unit&) const {}
};

__device__ __forceinline__ unsigned cvt_pk_bf16(float lo, float hi) { unsigned r; asm volatile("v_cvt_pk_bf16_f32 %0, %1, %2" : "=v"(r) : "v"(lo), "v"(hi)); return r; }
typedef float f32x2 __attribute__((ext_vector_type(2)));
__device__ __forceinline__ f32x2 gelu_pk(f32x2 v) {
    const f32x2 av = __builtin_elementwise_abs(v), d = av * 0.2316418882f + 1.0f;
    f32x2 t; t.x = __builtin_amdgcn_rcpf(d.x); t.y = __builtin_amdgcn_rcpf(d.y);
    f32x2 q = t * 0.5307027145f + (-0.7265760135f); q = q * t + 0.7107068705f; q = q * t + (-0.142248368f); q = q * t + 0.127414796f; q = q * t;
    const f32x2 s = (v * v) * (-0.72134752044f);
    f32x2 e; e.x = __builtin_amdgcn_exp2f(s.x); e.y = __builtin_amdgcn_exp2f(s.y);
    const f32x2 m = v * (q * e), r = v - m;
    f32x2 o; o.x = v.x < 0.f ? m.x : r.x; o.y = v.y < 0.f ? m.y : r.y; return o;
}

template <int ACT  > struct EpiBf16 {
    static constexpr bool PERM = true, AFTER_DRAIN = false; static_assert(ACT == 0 || ACT == 1, "EpiBf16: ACT is 0 (none) or 1 (gelu_pk)");
    bf16_t* O; int ldc; const float* bias; int split_cols; size_t split_stride; float scale0;
    __device__ __forceinline__ void operator()(const f32x4 (&acc)[2][2][4][2], const Unit& u, int wr, int wc, int fr, int fq) const {
        const int row0 = u.pm * BM + wr * 64 + fr; int colt = u.pn * BM; bf16_t* base = O;
        float sc = 1.f; if (split_cols) { const int t = colt / split_cols; base += (size_t)t * split_stride; colt -= t * split_cols; if (t == 0) sc = scale0; }
        const int col0 = colt + wc * 32 + 8 * fq, bcol0 = u.pn * BM + wc * 32 + 8 * fq;
        f32x4 bv[2][2];
#pragma unroll
        for (int bj = 0; bj < 2; ++bj)
#pragma unroll
            for (int n = 0; n < 2; ++n) bv[bj][n] = bias ? *(const f32x4*)(bias + bcol0 + bj * HALF + 4 * n) : (f32x4){0.f, 0.f, 0.f, 0.f};
#pragma unroll
        for (int ai = 0; ai < 2; ++ai)
#pragma unroll
            for (int m = 0; m < 4; ++m) { bf16_t* rowp = base + (size_t)(row0 + ai * HALF + m * 16) * ldc + col0;
#pragma unroll
                for (int bj = 0; bj < 2; ++bj) { f32x4 v0 = acc[ai][bj][m][0] + bv[bj][0], v1 = acc[ai][bj][m][1] + bv[bj][1];
                    if (ACT == 1) { f32x2 a = gelu_pk((f32x2){v0[0], v0[1]}), b = gelu_pk((f32x2){v0[2], v0[3]}), c = gelu_pk((f32x2){v1[0], v1[1]}), d = gelu_pk((f32x2){v1[2], v1[3]});
                        v0 = (f32x4){a.x, a.y, b.x, b.y}; v1 = (f32x4){c.x, c.y, d.x, d.y}; }
                    v0 = v0 * sc; v1 = v1 * sc; u32x4 w; w.x = cvt_pk_bf16(v0[0], v0[1]); w.y = cvt_pk_bf16(v0[2], v0[3]); w.z = cvt_pk_bf16(v1[0], v1[1]); w.w = cvt_pk_bf16(v1[2], v1[3]);
                    *(u32x4*)(rowp + bj * HALF) = w; } }
    }
};

struct EpiG1m {
    static constexpr bool PERM = true, AFTER_DRAIN = false;
    bf16_t *ug, *vg; unsigned char *qs, *kimg, *vimg; const float *qg, *kg, *rope; PG8_LAS float* xs; int pm_off, pn_off; float wi;
    __device__ __forceinline__ void operator()(const f32x4 (&acc)[2][2][4][2], const Unit& u_, int wr, int wc_, int fr_, int fq_) const {
        const Unit u{u_.pm + pm_off, u_.pn + pn_off}; const float WI = wi;
        int wc = wc_, fr = fr_, fq = fq_;
        asm volatile("" : "+s"(wc), "+v"(fr), "+v"(fq));
        const int colt = u.pn * BM;
        if (colt < 2048) {
            if (u.pm == 0) return;
            bf16_t* base = (colt < 1024) ? ug : vg; const int cbase = colt & 1023;
            const int row0 = u.pm * BM + wr * 64 + fr - 256, col0 = cbase + wc * 32 + 8 * fq;
#pragma unroll
            for (int ai = 0; ai < 2; ++ai)
#pragma unroll
                for (int m = 0; m < 4; ++m) { bf16_t* rowp = base + (size_t)(row0 + ai * HALF + m * 16) * 1024 + col0;
#pragma unroll
                    for (int bj = 0; bj < 2; ++bj) { const f32x4 v0 = acc[ai][bj][m][0], v1 = acc[ai][bj][m][1];
                        const f32x2 a = gelu_pk((f32x2){v0[0], v0[1]}), b = gelu_pk((f32x2){v0[2], v0[3]}), c = gelu_pk((f32x2){v1[0], v1[1]}), d = gelu_pk((f32x2){v1[2], v1[3]});
                        u32x4 w; w.x = cvt_pk_bf16(a.x, a.y); w.y = cvt_pk_bf16(b.x, b.y); w.z = cvt_pk_bf16(c.x, c.y); w.w = cvt_pk_bf16(d.x, d.y);
                        *(u32x4*)(rowp + bj * HALF) = w; } }
        } else if (colt < 4096) {
            const bool isq = colt < 3072;
            if (isq && u.pm == 0) return;
            const bool latent = u.pm != 0;
            const int head0 = (colt - (isq ? 2048 : 3072)) >> 7, comp = wc >> 1, cin = 32 * (wc & 1) + 8 * fq;
            const float* gn = (isq ? qg : kg) + cin;
            const f32x4 g0 = *(const f32x4*)gn, g1 = *(const f32x4*)(gn + 4);
#pragma unroll
            for (int ai = 0; ai < 2; ++ai)
#pragma unroll
                for (int m = 0; m < 4; ++m)
#pragma unroll
                    for (int bj = 0; bj < 2; ++bj) { const f32x4 v0 = acc[ai][bj][m][0], v1 = acc[ai][bj][m][1];
                        float s_ = ((v0[0] * v0[0] + v0[1] * v0[1]) + (v0[2] * v0[2] + v0[3] * v0[3])) + ((v1[0] * v1[0] + v1[1] * v1[1]) + (v1[2] * v1[2] + v1[3] * v1[3]));
                        s_ += __shfl_xor(s_, 16); s_ += __shfl_xor(s_, 32);
                        if (fq == 0) xs[((ai * HALF + wr * 64 + m * 16 + fr) * 2 + bj) * 4 + wc] = s_; }
            asm volatile("s_waitcnt lgkmcnt(0)" ::: "memory"); __builtin_amdgcn_s_barrier(); asm volatile("" ::: "memory");
            const float mul = isq ? QSCALE : 1.0f;
#pragma unroll
            for (int ai = 0; ai < 2; ++ai)
#pragma unroll
                for (int m = 0; m < 4; ++m) { const int rl = ai * HALF + wr * 64 + m * 16 + fr, row = u.pm * BM + rl, pos = row - CTX;
                    const int tp = (wc & 1) ? 256 + (pos & 63) : (pos >> 6);
                    const float* tb = rope + ((size_t)(latent ? tp : 0) * 16 + 4 * fq) * 2;
                    f32x4 t0 = *(const f32x4*)tb, t1 = *(const f32x4*)(tb + 4);
                    if (!latent) { t0 = (f32x4){1.f, 0.f, 1.f, 0.f}; t1 = t0; }
#pragma unroll
                    for (int bj = 0; bj < 2; ++bj) { const float tot = xs[(rl * 2 + bj) * 4 + wc] + xs[(rl * 2 + bj) * 4 + (wc ^ 1)];
                        const float r_ = WI / sqrtf(tot * (WI * WI / 64.0f) + EPS);
                        const f32x4 a0 = acc[ai][bj][m][0] * r_ * g0, a1 = acc[ai][bj][m][1] * r_ * g1;
                        const float e0 = (a0[0] * t0[0] - a0[1] * t0[1]) * mul, o0 = (a0[0] * t0[1] + a0[1] * t0[0]) * mul, e1 = (a0[2] * t0[2] - a0[3] * t0[3]) * mul, o1 = (a0[2] * t0[3] + a0[3] * t0[2]) * mul;
                        const float e2 = (a1[0] * t1[0] - a1[1] * t1[1]) * mul, o2 = (a1[0] * t1[1] + a1[1] * t1[0]) * mul, e3 = (a1[2] * t1[2] - a1[3] * t1[3]) * mul, o3 = (a1[2] * t1[3] + a1[3] * t1[2]) * mul;
                        int w0 = __builtin_amdgcn_cvt_pk_fp8_f32(e0, o0, 0, false); w0 = __builtin_amdgcn_cvt_pk_fp8_f32(e1, o1, w0, true);
                        int w1 = __builtin_amdgcn_cvt_pk_fp8_f32(e2, o2, 0, false); w1 = __builtin_amdgcn_cvt_pk_fp8_f32(e3, o3, w1, true);
                        const u32x2 w = {(unsigned)w0, (unsigned)w1};
                        const int head = head0 + bj;
                        if (isq) *(u32x2*)(qs + ((size_t)head * SEQ + pos) * 128 + comp * 64 + cin) = w;
                        else *(u32x2*)(kimg + ((size_t)head * NTILE + (row >> 6)) * 8192 + k8_off(row & 63, comp * 64 + cin)) = w; }
                    asm volatile("" ::: "memory"); }
        } else {
            const int row0 = u.pm * BM + wr * 64 + fr, c0 = wc * 32 + 8 * fq, head0 = (colt - 4096) >> 7;
#pragma unroll
            for (int ai = 0; ai < 2; ++ai)
#pragma unroll
                for (int m = 0; m < 4; ++m) { const int row = row0 + ai * HALF + m * 16;
#pragma unroll
                    for (int bj = 0; bj < 2; ++bj) { const f32x4 v0 = acc[ai][bj][m][0], v1 = acc[ai][bj][m][1];
                        int w0 = __builtin_amdgcn_cvt_pk_fp8_f32(v0[0] * WI, v0[1] * WI, 0, false); w0 = __builtin_amdgcn_cvt_pk_fp8_f32(v0[2] * WI, v0[3] * WI, w0, true);
                        int w1 = __builtin_amdgcn_cvt_pk_fp8_f32(v1[0] * WI, v1[1] * WI, 0, false); w1 = __builtin_amdgcn_cvt_pk_fp8_f32(v1[2] * WI, v1[3] * WI, w1, true);
                        unsigned char* ib = vimg + ((size_t)(head0 + bj) * NTILE + (row >> 6)) * 8192;
#pragma unroll
                        for (int i = 0; i < 4; ++i) { ib[v8_off(row & 63, c0 + i)] = (unsigned char)((unsigned)w0 >> (8 * i)); ib[v8_off(row & 63, c0 + 4 + i)] = (unsigned char)((unsigned)w1 >> (8 * i)); } } }
        }
    }
};
struct EpiOutm {
    static constexpr bool PERM = true, AFTER_DRAIN = false;
    const float* x; const float* g1; bf16_t* xn; float* rss;
    __device__ __forceinline__ void operator()(const f32x4 (&acc)[2][2][4][2], const Unit& u, int wr, int wc, int fr, int fq) const {
        const int row0 = u.pm * BM + wr * 64 + fr, col0 = u.pn * BM + wc * 32 + 8 * fq;
        f32x4 gv[2][2];
#pragma unroll
        for (int bj = 0; bj < 2; ++bj)
#pragma unroll
            for (int n = 0; n < 2; ++n) gv[bj][n] = *(const f32x4*)(g1 + col0 + bj * HALF + 4 * n);
#pragma unroll
        for (int ai = 0; ai < 2; ++ai)
#pragma unroll
            for (int m = 0; m < 4; ++m) { const int row = row0 + ai * HALF + m * 16; const size_t off = (size_t)row * 2048 + col0; float ss = 0.f;
#pragma unroll
                for (int bj = 0; bj < 2; ++bj) {
                    const f32x4 v0 = *(const f32x4*)(x + off + bj * HALF) + gv[bj][0] * acc[ai][bj][m][0], v1 = *(const f32x4*)(x + off + bj * HALF + 4) + gv[bj][1] * acc[ai][bj][m][1];
                    ss += ((v0[0] * v0[0] + v0[1] * v0[1]) + (v0[2] * v0[2] + v0[3] * v0[3])) + ((v1[0] * v1[0] + v1[1] * v1[1]) + (v1[2] * v1[2] + v1[3] * v1[3]));
                    u32x4 w; w.x = cvt_pk_bf16(v0[0], v0[1]); w.y = cvt_pk_bf16(v0[2], v0[3]); w.z = cvt_pk_bf16(v1[0], v1[1]); w.w = cvt_pk_bf16(v1[2], v1[3]);
                    *(u32x4*)(xn + off + bj * HALF) = w; }
                ss += __shfl_xor(ss, 16); ss += __shfl_xor(ss, 32);
                if (fq == 0) rss[(size_t)row * 32 + u.pn * 4 + wc] = ss; }
    }
};
struct EpiQp {
    static constexpr bool PERM = true, AFTER_DRAIN = false;
    bf16_t* q; const float* rss; const float* bq;
    __device__ __forceinline__ void operator()(const f32x4 (&acc)[2][2][4][2], const Unit& u, int wr, int wc, int fr, int fq) const {
        const int row0 = u.pm * BM + wr * 64 + fr, col0 = u.pn * BM + wc * 32 + 8 * fq;
        f32x4 bv[2][2];
#pragma unroll
        for (int bj = 0; bj < 2; ++bj)
#pragma unroll
            for (int n = 0; n < 2; ++n) bv[bj][n] = *(const f32x4*)(bq + col0 + bj * HALF + 4 * n);
#pragma unroll
        for (int ai = 0; ai < 2; ++ai)
#pragma unroll
            for (int m = 0; m < 4; ++m) { const int row = row0 + ai * HALF + m * 16;
                const f32x4 p0 = *(const f32x4*)(rss + (size_t)row * 32 + fq * 8), p1 = *(const f32x4*)(rss + (size_t)row * 32 + fq * 8 + 4);
                float ss = ((p0[0] + p0[1]) + (p0[2] + p0[3])) + ((p1[0] + p1[1]) + (p1[2] + p1[3]));
                ss += __shfl_xor(ss, 16); ss += __shfl_xor(ss, 32);
                const float r_ = 1.0f / sqrtf(ss * (1.0f / 2048.0f) + EPS);
                bf16_t* rowp = q + (size_t)row * 2048 + col0;
#pragma unroll
                for (int bj = 0; bj < 2; ++bj) { const f32x4 v0 = acc[ai][bj][m][0] * r_ + bv[bj][0], v1 = acc[ai][bj][m][1] * r_ + bv[bj][1];
                    u32x4 w; w.x = cvt_pk_bf16(v0[0], v0[1]); w.y = cvt_pk_bf16(v0[2], v0[3]); w.z = cvt_pk_bf16(v1[0], v1[1]); w.w = cvt_pk_bf16(v1[2], v1[3]);
                    *(u32x4*)(rowp + bj * HALF) = w; } }
    }
};
typedef int pg8_i32x4 __attribute__((ext_vector_type(4)));
template <class Epi, class Sched, bool ALIGN_EPI = false, bool SP2 = false, bool FP8 = false>
__device__ __forceinline__ void gemm_phase(PG8_LAS unsigned char* lds, const Gemm g, const Sched& S, const Epi& E) {
    const int tid = threadIdx.x, wid = __builtin_amdgcn_readfirstlane(tid >> 6), lane = tid & 63, wr = wid >> 2, wc = wid & 3, fr = lane & 15, fq = lane >> 4;
    const int K = g.K, nt = K / BK;
    unsigned voffA[2], voffB[2];
#pragma unroll
    for (int i = 0; i < 2; ++i) { int R, C; stage_rc(tid * 16 + i * 8192, R, C); const int Rb = Epi::PERM ? ((R & ~31) + perm32(R & 31)) : R;
        voffA[i] = (unsigned)(R * K + C) * 2u; voffB[i] = (unsigned)(Rb * K + C) * 2u; }
    const size_t kstep = (size_t)(BK * 2);
    const size_t hstep = (size_t)HALF * K * 2;
    const size_t tstep = 2 * hstep;
    const unsigned ldsw = (unsigned)wid * 1024u;
    const int aoff = lds_byte(wr * 64 + fr, fq * 8), boff = lds_byte(wc * 32 + fr, fq * 8);
#define PG8_SA(b, h) (((b) * 2 + (h)) * HTB)
#define PG8_SB(b, h) ((4 + (b) * 2 + (h)) * HTB)
#define PG8_STAGE(bufoff, gbase, voff) do { _Pragma("unroll") for (int _i = 0; _i < 2; ++_i) \
        __builtin_amdgcn_global_load_lds((const unsigned*)((const char*)(gbase) + (voff)[_i]), (PG8_LAS unsigned*)(lds + (bufoff) + ldsw + _i * 8192), 16, 0, 0); } while (0)
#define PG8_LDA(dst, b, h) do { _Pragma("unroll") for (int m = 0; m < 4; ++m) _Pragma("unroll") for (int k = 0; k < 2; ++k) dst[m][k] = *(const PG8_LAS bf16x8*)(lds + PG8_SA(b, h) + aoff + m * 2048 + k * 1024); } while (0)
#define PG8_LDB(dst, b, h) do { _Pragma("unroll") for (int n = 0; n < 2; ++n) _Pragma("unroll") for (int k = 0; k < 2; ++k) dst[n][k] = *(const PG8_LAS bf16x8*)(lds + PG8_SB(b, h) + boff + n * 2048 + k * 1024); } while (0)
#define PG8_CAT(X) __builtin_shufflevector(__builtin_bit_cast(pg8_i32x4, X[0]), __builtin_bit_cast(pg8_i32x4, X[1]), 0, 1, 2, 3, 4, 5, 6, 7)
#define PG8_MMA(ai, bj, At, Bt) do { __builtin_amdgcn_s_setprio(1); _Pragma("unroll") for (int m = 0; m < 4; ++m) _Pragma("unroll") for (int n = 0; n < 2; ++n) { \
        if constexpr (FP8) asm volatile("v_mfma_f32_16x16x128_f8f6f4 %0, %1, %2, %0" : "+v"(acc[ai][bj][m][n]) : "v"(PG8_CAT(Bt[n])), "v"(PG8_CAT(At[m])));   \
        else { _Pragma("unroll") for (int k = 0; k < 2; ++k) acc[ai][bj][m][n] = __builtin_amdgcn_mfma_f32_16x16x32_bf16(Bt[n][k], At[m][k], acc[ai][bj][m][n], 0, 0, 0); } } __builtin_amdgcn_s_setprio(0); } while (0)
#define PG8_WAIT_V(n) asm volatile("s_waitcnt vmcnt(" #n ")" ::: "memory")
#define PG8_WAIT_L(n) asm volatile("s_waitcnt lgkmcnt(" #n ")" ::: "memory")
#define PG8_BAR __builtin_amdgcn_s_barrier()
#define PG8_SCHED __builtin_amdgcn_sched_barrier(0)
    Unit cur, nxt; int ui = 0;
    if (!S.next(0, cur)) return;
    f32x4 acc[2][2][4][2];
#pragma unroll
    for (int a = 0; a < 2; ++a)
#pragma unroll
        for (int b = 0; b < 2; ++b)
#pragma unroll
            for (int m = 0; m < 4; ++m)
#pragma unroll
                for (int n = 0; n < 2; ++n) acc[a][b][m][n] = (f32x4){0.f, 0.f, 0.f, 0.f};
    bf16x8 At[4][2], B0[2][2], B1[2][2];
    const char* cA = (const char*)g.A + (size_t)cur.pm * tstep; const char* cB = (const char*)g.Bt + (size_t)cur.pn * tstep;
    S.a_ready(cur);
    if constexpr (SP2) {
        PG8_STAGE(PG8_SB(0, 0), cB, voffB); PG8_STAGE(PG8_SB(0, 1), cB + hstep, voffB); PG8_STAGE(PG8_SA(0, 0), cA, voffA); PG8_STAGE(PG8_SA(0, 1), cA + hstep, voffA);
        if (wr == 1) PG8_BAR;
        PG8_WAIT_V(2); PG8_BAR;
        PG8_STAGE(PG8_SB(1, 0), cB + kstep, voffB); PG8_STAGE(PG8_SA(1, 0), cA + kstep, voffA); PG8_STAGE(PG8_SB(1, 1), cB + hstep + kstep, voffB);
        PG8_WAIT_V(6); PG8_BAR;
    } else {
        PG8_STAGE(PG8_SB(0, 0), cB, voffB); PG8_STAGE(PG8_SA(0, 0), cA, voffA); PG8_STAGE(PG8_SB(0, 1), cB + hstep, voffB); PG8_STAGE(PG8_SA(0, 1), cA + hstep, voffA);
        if (wr == 1) PG8_BAR;
        PG8_WAIT_V(4); PG8_BAR;
        PG8_STAGE(PG8_SB(1, 0), cB + kstep, voffB); PG8_STAGE(PG8_SA(1, 0), cA + kstep, voffA); PG8_STAGE(PG8_SB(1, 1), cB + hstep + kstep, voffB);
        PG8_WAIT_V(6); PG8_BAR;
    }
    for (;;) {
        const bool has_next = S.next(ui + 1, nxt);
        const char* nA = has_next ? (const char*)g.A + (size_t)nxt.pm * tstep : cA; const char* nB = has_next ? (const char*)g.Bt + (size_t)nxt.pn * tstep : cB;
        for (int t = 0; t < nt; t += 2) {
            const bool last = (t == nt - 2);
            const char* a1 = cA + (size_t)(t + 1) * kstep;
            const char* a2 = last ? nA : cA + (size_t)(t + 2) * kstep; const char* b2 = last ? nB : cB + (size_t)(t + 2) * kstep;
            const char* a3 = a2 + kstep; const char* b3 = b2 + kstep;
            if (last && has_next) S.a_ready(nxt);
            if constexpr (SP2) {
            PG8_LDB(B0, 0, 0); PG8_LDB(B1, 0, 1); PG8_SCHED; PG8_LDA(At, 0, 0); PG8_STAGE(PG8_SA(1, 1), a1 + hstep, voffA);
            PG8_WAIT_V(8); PG8_WAIT_L(0); PG8_BAR; PG8_MMA(0, 0, At, B0); PG8_MMA(0, 1, At, B1); PG8_BAR; PG8_SCHED;
            PG8_LDA(At, 0, 1); PG8_STAGE(PG8_SB(0, 0), b2, voffB); PG8_STAGE(PG8_SB(0, 1), b2 + hstep, voffB); PG8_STAGE(PG8_SA(0, 0), a2, voffA);
            PG8_WAIT_V(8); PG8_WAIT_L(0); PG8_BAR; PG8_MMA(1, 0, At, B0); PG8_MMA(1, 1, At, B1); PG8_BAR; PG8_SCHED;
            PG8_LDB(B0, 1, 0); PG8_LDB(B1, 1, 1); PG8_SCHED; PG8_LDA(At, 1, 0); PG8_STAGE(PG8_SA(0, 1), a2 + hstep, voffA);
            PG8_WAIT_V(8); PG8_WAIT_L(0); PG8_BAR; PG8_MMA(0, 0, At, B0); PG8_MMA(0, 1, At, B1); PG8_BAR; PG8_SCHED;
            PG8_LDA(At, 1, 1); PG8_STAGE(PG8_SB(1, 0), b3, voffB); PG8_STAGE(PG8_SB(1, 1), b3 + hstep, voffB); PG8_STAGE(PG8_SA(1, 0), a3, voffA);
            PG8_WAIT_V(8); PG8_WAIT_L(0); PG8_BAR; PG8_MMA(1, 0, At, B0); PG8_MMA(1, 1, At, B1); PG8_BAR; PG8_SCHED;
            } else {
            PG8_LDB(B0, 0, 0); PG8_SCHED; PG8_LDA(At, 0, 0); PG8_STAGE(PG8_SA(1, 1), a1 + hstep, voffA);
            PG8_WAIT_L(8); PG8_BAR; PG8_WAIT_L(0); PG8_MMA(0, 0, At, B0); PG8_BAR; PG8_SCHED;
            PG8_LDB(B1, 0, 1); PG8_STAGE(PG8_SB(0, 0), b2, voffB);
            PG8_BAR; PG8_WAIT_L(0); PG8_MMA(0, 1, At, B1); PG8_BAR;
            PG8_LDA(At, 0, 1); PG8_STAGE(PG8_SA(0, 0), a2, voffA);
            PG8_BAR; PG8_WAIT_L(0); PG8_MMA(1, 0, At, B0); PG8_BAR; PG8_SCHED;
            PG8_STAGE(PG8_SB(0, 1), b2 + hstep, voffB);
            PG8_WAIT_V(6); PG8_BAR; PG8_MMA(1, 1, At, B1); PG8_BAR;
            PG8_LDB(B0, 1, 0); PG8_SCHED; PG8_LDA(At, 1, 0); PG8_STAGE(PG8_SA(0, 1), a2 + hstep, voffA);
            PG8_WAIT_L(8); PG8_BAR; PG8_WAIT_L(0); PG8_MMA(0, 0, At, B0); PG8_BAR; PG8_SCHED;
            PG8_LDB(B1, 1, 1); PG8_STAGE(PG8_SB(1, 0), b3, voffB);
            PG8_BAR; PG8_WAIT_L(0); PG8_MMA(0, 1, At, B1); PG8_BAR;
            PG8_LDA(At, 1, 1); PG8_STAGE(PG8_SA(1, 0), a3, voffA);
            PG8_BAR; PG8_WAIT_L(0); PG8_MMA(1, 0, At, B0); PG8_BAR; PG8_SCHED;
            PG8_STAGE(PG8_SB(1, 1), b3 + hstep, voffB);
            PG8_WAIT_V(6); PG8_BAR; PG8_MMA(1, 1, At, B1); PG8_BAR;
            }
        }
        if constexpr (ALIGN_EPI) { if (wr == 0) PG8_BAR; }
        if constexpr (FP8) asm volatile("s_nop 15\n\ts_nop 15" ::: "memory");
        if constexpr (!Epi::AFTER_DRAIN) { E(acc, cur, wr, wc, fr, fq); S.done(cur); }
        if (!has_next) break;
#pragma unroll
        for (int a = 0; a < 2; ++a)
#pragma unroll
            for (int b = 0; b < 2; ++b)
#pragma unroll
                for (int m = 0; m < 4; ++m)
#pragma unroll
                    for (int n = 0; n < 2; ++n) acc[a][b][m][n] = (f32x4){0.f, 0.f, 0.f, 0.f};
        cur = nxt; cA = nA; cB = nB; ++ui;
        if constexpr (ALIGN_EPI) { if (wr == 1) PG8_BAR; }
    }
    PG8_WAIT_V(0);
    if constexpr (!ALIGN_EPI) { if (wr == 0) PG8_BAR; }
    PG8_BAR;
    if constexpr (Epi::AFTER_DRAIN) { E.fused(acc, cur, wr, wc, fr, fq, lds, wid, lane); S.done(cur); }
#undef PG8_SA
#undef PG8_SB
#undef PG8_STAGE
#undef PG8_LDA
#undef PG8_LDB
#undef PG8_MMA
#undef PG8_CAT
#undef PG8_WAIT_V
#undef PG8_WAIT_L
#undef PG8_BAR
#undef PG8_SCHED
}
}


#define LAS __attribute__((address_space(3)))
namespace att {
using bf16x8 = __attribute__((ext_vector_type(8))) short;
using s16x4 = __attribute__((ext_vector_type(4))) short;
#define KSWZ(row, colB) ((row) * 256 + ((colB) ^ (((row) & 15) << 4)))
__device__ __forceinline__ int crow(int r, int hi) { return (r & 3) + 8 * (r >> 2) + 4 * hi; }
__device__ __forceinline__ int v_rd_base(int lane) { return ((lane & 3) << 3) | (((lane >> 2) & 3) << 6) | (((lane >> 4) & 1) << 5) | (((lane >> 5) & 1) << 8); }
constexpr int v_rd_off(int d0, int ks, int half) { return d0 * 512 + ks * 4096 + half * 2048; }
template <int OFF> __device__ __forceinline__ s16x4 tr_read(int vb) { s16x4 r; asm volatile("ds_read_b64_tr_b16 %0, %1 offset:%2" : "=&v"(r) : "v"(vb), "i"(OFF) : "memory"); return r; }
typedef __attribute__((address_space(3))) const char* lds_cptr;
typedef short v4i16_t __attribute__((ext_vector_type(4)));
typedef float f32x2_t __attribute__((ext_vector_type(2)));
typedef __bf16 bf16x2_t __attribute__((ext_vector_type(2)));
__device__ __forceinline__ void glds16(const void* gsrc, unsigned lds_dst) { unsigned keep;
    asm volatile("s_mov_b32 %0, m0\n\ts_mov_b32 m0, %2\n\ts_nop 0\n\tglobal_load_lds_dwordx4 %1, off\n\ts_mov_b32 m0, %0" : "=&s"(keep) : "v"(gsrc), "s"(lds_dst) : "memory"); }
typedef int i32x8 __attribute__((ext_vector_type(8)));
typedef int i32x4v __attribute__((ext_vector_type(4)));
__device__ __forceinline__ i32x8 ld32(lds_cptr a, lds_cptr b) { const i32x4v x = *(const LAS i32x4v*)a, y = *(const LAS i32x4v*)b; return (i32x8){x[0], x[1], x[2], x[3], y[0], y[1], y[2], y[3]}; }
__device__ __forceinline__ void attn_unit8(const Params& p, int h, int qb, char* lds) {
    int tid = threadIdx.x;
    asm volatile("" : "+v"(tid));
    const int wid = tid >> 6, lane = tid & 63, r32 = lane & 31, hi = lane >> 5;
    constexpr int A8_V = 0, A8_K = 49152, A8_Q = 98304, A8_WS = 131072;
    const int vs = (r32 >> 2) & 3, lb = (int)(uintptr_t)lds;
    const int vo0 = lb + r32 * 64 + (((2 * hi) ^ vs) << 4), vo1 = lb + r32 * 64 + (((2 * hi + 1) ^ vs) << 4);
    const int qv0 = vo0 + A8_Q + wid * 4096, qv1 = vo1 + A8_Q + wid * 4096;
    {   const unsigned char* Qw = P_QS8(p) + ((size_t)h * SEQ + (size_t)qb * 256 + wid * 32 + r32) * 128 + hi * 32;
        const i32x4v a0 = *(const i32x4v*)Qw, a1 = *(const i32x4v*)(Qw + 16), b0 = *(const i32x4v*)(Qw + 64), b1 = *(const i32x4v*)(Qw + 80);
        *(LAS i32x4v*)(uintptr_t)(unsigned)qv0 = a0; *(LAS i32x4v*)(uintptr_t)(unsigned)qv1 = a1; *(LAS i32x4v*)(uintptr_t)(unsigned)(qv0 + 2048) = b0; *(LAS i32x4v*)(uintptr_t)(unsigned)(qv1 + 2048) = b1;
    }
    const unsigned char* kimg = P_KIMG8(p) + (size_t)h * NTILE * 8192 + tid * 16;
    const unsigned char* vimg = P_VIMG8(p) + (size_t)h * NTILE * 8192 + tid * 16;
    const unsigned ldsw = (unsigned)__builtin_amdgcn_readfirstlane(wid) * 1024u;
    const unsigned kdst = (unsigned)(uintptr_t)(lds + A8_K) + ldsw, vdst = (unsigned)(uintptr_t)(lds + A8_V) + ldsw;
#define GLDSK(t, b) do { const size_t o_ = (size_t)(t) * 16384; _Pragma("unroll") for (int i_ = 0; i_ < 2; ++i_) glds16(kimg + o_ + i_ * 8192, (unsigned)__builtin_amdgcn_readfirstlane(kdst + (b) * 16384 + i_ * 8192)); } while (0)
#define GLDSV(t, b) do { const size_t o_ = (size_t)(t) * 16384; _Pragma("unroll") for (int i_ = 0; i_ < 2; ++i_) glds16(vimg + o_ + i_ * 8192, (unsigned)__builtin_amdgcn_readfirstlane(vdst + (b) * 16384 + i_ * 8192)); } while (0)
    f32x16 oA[4], oB[4]; f32x4 lAc = {0.f, 0.f, 0.f, 0.f}, lBc = {0.f, 0.f, 0.f, 0.f};
    i32x8 onesB; { const int ow = (((lane & 15) == 0 && !((lane >> 4) & 1)) || ((lane & 15) == 1 && ((lane >> 4) & 1))) ? 0x38383838 : 0;
#pragma unroll
        for (int i = 0; i < 8; ++i) onesB[i] = ow; }
#pragma unroll
    for (int d = 0; d < 4; ++d) { oA[d] = f32x16{}; oB[d] = f32x16{}; }
    f32x16 sA0, sA1, sB0, sB1; i32x8 pA = {}, pB = {}, kx, ky, vx, vy, qA, qB;
#define SB() __builtin_amdgcn_sched_barrier(0)
#define RD(a0_, a1_, imm_) ld32((lds_cptr)(uintptr_t)(unsigned)((a0_) + (imm_)), (lds_cptr)(uintptr_t)(unsigned)((a1_) + (imm_)))
#define MMS(A_, B_) __builtin_amdgcn_mfma_scale_f32_32x32x64_f8f6f4(A_, B_, f32x16{}, 0, 0, 0, 0, 0, 0)
#define MMO(ACC, A_, B_) ACC = __builtin_amdgcn_mfma_scale_f32_32x32x64_f8f6f4(A_, B_, ACC, 1, 0, 0, 0, 0, 0)
#define EX4(S, B) do { S[B] = __builtin_amdgcn_exp2f(S[B]); S[B + 1] = __builtin_amdgcn_exp2f(S[B + 1]); S[B + 2] = __builtin_amdgcn_exp2f(S[B + 2]); S[B + 3] = __builtin_amdgcn_exp2f(S[B + 3]); } while (0)
#define MML(ACC, A_) ACC = __builtin_amdgcn_mfma_scale_f32_16x16x128_f8f6f4(A_, onesB, ACC, 1, 0, 0, 0, 0, 0)
#define PK4(S, B, OUT, I) do { OUT[I] = __builtin_amdgcn_cvt_pk_bf8_f32(S[B], S[B + 1], OUT[I], false); OUT[I] = __builtin_amdgcn_cvt_pk_bf8_f32(S[B + 2], S[B + 3], OUT[I], true); } while (0)
#define HALFE(S, O, P, I) do { EX4(S, O); EX4(S, (O) + 4); PK4(S, O, P, I); PK4(S, (O) + 4, P, (I) + 1); } while (0)
#define GROUPP(C0, C1, KI, VI, Q0, Q1, QI, N0, N1, NI, D1, D2, D3, D4) do { \
          vx = RD(Q0, Q1, (QI)); vy = RD(Q0, Q1, (QI) + 2048); SB(); sB0 = MMS(kx, qB); SB(); \
          MML(lBc, pB); MMO(oB[0], pB, vx); HALFE(sA0, 0, pA, 0); D1; SB(); \
          vx = RD(Q0, Q1, (QI) + 4096); SB(); MMO(oB[1], pB, vy); HALFE(sA0, 8, pA, 2); SB(); \
          vy = RD(Q0, Q1, (QI) + 6144); ky = RD(C0, C1, (KI) + 4096 + 2048); SB(); MMO(oB[2], pB, vx); HALFE(sA1, 0, pA, 4); D2; SB(); \
          vx = RD(C0, C1, (VI)); SB(); MMO(oB[3], pB, vy); sB1 = MMS(ky, qB); HALFE(sA1, 8, pA, 6); SB(); \
          vy = RD(C0, C1, (VI) + 2048); SB(); MML(lAc, pA); MMO(oA[0], pA, vx); D3; SB(); \
          vx = RD(C0, C1, (VI) + 4096); SB(); MMO(oA[1], pA, vy); HALFE(sB0, 0, pB, 0); SB(); \
          vy = RD(C0, C1, (VI) + 6144); kx = RD(N0, N1, (NI)); qA = RD(qv0, qv1, 0); SB(); MMO(oA[2], pA, vx); HALFE(sB0, 8, pB, 2); D4; SB(); \
          ky = RD(N0, N1, (NI) + 2048); SB(); MMO(oA[3], pA, vy); sA0 = MMS(kx, qA); HALFE(sB1, 0, pB, 4); SB(); \
          kx = RD(N0, N1, (NI) + 4096); qB = RD(qv0, qv1, 2048); SB(); sA1 = MMS(ky, qA); HALFE(sB1, 8, pB, 6); \
        asm volatile("" : "+v"(pB));        \
        SB(); } while (0)
    GLDSK(0, 0); GLDSV(0, 0); GLDSK(1, 1); GLDSV(1, 1);
    asm volatile("s_waitcnt vmcnt(0)" ::: "memory"); __syncthreads();
    int bcur = 0;
    int cb0 = vo0, cb1 = vo1;
    kx = RD(cb0, cb1, A8_K); ky = RD(cb0, cb1, A8_K + 2048); qA = RD(qv0, qv1, 0); sA0 = MMS(kx, qA); sA1 = MMS(ky, qA); SB();
    kx = RD(cb0, cb1, A8_K + 4096); qB = RD(qv0, qv1, 2048); SB();
    for (int j = 0; j < NTILE / 2; ++j) {
        const int bnx = (bcur == 2) ? 0 : bcur + 1, bn2 = (bnx == 2) ? 0 : bnx + 1;
        const int dprev = (j == 0) ? 0 : ((bcur == 0) ? 32768 : -16384), dnext = (bcur == 2) ? -32768 : 16384;
        {   int pb0 = cb0 + dprev, pb1 = cb1 + dprev;
            asm volatile("" : "+v"(pb0), "+v"(pb1));
            GROUPP(cb0, cb1, A8_K, A8_V, pb0, pb1, A8_V + 8192, cb0, cb1, A8_K + 8192, (void)0, (void)0, (void)0, (void)0); }
        asm volatile("s_waitcnt vmcnt(0)" ::: "memory"); __syncthreads();
        {
            const int tl = (j + 2 < NTILE / 2) ? j + 2 : NTILE / 2 - 1; const size_t to_ = (size_t)tl * 16384;
            const unsigned kd_ = (unsigned)__builtin_amdgcn_readfirstlane(kdst + bn2 * 16384), vd_ = (unsigned)__builtin_amdgcn_readfirstlane(vdst + bn2 * 16384);
            int nb0 = cb0 + dnext, nb1 = cb1 + dnext;
            asm volatile("" : "+v"(nb0), "+v"(nb1));
            GROUPP(cb0, cb1, A8_K + 8192, A8_V + 8192, cb0, cb1, A8_V, nb0, nb1, A8_K,
                   glds16(kimg + to_, kd_), glds16(kimg + to_ + 8192, kd_ + 8192), glds16(vimg + to_, vd_), glds16(vimg + to_ + 8192, vd_ + 8192));
            cb0 = nb0; cb1 = nb1; }
        bcur = bnx;
    }
    asm volatile("s_waitcnt vmcnt(0)" ::: "memory");
    {   const int dl = (bcur == 0) ? 32768 : -16384; const int pb0 = cb0 + dl, pb1 = cb1 + dl;
        vx = RD(pb0, pb1, A8_V + 8192); vy = RD(pb0, pb1, A8_V + 8192 + 2048); MML(lBc, pB); MMO(oB[0], pB, vx); MMO(oB[1], pB, vy); SB();
        vx = RD(pb0, pb1, A8_V + 8192 + 4096); vy = RD(pb0, pb1, A8_V + 8192 + 6144); MMO(oB[2], pB, vx); MMO(oB[3], pB, vy); }
    __syncthreads();
#undef SB
#undef RD
#undef MMS
#undef MMO
#undef EX4
#undef MML
#undef PK4
#undef HALFE
#undef GROUPP
#undef GLDSK
#undef GLDSV
    int tide = threadIdx.x;
    asm volatile("" : "+v"(tide));
    const int r32e = tide & 31, hie = (tide >> 5) & 1, wide = tide >> 6;
    const float lam = P_SCAL(p)[0];
    float* wsf = (float*)(lds + A8_WS) + wide * 64;
    {   const int lq = 16 * (r32e & 15) + 4 * ((r32e >> 4) + 2 * hie);
        if ((r32e & 15) <= 1) {
#pragma unroll
            for (int r = 0; r < 4; ++r) { wsf[lq + r] = __builtin_amdgcn_rcpf(lAc[r]); wsf[32 + lq + r] = lam * __builtin_amdgcn_rcpf(lBc[r]); } } }
    asm volatile("s_waitcnt lgkmcnt(0)" ::: "memory");
    const unsigned tb = (unsigned)(uintptr_t)lds + (unsigned)wide * 8192u;
    const float g0 = p.subln_g[r32e] * (1.0f - LAM_INIT), g1 = p.subln_g[32 + r32e] * (1.0f - LAM_INIT), g2 = p.subln_g[64 + r32e] * (1.0f - LAM_INIT), g3 = p.subln_g[96 + r32e] * (1.0f - LAM_INIT);
#define DPPQ(v_, ctl_) __builtin_bit_cast(float, __builtin_amdgcn_update_dpp(0, __builtin_bit_cast(int, v_), ctl_, 0xF, 0xF, true))
#pragma unroll
    for (int r = 0; r < 16; ++r) { const float ra = wsf[crow(r, hie)], rb2 = wsf[32 + crow(r, hie)];
        const float y0 = oA[0][r] * ra - oB[0][r] * rb2, y1 = oA[1][r] * ra - oB[1][r] * rb2, y2 = oA[2][r] * ra - oB[2][r] * rb2, y3 = oA[3][r] * ra - oB[3][r] * rb2;
        float q = (y0 * y0 + y1 * y1) + (y2 * y2 + y3 * y3);
        q += DPPQ(q, 0xB1); q += DPPQ(q, 0x4E); q += DPPQ(q, 0x141); q += DPPQ(q, 0x140);
        q += __builtin_bit_cast(float, __builtin_amdgcn_ds_swizzle(__builtin_bit_cast(int, q), 0x401F));
        const float rs = __builtin_amdgcn_rsqf(q * (1.0f / 128.0f) + EPS);
        const unsigned ta = tb + (unsigned)crow(r, hie) * 256u + (unsigned)r32e * 2u;
        *(LAS bf16_t*)(uintptr_t)ta = (bf16_t)f2bf(y0 * rs * g0); *(LAS bf16_t*)(uintptr_t)(ta + 64u) = (bf16_t)f2bf(y1 * rs * g1);
        *(LAS bf16_t*)(uintptr_t)(ta + 128u) = (bf16_t)f2bf(y2 * rs * g2); *(LAS bf16_t*)(uintptr_t)(ta + 192u) = (bf16_t)f2bf(y3 * rs * g3); }
#undef DPPQ
    asm volatile("s_waitcnt lgkmcnt(0)" ::: "memory");
    {   bf16_t* Ob = P_A2(p) + ((size_t)qb * 256 + (size_t)wide * 32) * 2048 + 1024 + h * 128;
        const int lanee = tide & 63;
#pragma unroll
        for (int i = 0; i < 8; ++i) { const int c = lanee + 64 * i, row = c >> 4, cc = c & 15;
            const u32x4 w_ = *(const LAS u32x4*)(uintptr_t)(tb + (unsigned)c * 16u);
            *(u32x4*)(Ob + (size_t)row * 2048 + cc * 8) = w_; } }
    __syncthreads();
}
#undef KSWZ
}

namespace gm {
using att::bf16x8; using att::s16x4;
template <int D0> __device__ __forceinline__ void mm_half(f32x16& o, int vb, const bf16x8* pa) {
    const s16x4 l0 = att::tr_read<att::v_rd_off(D0, 0, 0)>(vb), h0 = att::tr_read<att::v_rd_off(D0, 0, 1)>(vb), l1 = att::tr_read<att::v_rd_off(D0, 1, 0)>(vb), h1 = att::tr_read<att::v_rd_off(D0, 1, 1)>(vb);
    const s16x4 l2 = att::tr_read<att::v_rd_off(D0, 2, 0)>(vb), h2 = att::tr_read<att::v_rd_off(D0, 2, 1)>(vb), l3 = att::tr_read<att::v_rd_off(D0, 3, 0)>(vb), h3 = att::tr_read<att::v_rd_off(D0, 3, 1)>(vb);
    asm volatile("s_waitcnt lgkmcnt(0)" ::: "memory"); __builtin_amdgcn_sched_barrier(0);
#define PKV(L, H) (bf16x8){L[0], L[1], L[2], L[3], H[0], H[1], H[2], H[3]}
    o = __builtin_amdgcn_mfma_f32_32x32x16_bf16(pa[0], PKV(l0, h0), o, 0, 0, 0);
    o = __builtin_amdgcn_mfma_f32_32x32x16_bf16(pa[1], PKV(l1, h1), o, 0, 0, 0);
    o = __builtin_amdgcn_mfma_f32_32x32x16_bf16(pa[2], PKV(l2, h2), o, 0, 0, 0);
    o = __builtin_amdgcn_mfma_f32_32x32x16_bf16(pa[3], PKV(l3, h3), o, 0, 0, 0);
#undef PKV
}
__device__ __forceinline__ void gmlp_unit(const Params& p, int n, int g, char* lds) {
    int tid = threadIdx.x; asm volatile("" : "+v"(tid));
    const int wid = tid >> 6, lane = tid & 63, r32 = lane & 31, hi = lane >> 5;
    {
        const int q = tid >> 2, cq = tid & 3;
        const bf16_t* src = P_VG(p) + ((size_t)n * 128 + q) * 1024 + g * 128 + cq * 32;
        float xv[32];
#pragma unroll
        for (int i = 0; i < 4; ++i) { const u32x4 w = *(const u32x4*)(src + i * 8); const unsigned ws_[4] = {w.x, w.y, w.z, w.w};
#pragma unroll
            for (int k = 0; k < 4; ++k) { xv[i * 8 + 2 * k] = __uint_as_float(ws_[k] << 16); xv[i * 8 + 2 * k + 1] = __uint_as_float(ws_[k] & 0xffff0000u); } }
        float sm = 0.f;
#pragma unroll
        for (int i = 0; i < 32; ++i) sm += xv[i];
        sm += __shfl_xor(sm, 1); sm += __shfl_xor(sm, 2);
        const float mu = sm * (1.0f / 128.0f); float var = 0.f;
#pragma unroll
        for (int i = 0; i < 32; ++i) { xv[i] -= mu; var += xv[i] * xv[i]; }
        var += __shfl_xor(var, 1); var += __shfl_xor(var, 2);
        const float rs = 1.0f / sqrtf(var * (1.0f / 128.0f) + EPS);
        const float* lg = p.gmlp_ln_g + g * 128 + cq * 32;
        char* img = lds + (q >> 6) * 16384;
#pragma unroll
        for (int i = 0; i < 4; ++i) { u32x4 o;
            o.x = pk2(xv[i * 8 + 0] * rs * lg[i * 8 + 0], xv[i * 8 + 1] * rs * lg[i * 8 + 1]); o.y = pk2(xv[i * 8 + 2] * rs * lg[i * 8 + 2], xv[i * 8 + 3] * rs * lg[i * 8 + 3]);
            o.z = pk2(xv[i * 8 + 4] * rs * lg[i * 8 + 4], xv[i * 8 + 5] * rs * lg[i * 8 + 5]); o.w = pk2(xv[i * 8 + 6] * rs * lg[i * 8 + 6], xv[i * 8 + 7] * rs * lg[i * 8 + 7]);
            *(u32x4*)(img + v_img_off(q & 63, cq * 32 + i * 8)) = o; }
    }
    __syncthreads();
    const int pb = wid >> 1, d0b = (wid & 1) * 2;
    bf16x8 pa[8];
    const bf16_t* wsg = (const bf16_t*)(p.ws + WS_GWS) + ((size_t)g * 128 + pb * 32 + r32) * 128 + hi * 8;
#pragma unroll
    for (int ks = 0; ks < 8; ++ks) pa[ks] = *reinterpret_cast<const bf16x8*>(wsg + ks * 16);
    f32x16 o0 = f32x16{}, o1 = f32x16{};
    const int vb = (int)(uintptr_t)lds + att::v_rd_base(lane) + d0b * 512;
    mm_half<0>(o0, vb, pa); mm_half<1>(o1, vb, pa);
    mm_half<0>(o0, vb + 16384, pa + 4); mm_half<1>(o1, vb + 16384, pa + 4);
#pragma unroll
    for (int r = 0; r < 16; ++r) { const int prow = pb * 32 + att::crow(r, hi); const float bsv = p.gmlp_bs[g * 128 + prow];
        const size_t row = (size_t)n * 128 + prow; const int col = g * 128 + d0b * 32 + r32;
        const float u0 = bf2f(P_UG(p)[row * 1024 + col]), u1 = bf2f(P_UG(p)[row * 1024 + col + 32]);
        P_A2(p)[row * 2048 + col] = (bf16_t)f2bf(u0 * (o0[r] + bsv)); P_A2(p)[row * 2048 + col + 32] = (bf16_t)f2bf(u1 * (o1[r] + bsv)); }
    __syncthreads();
}
}

namespace peer {
typedef __bf16 bf16x2_t __attribute__((ext_vector_type(2)));
__device__ __forceinline__ float fmax_s(float a, float b) { float r; asm("v_max_f32 %0, %1, %2" : "=v"(r) : "v"(a), "v"(b)); return r; }
__device__ __forceinline__ float fmin_s(float a, float b) { float r; asm("v_min_f32 %0, %1, %2" : "=v"(r) : "v"(a), "v"(b)); return r; }
__device__ __forceinline__ void ce_desc(float& a, float& b) { const float mx = fmax_s(a, b), mn = fmin_s(a, b); a = mx; b = mn; }
__device__ __forceinline__ void ce_asc(float& a, float& b) { const float mx = fmax_s(a, b), mn = fmin_s(a, b); a = mn; b = mx; }
__device__ __forceinline__ void sort16_desc(float* v) {
#pragma unroll
    for (int k = 2; k <= 16; k <<= 1)
#pragma unroll
        for (int j = k >> 1; j > 0; j >>= 1)
#pragma unroll
            for (int i = 0; i < 16; ++i) { const int l = i ^ j; if (l > i) { if ((i & k) == 0) ce_desc(v[i], v[l]); else ce_asc(v[i], v[l]); } }
}
__device__ __forceinline__ void merge_top16(float* a, const float* b) {
#pragma unroll
    for (int i = 0; i < 16; ++i) a[i] = fmax_s(a[i], b[15 - i]);
#pragma unroll
    for (int j = 8; j > 0; j >>= 1)
#pragma unroll
        for (int i = 0; i < 16; ++i) { const int l = i ^ j; if (l > i) ce_desc(a[i], a[l]); }
}
__device__ __forceinline__ void top16_of_64(float* v) {
    sort16_desc(v); sort16_desc(v + 16); sort16_desc(v + 32); sort16_desc(v + 48);
    merge_top16(v, v + 16); merge_top16(v + 32, v + 48); merge_top16(v, v + 32);
}
__device__ __forceinline__ float dot2(unsigned a, unsigned b, float acc) { return __builtin_amdgcn_fdot2_f32_bf16(__builtin_bit_cast(bf16x2_t, a), __builtin_bit_cast(bf16x2_t, b), acc, false); }
__device__ __forceinline__ float wave_sum_dpp(float v) {
    v += __builtin_bit_cast(float, __builtin_amdgcn_update_dpp(0, __builtin_bit_cast(int, v), 0xB1, 0xF, 0xF, true));
    v += __builtin_bit_cast(float, __builtin_amdgcn_update_dpp(0, __builtin_bit_cast(int, v), 0x4E, 0xF, 0xF, true));
    v += __builtin_bit_cast(float, __builtin_amdgcn_update_dpp(0, __builtin_bit_cast(int, v), 0x141, 0xF, 0xF, true));
    v += __builtin_bit_cast(float, __builtin_amdgcn_update_dpp(0, __builtin_bit_cast(int, v), 0x140, 0xF, 0xF, true));
    const int vi = __builtin_bit_cast(int, v);
    const float a = __builtin_bit_cast(float, __builtin_amdgcn_readlane(vi, 0)), b = __builtin_bit_cast(float, __builtin_amdgcn_readlane(vi, 16));
    const float c = __builtin_bit_cast(float, __builtin_amdgcn_readlane(vi, 32)), d = __builtin_bit_cast(float, __builtin_amdgcn_readlane(vi, 48));
    return (a + b) + (c + d);
}
__device__ __forceinline__ float gelu_as(float v) {
    const float av = fabsf(v), t = __builtin_amdgcn_rcpf(av * 0.2316418882f + 1.0f);
    float q = t * 0.5307027145f + (-0.7265760135f); q = q * t + 0.7107068705f; q = q * t + (-0.142248368f); q = q * t + 0.127414796f; q = q * t;
    const float e = __builtin_amdgcn_exp2f((v * v) * (-0.72134752044f));
    const float m = v * (q * e);
    return v < 0.f ? m : v - m;
}
constexpr int PEER_TOK = 32;
__device__ __forceinline__ void peer_unit(const Params& p, int u, char* lds) {
    int tid = threadIdx.x; asm volatile("" : "+v"(tid));
    const int wid = tid >> 6, lane = tid & 63, r32 = lane & 31, hi = lane >> 5;
    constexpr int KS = 136;
    int* IDXl = (int*)lds; float* GATEl = (float*)(lds + 32 * KS * 4); int* SCR = (int*)(lds + 2 * 32 * KS * 4) + wid * 1024;
    const int t0 = u * PEER_TOK;
    {
        const int h = wid;
        float sab[2][16];
#pragma unroll
        for (int c = 0; c < 2; ++c) {
            f32x16 acc[4];
#pragma unroll
            for (int nb = 0; nb < 4; ++nb) acc[nb] = f32x16{};
            const bf16_t* qrow = P_QP(p) + (size_t)(t0 + r32) * 2048 + h * 256 + c * 128 + hi * 8;
            const bf16_t* krow = (const bf16_t*)(p.ws + WS_KEYS) + ((size_t)(h * 2 + c) * 128 + r32) * 128 + hi * 8;
#pragma unroll
            for (int ks = 0; ks < 8; ++ks) {
                const bf16x8 bq = *reinterpret_cast<const bf16x8*>(qrow + ks * 16);
#pragma unroll
                for (int nb = 0; nb < 4; ++nb) { const bf16x8 ak = *reinterpret_cast<const bf16x8*>(krow + nb * 32 * 128 + ks * 16);
                    acc[nb] = __builtin_amdgcn_mfma_f32_32x32x16_bf16(ak, bq, acc[nb], 0, 0, 0); }
            }
            float v[64];
#pragma unroll
            for (int nb = 0; nb < 4; ++nb)
#pragma unroll
                for (int r = 0; r < 16; ++r) { const unsigned cn = (unsigned)(32 * nb + (r & 3) + 8 * (r >> 2));
                    v[nb * 16 + r] = __uint_as_float((__float_as_uint(acc[nb][r]) & ~0x7Fu) | cn | ((unsigned)hi << 2)); }
            top16_of_64(v);
            float o[16];
#pragma unroll
            for (int i = 0; i < 16; ++i) o[i] = __shfl_xor(v[i], 32);
            merge_top16(v, o);
#pragma unroll
            for (int i = 0; i < 16; ++i) sab[c][i] = v[i];
        }
        if (hi == 0) {
#pragma unroll
            for (int i = 0; i < 16; ++i) { SCR[r32 * 32 + i] = (int)(__float_as_uint(sab[0][i]) & 0x7Fu); SCR[r32 * 32 + 16 + i] = (int)(__float_as_uint(sab[1][i]) & 0x7Fu); }
        }
        float cnd[64];
        {   int n = 0;
#pragma unroll
            for (int i = 0; i < 16; ++i)
#pragma unroll
                for (int j = 0; j < 16; ++j) if ((i + 1) * (j + 1) <= 16) { cnd[n] = __uint_as_float((__float_as_uint(sab[0][i] + sab[1][j]) & ~0xFFu) | (unsigned)(i * 16 + j)); ++n; }
#pragma unroll
            for (int k = 50; k < 64; ++k) cnd[k] = -INFINITY;
        }
        top16_of_64(cnd);
        float ex[16]; float sum = 0.f;
#pragma unroll
        for (int k = 0; k < 16; ++k) { ex[k] = __builtin_amdgcn_exp2f((cnd[k] - cnd[0]) * LOG2E); sum += ex[k]; }
        const float rsum = 1.0f / sum;
        asm volatile("s_waitcnt lgkmcnt(0)" ::: "memory");
        if (hi == 0) {
#pragma unroll
            for (int k = 0; k < 16; ++k) { const unsigned pos = __float_as_uint(cnd[k]) & 0xFFu;
                const int ia = SCR[r32 * 32 + (pos >> 4)], ib = SCR[r32 * 32 + 16 + (pos & 15)];
                IDXl[r32 * KS + h * 16 + k] = ia * 128 + ib; GATEl[r32 * KS + h * 16 + k] = ex[k] * rsum; }
            IDXl[r32 * KS + 128 + h] = 0; GATEl[r32 * KS + 128 + h] = 0.f;
        }
    }
    __syncthreads();
    const unsigned tabb = (unsigned)(uintptr_t)(lds + 2 * 32 * KS * 4);
    {   const int tc = tid >> 6, tlx = tid & 63;
        *(LAS f32x4*)(uintptr_t)(tabb + (unsigned)tid * 16u) = *(const f32x4*)(P_G2V(p) + tlx * 32 + tc * 4);
        *(LAS f32x4*)(uintptr_t)(tabb + 8192u + (unsigned)tid * 16u) = *(const f32x4*)(P_S2V(p) + tlx * 32 + tc * 4) * H6_SCALE;
        *(LAS f32x4*)(uintptr_t)(tabb + 16384u + (unsigned)tid * 16u) = *(const f32x4*)(P_MODS(p) + 5 * 2048 + (tc >> 2) * 1024 + tlx * 16 + (tc & 3) * 4) * (1.0f / V6_SCALE);
    }
    {
#pragma unroll 1
        for (int tt = 0; tt < 4; ++tt) {
            const int tl = wid * 4 + tt;
            unsigned a0 = ((unsigned)IDXl[tl * KS + lane] << 7) | (unsigned)lane, a1 = ((unsigned)IDXl[tl * KS + 64 + lane] << 7) | (unsigned)(64 + lane);
#pragma unroll
            for (int k = 2; k <= 128; k <<= 1)
#pragma unroll
                for (int j = k >> 1; j > 0; j >>= 1) {
                    if (j == 64) { const unsigned mn = a0 < a1 ? a0 : a1, mx = a0 < a1 ? a1 : a0; a0 = mn; a1 = mx; }
                    else {
                        const unsigned o0 = (unsigned)__shfl_xor((int)a0, j), o1 = (unsigned)__shfl_xor((int)a1, j);
                        const bool lower = (lane & j) == 0;
                        const bool up0 = ((lane & k) == 0), up1 = (((64 + lane) & k) == 0);
                        const unsigned mn0 = a0 < o0 ? a0 : o0, mx0 = a0 < o0 ? o0 : a0, mn1 = a1 < o1 ? a1 : o1, mx1 = a1 < o1 ? o1 : a1;
                        a0 = (up0 == lower) ? mn0 : mx0; a1 = (up1 == lower) ? mn1 : mx1;
                    }
                }
            const float g0 = GATEl[tl * KS + (a0 & 127u)], g1 = GATEl[tl * KS + (a1 & 127u)];
            asm volatile("s_waitcnt lgkmcnt(0)" ::: "memory");
            IDXl[tl * KS + lane] = (int)(a0 >> 7); IDXl[tl * KS + 64 + lane] = (int)(a1 >> 7);
            GATEl[tl * KS + lane] = g0; GATEl[tl * KS + 64 + lane] = g1;
        }
        asm volatile("s_waitcnt lgkmcnt(0)" ::: "memory");
    }
    __syncthreads();
    {
        typedef float f32x2 __attribute__((ext_vector_type(2)));
        const unsigned char* UT = p.ws + WS_UT;
        float nps;
        const unsigned xrb0 = tabb + 40960u + (unsigned)__builtin_amdgcn_readfirstlane(wid) * 8192u;
#define LOADTOK(tl_, xb_) do { const size_t tq_ = (size_t)t0 + (tl_); nps = (lane < 32) ? P_RSS(p)[tq_ * 32 + lane] : 0.f; const unsigned char* hp_ = (const unsigned char*)(P_XN(p) + tq_ * 2048) + lane * 16; \
            att::glds16(hp_, (xb_)); att::glds16(hp_ + 1024, (xb_) + 1024u); att::glds16(hp_ + 2048, (xb_) + 2048u); att::glds16(hp_ + 3072, (xb_) + 3072u); } while (0)
        LOADTOK(wid * 4, xrb0);
        for (int tt = 0; tt < 4; ++tt) {
            const int tl = wid * 4 + tt; const size_t t = (size_t)t0 + tl;
            const unsigned xrb = xrb0 + (unsigned)(tt & 1) * 4096u, xrn = xrb0 + (unsigned)((tt + 1) & 1) * 4096u;
            int lane_t = lane; asm volatile("" : "+v"(lane_t));
            const unsigned h2b = tabb + 24576u + (unsigned)__builtin_amdgcn_readfirstlane(wid) * 2048u;
            {
                const float rstd = 1.0f / sqrtf(wave_sum_dpp(nps) * (1.0f / 2048.0f) + EPS) * H6_SCALE;
                asm volatile("s_waitcnt vmcnt(0)" ::: "memory");
                f32x16 lo_, hi_;
#pragma unroll
                for (int c = 0; c < 4; ++c) { const u32x4 w_ = *(const LAS u32x4*)(uintptr_t)(xrb + (unsigned)lane_t * 64u + (unsigned)c * 16u); const unsigned ws_[4] = {w_.x, w_.y, w_.z, w_.w};
#pragma unroll
                    for (int q = 0; q < 2; ++q) { const int e0 = 8 * c + 4 * q; const unsigned ta_ = tabb + (unsigned)((2 * c + q) * 64 + lane_t) * 16u;
                        const f32x4 gg = *(const LAS f32x4*)(uintptr_t)ta_, s4 = *(const LAS f32x4*)(uintptr_t)(ta_ + 8192u);
                        const float v0 = __uint_as_float(ws_[2 * q] << 16) * rstd * gg[0] + s4[0], v1 = __uint_as_float(ws_[2 * q] & 0xffff0000u) * rstd * gg[1] + s4[1];
                        const float v2 = __uint_as_float(ws_[2 * q + 1] << 16) * rstd * gg[2] + s4[2], v3 = __uint_as_float(ws_[2 * q + 1] & 0xffff0000u) * rstd * gg[3] + s4[3];
                        if (c < 2) { lo_[e0] = v0; lo_[e0 + 1] = v1; lo_[e0 + 2] = v2; lo_[e0 + 3] = v3; } else { hi_[e0 - 16] = v0; hi_[e0 - 15] = v1; hi_[e0 - 14] = v2; hi_[e0 - 13] = v3; } } }
                const u32x6 pk = __builtin_amdgcn_cvt_scalef32_2xpk16_fp6_f32(lo_, hi_, 1.0f);
                const unsigned ha_ = h2b + (unsigned)lane_t * 32u;
                *(LAS u32x4*)(uintptr_t)ha_ = (u32x4){pk[0], pk[1], pk[2], pk[3]}; *(LAS u32x2*)(uintptr_t)(ha_ + 16u) = (u32x2){pk[4], pk[5]};
                asm volatile("s_waitcnt lgkmcnt(0)" ::: "memory");
            }
            if (tt < 3) LOADTOK(tl + 1, xrn);
            f32x2 acc[16];
#pragma unroll
            for (int i = 0; i < 16; ++i) acc[i] = (f32x2){0.f, 0.f};
            const int l16 = lane & 15;
#if FP6_INTERLEAVED
#define FK(k_) ((((k_) & 15) << 1) | ((k_) >> 4))
#else
#define FK(k_) (k_)
#endif
#define DEC6(P_) __builtin_amdgcn_cvt_scalef32_pk32_f16_fp6(P_, 1.0f)
#define SBAR() __builtin_amdgcn_sched_barrier(0)
            constexpr int NBV = 2;
            const unsigned vl16 = (unsigned)lane * 16u, vl8 = 1024u + (unsigned)lane * 8u;
            u32x4 Aq[NBV], Bq[NBV]; u32x2 Ar[NBV], Br[NBV];
#define LOADV(S_, iv_, base_) do { _Pragma("unroll") for (int i_ = 0; i_ < NBV; ++i_) { \
                const int e_ = __builtin_amdgcn_readlane(iv_, (base_) + i_); const unsigned char* r_ = UT + (size_t)e_ * 3072 + 1536;        \
                S_##q[i_] = *(const u32x4*)(r_ + vl16); S_##r[i_] = *(const u32x2*)(r_ + vl8); } } while (0)
#define COMPV(S_, base_) do { _Pragma("unroll") for (int i_ = 0; i_ < NBV; ++i_) { \
                const _Float16 wh_ = (_Float16)__builtin_bit_cast(float, __builtin_amdgcn_readlane(__builtin_bit_cast(int, wv), (base_) + i_)); const h16x2 w2_ = {wh_, wh_}; \
                const h16x32 dv_ = DEC6(((u32x6){S_##q[i_].x, S_##q[i_].y, S_##q[i_].z, S_##q[i_].w, S_##r[i_].x, S_##r[i_].y})); \
                _Pragma("unroll") for (int m_ = 0; m_ < 16; ++m_) acch[m_] = (h16x2){dv_[2 * m_], dv_[2 * m_ + 1]} * w2_ + acch[m_]; __builtin_amdgcn_sched_barrier(0); } } while (0)
            int idxv = IDXl[tl * KS + l16];
            LOADV(A, idxv, 0);
            u32x4 L0[3], L1[3];
            const unsigned char* ub = UT + (size_t)idxv * 3072 + (unsigned)(lane >> 4) * 16u;
#define LDU(L_, ub_, t8_) do { L_[0] = *(const u32x4*)((ub_) + (t8_) * 192); L_[1] = *(const u32x4*)((ub_) + (t8_) * 192 + 64); L_[2] = *(const u32x4*)((ub_) + (t8_) * 192 + 128); } while (0)
#define MMU(L_, t8_) do { const u32x4 a0_ = *(const LAS u32x4*)(uintptr_t)(hq + (unsigned)(2 * (t8_)) * 128u); const u32x2 a1_ = *(const LAS u32x2*)(uintptr_t)(hq + (unsigned)(2 * (t8_)) * 128u + 16u); \
                        const u32x4 c0_ = *(const LAS u32x4*)(uintptr_t)(hq + (unsigned)(2 * (t8_) + 1) * 128u); const u32x2 c1_ = *(const LAS u32x2*)(uintptr_t)(hq + (unsigned)(2 * (t8_) + 1) * 128u + 16u); \
                        const att::i32x8 A0_ = {(int)a0_.x, (int)a0_.y, (int)a0_.z, (int)a0_.w, (int)a1_.x, (int)a1_.y, 0, 0}, A1_ = {(int)c0_.x, (int)c0_.y, (int)c0_.z, (int)c0_.w, (int)c1_.x, (int)c1_.y, 0, 0}; \
                        const att::i32x8 B0_ = {(int)L_[0].x, (int)L_[0].y, (int)L_[0].z, (int)L_[0].w, (int)L_[1].x, (int)L_[1].y, 0, 0}, B1_ = {(int)L_[1].z, (int)L_[1].w, (int)L_[2].x, (int)L_[2].y, (int)L_[2].z, (int)L_[2].w, 0, 0}; \
                        dacc = __builtin_amdgcn_mfma_scale_f32_16x16x128_f8f6f4(A0_, B0_, dacc, 2, 2, 0, 0, 0, 0); dacc = __builtin_amdgcn_mfma_scale_f32_16x16x128_f8f6f4(A1_, B1_, dacc, 2, 2, 0, 0, 0, 0); } while (0)
            LDU(L0, ub, 0); LDU(L1, ub, 1);
            const unsigned hq = h2b + (unsigned)(lane >> 4) * 32u;
#pragma unroll 1
            for (int bt = 0; bt < 8; ++bt) {
                const float gatev = GATEl[tl * KS + bt * 16 + l16];
                const int idxn = IDXl[tl * KS + ((bt + 1) & 7) * 16 + l16];
                f32x4 dacc = {0.f, 0.f, 0.f, 0.f};
                {
                    MMU(L0, 0); LDU(L0, ub, 2); MMU(L1, 1); LDU(L1, ub, 3); MMU(L0, 2); LDU(L0, ub, 4); MMU(L1, 3); LDU(L1, ub, 5);
                    MMU(L0, 4); LDU(L0, ub, 6); MMU(L1, 5); LDU(L1, ub, 7); MMU(L0, 6); MMU(L1, 7);
                }
                const float wv = gatev * gelu_as(dacc[0] * (1.0f / (U6_SCALE * H6_SCALE)));
                h16x2 acch[16];
#pragma unroll
                for (int m = 0; m < 16; ++m) acch[m] = (h16x2){(_Float16)0.f, (_Float16)0.f};
                SBAR();
                LOADV(B, idxv, 2); SBAR(); COMPV(A, 0); SBAR();
                LOADV(A, idxv, 4); SBAR(); COMPV(B, 2); SBAR();
                LOADV(B, idxv, 6); SBAR(); COMPV(A, 4); SBAR();
                LOADV(A, idxv, 8); SBAR(); COMPV(B, 6); SBAR();
                LOADV(B, idxv, 10); SBAR(); COMPV(A, 8); SBAR();
                LOADV(A, idxv, 12); SBAR(); COMPV(B, 10); SBAR();
                LOADV(B, idxv, 14); SBAR(); COMPV(A, 12); SBAR();
                if (bt < 7) LOADV(A, idxn, 0);
                ub = UT + (size_t)idxn * 3072 + (unsigned)(lane >> 4) * 16u;
                if (bt < 7) { LDU(L0, ub, 0); LDU(L1, ub, 1); }
                SBAR(); COMPV(B, 14); SBAR();
#pragma unroll
                for (int m = 0; m < 16; ++m) { acc[m].x += (float)acch[m].x; acc[m].y += (float)acch[m].y; }
                idxv = idxn;
            }
#undef FK
#undef DEC6
#undef SBAR
#undef LOADV
#undef COMPV
#undef LDU
#undef MMU
            int lane_e = lane, tl_e = tl; asm volatile("" : "+v"(lane_e), "+v"(tl_e));
            const size_t t_e = (size_t)t0 + tl_e;
            float* orow = p.out + t_e * 2048;
            u32x4 ex[4];
            {   const unsigned xr_ = xrb + (unsigned)lane_e * 32u; ex[0] = *(const LAS u32x4*)(uintptr_t)xr_; ex[1] = *(const LAS u32x4*)(uintptr_t)(xr_ + 16u); ex[2] = *(const LAS u32x4*)(uintptr_t)(xr_ + 2048u); ex[3] = *(const LAS u32x4*)(uintptr_t)(xr_ + 2064u); }
#pragma unroll
            for (int j = 0; j < 2; ++j) { const int ob = j * 1024 + lane_e * 16;
                const unsigned xw[8] = {ex[2 * j].x, ex[2 * j].y, ex[2 * j].z, ex[2 * j].w, ex[2 * j + 1].x, ex[2 * j + 1].y, ex[2 * j + 1].z, ex[2 * j + 1].w};
#pragma unroll
                for (int q = 0; q < 4; ++q) { const int o = ob + q * 4;
                    const f32x4 x0 = {__uint_as_float(xw[2 * q] << 16), __uint_as_float(xw[2 * q] & 0xffff0000u), __uint_as_float(xw[2 * q + 1] << 16), __uint_as_float(xw[2 * q + 1] & 0xffff0000u)};
                    const f32x4 ga = *(const LAS f32x4*)(uintptr_t)(tabb + 16384u + (unsigned)((j * 4 + q) * 64 + lane_e) * 16u);
                    const f32x4 r_ = x0 + ga * (j == 0 ? (f32x4){acc[4 * q].x, acc[4 * q + 1].x, acc[4 * q + 2].x, acc[4 * q + 3].x} : (f32x4){acc[4 * q].y, acc[4 * q + 1].y, acc[4 * q + 2].y, acc[4 * q + 3].y});
                    *(f32x4*)(orow + o) = r_; } }
        }
    }
    __syncthreads();
}
}

#define XB_TMO      128
#define XB_XCNT(j)  (256  + 64 * (j))
#define XB_XSUB(j)  (1280 + 64 * (j))
#define XB_XGEN(j)  (2304 + 64 * (j))
#define XB_TOP      3328
#define XB_TOPGEN   3392
#define XCD_BAR_WORDS 3456
#define XB_SPIN_CAP (1u << 18)

__device__ __forceinline__ unsigned xb_ld(unsigned* p)              { return __hip_atomic_load(p, __ATOMIC_RELAXED, __HIP_MEMORY_SCOPE_AGENT); }
__device__ __forceinline__ unsigned xb_add(unsigned* p, unsigned v) { return __hip_atomic_fetch_add(p, v, __ATOMIC_RELAXED, __HIP_MEMORY_SCOPE_AGENT); }
__device__ __forceinline__ unsigned xb_xcc_id() { return (unsigned)__builtin_amdgcn_s_getreg((3 << 11) | 20) & 0xFu; }
#define XB_SPIN(cond, bar) do { unsigned _sp = 0; while (cond) { __builtin_amdgcn_s_sleep(1); \
    if ((++_sp & 255u) == 0u) { if (xb_ld(&(bar)[XB_TMO])) break; if (_sp > XB_SPIN_CAP) { atomicAdd(&(bar)[XB_TMO], 1u); break; } } } } while (0)

struct XcdBarrier {
    unsigned* bar; unsigned x;
    volatile LAS unsigned* st;
};

__device__ __forceinline__ XcdBarrier xcd_barrier_post(unsigned* bar, volatile LAS unsigned* st) {
    XcdBarrier b; b.bar = bar; b.x = xb_xcc_id(); b.st = st;
    if (threadIdx.x == 0) (void)xb_add(&bar[XB_XCNT(b.x)], 1u);
    return b;
}
__device__ __forceinline__ void xcd_barrier_complete(unsigned* bar, unsigned x, unsigned& nloc, unsigned& nx) {
    const unsigned G = gridDim.x * gridDim.y * gridDim.z;
    unsigned sum, cnt, mine, sp = 0u;
    for (;;) {
        sum = 0u; cnt = 0u; mine = 0u;
#pragma unroll
        for (unsigned j = 0; j < 16; ++j) { const unsigned c = xb_ld(&bar[XB_XCNT(j)]); sum += c; cnt += (c > 0u) ? 1u : 0u; mine = (j == x) ? c : mine; }
        if (sum == G) break;
        __builtin_amdgcn_s_sleep(1);
        if ((++sp & 255u) == 0u) { if (xb_ld(&bar[XB_TMO])) break; if (sp > XB_SPIN_CAP) { atomicAdd(&bar[XB_TMO], 1u); break; } }
    }
    nloc = mine > 0u ? mine : 1u; nx = cnt > 0u ? cnt : 1u;
}

__device__ __forceinline__ void xcd_barrier(const XcdBarrier& b) {
    asm volatile("s_waitcnt vmcnt(0)" ::: "memory");
    __syncthreads();
    if (threadIdx.x == 0) {
        unsigned* bar = b.bar;
        __builtin_amdgcn_s_waitcnt(0);
        unsigned nloc = b.st[0], nx = b.st[1];
        if (nloc == 0u) { xcd_barrier_complete(bar, b.x, nloc, nx); b.st[0] = nloc; b.st[1] = nx; }
        const unsigned old = xb_add(&bar[XB_XSUB(b.x)], 1u);
        const unsigned gen = old / nloc;
        if (old + 1u == (gen + 1u) * nloc) {
            __builtin_amdgcn_fence(__ATOMIC_RELEASE, "agent");
            asm volatile("s_waitcnt vmcnt(0)" ::: "memory");
            const unsigned og = xb_add(&bar[XB_TOP], 1u);
            const unsigned tg = og / nx;
            if (og + 1u == (tg + 1u) * nx) xb_add(&bar[XB_TOPGEN], 1u);
            else XB_SPIN(xb_ld(&bar[XB_TOPGEN]) == tg, bar);
            __builtin_amdgcn_fence(__ATOMIC_ACQUIRE, "agent");
            xb_add(&bar[XB_XGEN(b.x)], 1u);
            asm volatile("s_waitcnt vmcnt(0)" ::: "memory");
        } else {
            XB_SPIN(xb_ld(&bar[XB_XGEN(b.x)]) == gen, bar);
            __builtin_amdgcn_fence(__ATOMIC_ACQUIRE, "agent");
            asm volatile("s_waitcnt vmcnt(0)" ::: "memory");
        }
    }
    __syncthreads();
}

namespace cg = cooperative_groups;
constexpr int MK_LDS = 163840;
enum { PH_PREP = 0, PH_HNORM, PH_GEMM1, PH_POST, PH_ATTN, PH_OUTP, PH_H2, PH_QP, PH_PEER, PH_N };
struct MkArgs { Params p; int ph_lo, ph_hi; };
__global__ __launch_bounds__(512, 2) void mk_fwd(MkArgs a) {
    extern __shared__ __attribute__((aligned(16))) unsigned char lds[];
    const Params& p = a.p;
    const int lo = a.ph_lo, hi = a.ph_hi;
    const int tid = threadIdx.x, lane = tid & 63, wave = __builtin_amdgcn_readfirstlane(tid >> 6);
    const int G = gridDim.x, bx = blockIdx.x;
    cg::grid_group grid = cg::this_grid();
    volatile LAS unsigned* xst = (volatile LAS unsigned*)((LAS unsigned char*)lds + MK_LDS - 64);
    if (tid < 16) xst[tid] = 0u;
    __syncthreads();
    const XcdBarrier xbar = xcd_barrier_post((unsigned*)(p.ws + WS_CTL) + 4096, xst);
#define IN(k) (lo <= (k) && (k) < hi)
#define SEAM(k) do { if (IN(k) && IN((k) + 1)) xcd_barrier(xbar); } while (0)
    if (lo < 0) grid.sync();
    if (IN(PH_PREP)) {
        float* fl = (float*)lds;
        p0_adaln(p, fl, bx, G);
        __syncthreads();
        const size_t gtid = (size_t)bx * 512 + tid, gthreads = (size_t)G * 512;
        cvt_range(p.peer_keys, (bf16_t*)(p.ws + WS_KEYS), 8 * 2 * 128 * 128 / 8, gtid, gthreads);
        cvt_range(p.gmlp_ws, (bf16_t*)(p.ws + WS_GWS), 8 * 128 * 128 / 8, gtid, gthreads);
        for (size_t i = gtid; i < 320 * 16; i += gthreads) { const int tp = (int)(i >> 4), f = (int)(i & 15);
            const float posf = (float)(tp < 256 ? tp : tp - 256), inv = exp2f(-(float)f * (13.287712379549449f / 16.0f)), ang = posf * inv;
            P_ROPE(p)[2 * i] = cosf(ang); P_ROPE(p)[2 * i + 1] = sinf(ang); }
        float* scr = fl + wave * (64 * 33);
        const int gw = bx * 8 + wave, ngw = G * 8;
        constexpr int I_IN = (2048 / 64) * (5120 / 32), I_SQ = (2048 / 64) * (2048 / 32);
        for (int it = gw; it < I_IN; it += ngw) {
            if ((it % 160) < 64) transpose_item(p.w_in, 2048, 5120, (bf16_t*)(p.ws + WS_WIN_T), scr, it, lane);
            else transpose_item8(p.w_in, 2048, 5120, p.ws + WS_WIN_T + 8 * MiB - (size_t)2048 * 2048, scr, it, lane, W8_SCALE); }
    }
    SEAM(PH_PREP);
    if (IN(PH_HNORM)) {
        const int gw = bx * 8 + wave, ngw = G * 8;
        const float* mods = P_MODS(p); const float* modsc = P_MODSC(p);
        if (bx == 0) for (int i = tid; i < 2048; i += 512) { P_G2V(p)[i] = p.norm2_g[i] * (1.0f + mods[4 * 2048 + i]); P_S2V(p)[i] = mods[3 * 2048 + i]; }
        for (int row = gw; row < LT; row += ngw) {
            if (row < CTX) norm_row_dual(p.ctx + (size_t)row * DM, p.norm1_g, modsc, modsc + 2048, P_HB(p) + (size_t)row * DM, P_HB8(p) + (size_t)row * DM, lane);
            else norm_row_dual(p.x + (size_t)(row - CTX) * DM, p.norm1_g, mods, mods + 2048, P_HB(p) + (size_t)row * DM, P_HB8(p) + (size_t)row * DM, lane);
        }
    }
    SEAM(PH_HNORM);
    if (IN(PH_GEMM1)) {
        {
            pg8::Gemm g{P_HB(p) + (size_t)CTX * DM, (const bf16_t*)(p.ws + WS_WIN_T), SEQ, 2048, DM}; pg8::StaticOrder S; S.init(SEQ, 2048, G, bx);
            pg8::EpiG1m E{P_UG(p), P_VG(p), P_QS8(p), P_KIMG8(p), P_VIMG8(p), p.q_norm_g, p.k_norm_g, P_ROPE(p), (LAS float*)((LAS unsigned char*)lds + 131072), 1, 0, 1.0f};
            pg8::gemm_phase<pg8::EpiG1m, pg8::StaticOrder, true, true, false>((LAS unsigned char*)lds, g, S, E); }
        {
            pg8::Gemm g{(const bf16_t*)P_HB8(p), (const bf16_t*)(p.ws + WS_WIN_T + 8 * MiB), LT, 3072, DM / 2}; pg8::StaticOrder S; S.init(LT, 3072, G, bx);
            pg8::EpiG1m E{P_UG(p), P_VG(p), P_QS8(p), P_KIMG8(p), P_VIMG8(p), p.q_norm_g, p.k_norm_g, P_ROPE(p), (LAS float*)((LAS unsigned char*)lds + 131072), 0, 8, 1.0f / W8_SCALE};
            pg8::gemm_phase<pg8::EpiG1m, pg8::StaticOrder, true, true, true>((LAS unsigned char*)lds, g, S, E); }
        {
            unsigned* qctr = (unsigned*)(p.ws + WS_CTL) + 64;
            float* scr = (float*)lds + wave * (64 * 33);
            for (;;) {
                __syncthreads();
                if (tid == 0) xst[8] = atomicAdd(qctr, 1u);
                __syncthreads();
                const unsigned c = xst[8];
                if (c >= 2592u) break;
                if (c >= 2560u) {
                    const int n0 = (int)(c - 2560u) * 64; const float* w_ = p.peer_wq + n0 + lane; const float* s2 = P_S2V(p); float a_ = 0.f;
#pragma unroll 8
                    for (int k = wave * 256; k < wave * 256 + 256; ++k) a_ += s2[k] * w_[(size_t)k * 2048];
                    float* red = (float*)lds; red[wave * 64 + lane] = a_;
                    __syncthreads();
                    if (wave == 0) { float t_ = 0.f;
#pragma unroll
                        for (int w8 = 0; w8 < 8; ++w8) t_ += red[w8 * 64 + lane];
                        P_BQ(p)[n0 + lane] = t_; }
                    continue; }
                if (c < 2048u) { const bool isv = c >= 1024u; const size_t r0 = (size_t)(c & 1023u) * 16;
                    const float* src = (isv ? p.peer_v : p.peer_u) + r0 * 2048; unsigned char* dst = p.ws + WS_UT + r0 * 3072 + (isv ? 1536 : 0); const float sc = isv ? V6_SCALE : U6_SCALE;
                    for (int i = tid; i < 16 * 64; i += 512) { const int rr = i >> 6, cc = i & 63;
                        const float* s_ = isv ? src + (size_t)rr * 2048 + cc * 16 : src + (size_t)rr * 2048 + cc * 32;
                        const int o2 = isv ? 1024 : 16;
                        f32x16 a_, b_;
#pragma unroll
                        for (int k = 0; k < 4; ++k) { const f32x4 x_ = *(const f32x4*)(s_ + 4 * k) * sc, y_ = *(const f32x4*)(s_ + o2 + 4 * k) * sc;
                            a_[4 * k] = x_[0]; a_[4 * k + 1] = x_[1]; a_[4 * k + 2] = x_[2]; a_[4 * k + 3] = x_[3]; b_[4 * k] = y_[0]; b_[4 * k + 1] = y_[1]; b_[4 * k + 2] = y_[2]; b_[4 * k + 3] = y_[3]; }
                        const u32x6 pk = __builtin_amdgcn_cvt_scalef32_2xpk16_fp6_f32(a_, b_, 1.0f);
                        const int sg = cc >> 2, kq = cc & 3;
                        if (isv) { unsigned char* d_ = dst + (size_t)rr * 3072;
                            *(u32x4*)(d_ + cc * 16) = (u32x4){pk[0], pk[1], pk[2], pk[3]}; *(u32x2*)(d_ + 1024 + cc * 8) = (u32x2){pk[4], pk[5]}; }
                        else { unsigned char* d_ = dst + (size_t)rr * 3072 + (sg >> 1) * 192 + kq * 16;
                            if ((sg & 1) == 0) { *(u32x4*)d_ = (u32x4){pk[0], pk[1], pk[2], pk[3]}; *(u32x2*)(d_ + 64) = (u32x2){pk[4], pk[5]}; }
                            else { *(u32x2*)(d_ + 64 + 8) = (u32x2){pk[0], pk[1]}; *(u32x4*)(d_ + 128) = (u32x4){pk[2], pk[3], pk[4], pk[5]}; } } } }
                else { const int it = (int)(c - 2048u) * 8 + wave; constexpr int I_SQ = (2048 / 64) * (2048 / 32);
                    if (it < I_SQ) transpose_item(p.w_out, 2048, 2048, (bf16_t*)(p.ws + WS_WOUT_T), scr, it, lane);
                    else transpose_item(p.peer_wq, 2048, 2048, (bf16_t*)(p.ws + WS_WQ_T), scr, it - I_SQ, lane, P_G2V(p)); }
            }
        }
    }
    SEAM(PH_GEMM1);
    if (IN(PH_POST)) {
        for (int u = bx; u < 128 * 8; u += G) gm::gmlp_unit(p, u >> 3, u & 7, (char*)lds);
    }
    SEAM(PH_POST);
    if (IN(PH_ATTN)) {
        for (int u = bx; u < NH * (SEQ / 256); u += G) att::attn_unit8(p, u & 7, u >> 3, (char*)lds);
    }
    SEAM(PH_ATTN);
    if (IN(PH_OUTP)) {
        pg8::Gemm g{P_A2(p), (const bf16_t*)(p.ws + WS_WOUT_T), SEQ, DM, DM}; pg8::StaticOrder S; S.init(SEQ, DM, G, bx);
        pg8::EpiOutm E{p.x, P_MODS(p) + 2 * 2048, P_XN(p), P_RSS(p)};
        pg8::gemm_phase<pg8::EpiOutm, pg8::StaticOrder, true, true>((LAS unsigned char*)lds, g, S, E);
    }
    SEAM(PH_OUTP);
    if (IN(PH_QP)) {
        pg8::Gemm g{P_XN(p), (const bf16_t*)(p.ws + WS_WQ_T), SEQ, DM, DM}; pg8::StaticOrder S; S.init(SEQ, DM, G, bx);
        pg8::EpiQp E{P_QP(p), P_RSS(p), P_BQ(p)};
        pg8::gemm_phase<pg8::EpiQp, pg8::StaticOrder, true, true>((LAS unsigned char*)lds, g, S, E);
    }
    SEAM(PH_QP);
    if (IN(PH_PEER)) {
        for (int u = bx; u < SEQ / peer::PEER_TOK; u += G) peer::peer_unit(p, u, (char*)lds);
    }
#undef IN
#undef SEAM
}
static int g_grid = 0;
static void mk_launch(const Params& p, int lo, int hi, hipStream_t stream) {
    (void)hipMemsetAsync(p.ws + WS_CTL, 0, 65536, stream);
    MkArgs a{}; a.p = p; a.ph_lo = lo; a.ph_hi = hi;
    void* args[] = {&a};
    hipError_t e = hipLaunchCooperativeKernel((const void*)mk_fwd, dim3(g_grid), dim3(512), args, MK_LDS, stream);
    if (e != hipSuccess) fprintf(stderr, "mk_launch [%d,%d) failed: %s (grid %d)\n", lo, hi, hipGetErrorString(e), g_grid);
}

extern "C" void kernel_launch(void* const* d_in, const int* in_sizes, int n_in, void* d_out, int out_size, void* d_ws, size_t ws_size, hipStream_t stream) {
    static int init = 0;
    if (!init) {
        if (n_in != 24 || ws_size < WS_END) { fprintf(stderr, "kernel_launch: unexpected n_in %d / ws %zu\n", n_in, ws_size); }
        (void)hipFuncSetAttribute((const void*)mk_fwd, hipFuncAttributeMaxDynamicSharedMemorySize, MK_LDS);
        int dev = 0, cus = 0, per_cu = 0;
        (void)hipGetDevice(&dev); (void)hipDeviceGetAttribute(&cus, hipDeviceAttributeMultiprocessorCount, dev);
        (void)hipOccupancyMaxActiveBlocksPerMultiprocessor(&per_cu, (const void*)mk_fwd, 512, MK_LDS);
        if (per_cu < 1) { fprintf(stderr, "kernel_launch: occupancy query says %d blocks/CU\n", per_cu); per_cu = 1; }
        g_grid = cus * 1;
        init = 1;
    }
    Params p{};
    const float** f = (const float**)&p;
    for (int i = 0; i < 24; ++i) f[i] = (const float*)d_in[i];
    p.out = (float*)d_out; p.ws = (unsigned char*)d_ws;

    mk_launch(p, PH_PREP, PH_N, stream);
}
```
